# Optimizing an MI355X kernel written in HIP

```python
import jax, jax.numpy as jnp
from jax import lax
import numpy as np

D_MODEL = 2048
BATCH = 2
SEQ = 16384
DEPTH = 1

GRID_W = 64
HEAD_DIM = 128
A_Q_HEADS = 8
A_KV_HEADS = 2
B_HEADS = 8
NA_ROWS = 8
NA_COLS = 16
ROPE_THETA = 10000.0
Q_BLOCK = 128
N_EXPERTS = 32
TOP_K = 4
D_EXPERT = D_MODEL
SWIGLU_ALPHA = 1.702
SWIGLU_LIMIT = 7.0
MOE_BLOCK = 256
EPS = 1e-6

A_Q_W = A_Q_HEADS * HEAD_DIM
A_KV_W = A_KV_HEADS * HEAD_DIM
B_W = B_HEADS * HEAD_DIM
IN_SIZES = (A_Q_W, A_KV_W, A_KV_W, B_W, B_W, B_W, D_MODEL, D_MODEL)
IN_COLS = sum(IN_SIZES)

kernel_name = "hybrid_gqa_axialrope_natten_moe_encoder"


def rmsnorm(x, g):
    x32 = x.astype(jnp.float32)
    y = x32 * lax.rsqrt(jnp.mean(x32 * x32, axis=-1, keepdims=True) + EPS)
    return y.astype(x.dtype) * g


def axial_rope_tables(seq_len):
    t = jnp.arange(seq_len, dtype=jnp.int32)
    pos = jnp.stack([(t // GRID_W), (t % GRID_W)], axis=-1).astype(jnp.float32)
    axis_dims = HEAD_DIM // 2
    inv_freq = ROPE_THETA ** (-jnp.arange(0, axis_dims, 2, dtype=jnp.float32) / axis_dims)
    ang = pos[:, :, None] * inv_freq[None, None, :]
    return jnp.cos(ang), jnp.sin(ang)


def apply_axial_rope(x, cos, sin):
    B, S, H, dh = x.shape
    xr = x.astype(jnp.float32).reshape(B, S, H, 2, 2, dh // 4)
    x1, x2 = xr[..., 0, :], xr[..., 1, :]
    c, s = cos[None, :, None], sin[None, :, None]
    out = jnp.stack([x1 * c - x2 * s, x2 * c + x1 * s], axis=-2)
    return out.reshape(B, S, H, dh).astype(x.dtype)


def gqa_axial_attention(q, k, v, cos, sin):
    B, S, _, dh = q.shape
    group = A_Q_HEADS // A_KV_HEADS
    q = apply_axial_rope(q, cos, sin)
    k = apply_axial_rope(k, cos, sin)
    scale = dh ** -0.5
    qb = jnp.moveaxis(q.reshape(B, S // Q_BLOCK, Q_BLOCK, A_KV_HEADS, group, dh), 1, 0)

    def block(q_blk):
        s = jnp.einsum('bqhgd,bkhd->bhgqk', q_blk, k, preferred_element_type=jnp.float32) * scale
        p = jax.nn.softmax(s, axis=-1).astype(v.dtype)
        return jnp.einsum('bhgqk,bkhd->bqhgd', p, v)

    o = lax.map(block, qb)
    return jnp.moveaxis(o, 0, 1).reshape(B, S, A_Q_HEADS * dh)


def neighbourhood_attention(q, k, v, rel_bias):
    B, S, H, dh = q.shape
    rows = S // GRID_W
    kr = min(NA_ROWS, rows)
    kc = NA_COLS
    scale = dh ** -0.5
    qg = q.reshape(B, rows, GRID_W, H, dh)
    kg = k.reshape(B, rows, GRID_W, H, dh)
    vg = v.reshape(B, rows, GRID_W, H, dh)
    c = np.arange(GRID_W)
    c_start = np.clip(c - kc // 2, 0, GRID_W - kc)
    col_idx = c_start[:, None] + np.arange(kc)[None, :]
    col_off = col_idx - c[:, None] + (NA_COLS - 1)
    bias_cols = rel_bias[:, :, col_off]

    def row_block(r):
        r_start = jnp.clip(r - kr // 2, 0, rows - kr)
        q_r = lax.dynamic_index_in_dim(qg, r, axis=1, keepdims=False)
        k_win = lax.dynamic_slice_in_dim(kg, r_start, kr, axis=1)
        v_win = lax.dynamic_slice_in_dim(vg, r_start, kr, axis=1)
        k_sel = k_win[:, :, col_idx]
        v_sel = v_win[:, :, col_idx]
        s = jnp.einsum('bchd,bicjhd->bhcij', q_r, k_sel, preferred_element_type=jnp.float32) * scale
        row_off = r_start + jnp.arange(kr) - r + (NA_ROWS - 1)
        bias = jnp.take(bias_cols, row_off, axis=1)
        s = s + jnp.transpose(bias, (0, 2, 1, 3))[None].astype(jnp.float32)
        p = jax.nn.softmax(s.reshape(B, H, GRID_W, kr * kc), axis=-1)
        p = p.reshape(B, H, GRID_W, kr, kc).astype(v.dtype)
        return jnp.einsum('bhcij,bicjhd->bchd', p, v_sel)

    o = lax.map(row_block, jnp.arange(rows, dtype=jnp.int32))
    return jnp.moveaxis(o, 0, 1).reshape(B, S, H * dh)


def clamped_swiglu(gate, up):
    gate = jnp.minimum(gate, SWIGLU_LIMIT)
    up = jnp.clip(up, -SWIGLU_LIMIT, SWIGLU_LIMIT)
    return gate * jax.nn.sigmoid(SWIGLU_ALPHA * gate) * (up + 1.0)


def moe_ffn(h, w_router, b_router, w_gate, b_gate, w_up, b_up, w_down, b_down):
    n, d = h.shape
    logits = jnp.dot(h, w_router, preferred_element_type=jnp.float32) + b_router.astype(jnp.float32)
    top_val, top_idx = lax.top_k(logits, TOP_K)
    top_w = jax.nn.softmax(top_val, axis=-1)
    nk = n * TOP_K
    flat_e = top_idx.reshape(nk)
    flat_tok = jnp.arange(nk, dtype=jnp.int32) // TOP_K
    order = jnp.argsort(flat_e)
    sorted_e = flat_e[order]
    counts = jnp.bincount(flat_e, length=N_EXPERTS)
    padded = (counts + MOE_BLOCK - 1) // MOE_BLOCK * MOE_BLOCK
    pad_end = jnp.cumsum(padded)
    pad_start = pad_end - padded
    start = jnp.cumsum(counts) - counts
    rank = jnp.arange(nk, dtype=jnp.int32) - start[sorted_e]
    dest = pad_start[sorted_e] + rank
    n_blocks = -(-nk // MOE_BLOCK) + N_EXPERTS
    n_slots = n_blocks * MOE_BLOCK
    slot_tok = jnp.full((n_slots,), n, jnp.int32).at[dest].set(flat_tok[order])
    slot_w = jnp.zeros((n_slots,), h.dtype).at[dest].set(top_w.reshape(nk)[order].astype(h.dtype))
    block_start = jnp.arange(n_blocks, dtype=jnp.int32) * MOE_BLOCK
    block_e = jnp.minimum(jnp.sum(block_start[:, None] >= pad_end[None, :], axis=1), N_EXPERTS - 1)
    h_pad = jnp.concatenate([h, jnp.zeros((1, d), h.dtype)], axis=0)
    xb = h_pad[slot_tok].reshape(n_blocks, MOE_BLOCK, d)

    def expert_block(args):
        xe, e = args
        gate = xe @ w_gate[e] + b_gate[e]
        up = xe @ w_up[e] + b_up[e]
        return clamped_swiglu(gate, up) @ w_down[e] + b_down[e]

    yb = lax.map(expert_block, (xb, block_e)).reshape(n_slots, d)
    out = jax.ops.segment_sum(yb * slot_w[:, None], slot_tok, num_segments=n + 1)
    return out[:n]


def setup_inputs(seed: int = 0) -> dict:
    key = jax.random.key(seed)
    ks = jax.random.split(key, 24)
    f32 = jnp.float32

    def nrm(k, shape, scale):
        return jax.random.normal(k, shape, f32) * scale

    def gain(k, shape):
        return 1.0 + 0.02 * jax.random.normal(k, shape, f32)

    return {
        "x": jax.random.normal(ks[0], (BATCH, SEQ, D_MODEL), f32),
        "attn_norm_g": gain(ks[1], (DEPTH, D_MODEL)),
        "w_in": nrm(ks[2], (DEPTH, D_MODEL, IN_COLS), D_MODEL ** -0.5),
        "a_q_norm_g": gain(ks[3], (DEPTH, HEAD_DIM)),
        "a_k_norm_g": gain(ks[4], (DEPTH, HEAD_DIM)),
        "b_q_norm_g": gain(ks[5], (DEPTH, HEAD_DIM)),
        "b_k_norm_g": gain(ks[6], (DEPTH, HEAD_DIM)),
        "na_rel_bias": nrm(ks[7], (DEPTH, B_HEADS, 2 * NA_ROWS - 1, 2 * NA_COLS - 1), 0.1),
        "w_branch_a": nrm(ks[8], (DEPTH, A_Q_W, D_MODEL), A_Q_W ** -0.5),
        "w_branch_b": nrm(ks[9], (DEPTH, B_W, D_MODEL), B_W ** -0.5),
        "w_out": nrm(ks[10], (DEPTH, D_MODEL, D_MODEL), D_MODEL ** -0.5),
        "ffn_norm_g": gain(ks[11], (DEPTH, D_MODEL)),
        "w_router": nrm(ks[12], (DEPTH, D_MODEL, N_EXPERTS), D_MODEL ** -0.5),
        "b_router": nrm(ks[13], (DEPTH, N_EXPERTS), 0.01),
        "w_gate": nrm(ks[14], (DEPTH, N_EXPERTS, D_MODEL, D_EXPERT), D_MODEL ** -0.5),
        "b_gate": nrm(ks[15], (DEPTH, N_EXPERTS, D_EXPERT), 0.01),
        "w_up": nrm(ks[16], (DEPTH, N_EXPERTS, D_MODEL, D_EXPERT), D_MODEL ** -0.5),
        "b_up": nrm(ks[17], (DEPTH, N_EXPERTS, D_EXPERT), 0.01),
        "w_down": nrm(ks[18], (DEPTH, N_EXPERTS, D_EXPERT, D_MODEL), D_EXPERT ** -0.5),
        "b_down": nrm(ks[19], (DEPTH, N_EXPERTS, D_MODEL), 0.01),
    }


def reference(x, attn_norm_g, w_in, a_q_norm_g, a_k_norm_g, b_q_norm_g, b_k_norm_g,
              na_rel_bias, w_branch_a, w_branch_b, w_out, ffn_norm_g, w_router, b_router,
              w_gate, b_gate, w_up, b_up, w_down, b_down):
    B, S, D = x.shape
    cos, sin = axial_rope_tables(S)
    split_at = [int(v) for v in np.cumsum(IN_SIZES)[:-1]]
    for l in range(DEPTH):
        h = rmsnorm(x, attn_norm_g[l])
        proj = h @ w_in[l]
        qa, ka, va, qb, kb, vb, ga, gb = jnp.split(proj, split_at, axis=-1)
        qa = rmsnorm(qa.reshape(B, S, A_Q_HEADS, HEAD_DIM), a_q_norm_g[l])
        ka = rmsnorm(ka.reshape(B, S, A_KV_HEADS, HEAD_DIM), a_k_norm_g[l])
        va = va.reshape(B, S, A_KV_HEADS, HEAD_DIM)
        qb = rmsnorm(qb.reshape(B, S, B_HEADS, HEAD_DIM), b_q_norm_g[l])
        kb = rmsnorm(kb.reshape(B, S, B_HEADS, HEAD_DIM), b_k_norm_g[l])
        vb = vb.reshape(B, S, B_HEADS, HEAD_DIM)
        ya = gqa_axial_attention(qa, ka, va, cos, sin)
        yb = neighbourhood_attention(qb, kb, vb, na_rel_bias[l])
        merged = jax.nn.sigmoid(ga) * (ya @ w_branch_a[l]) + jax.nn.sigmoid(gb) * (yb @ w_branch_b[l])
        x = x + merged @ w_out[l]
        h = rmsnorm(x, ffn_norm_g[l]).reshape(B * S, D)
        y = moe_ffn(h, w_router[l], b_router[l], w_gate[l], b_gate[l], w_up[l], b_up[l],
                    w_down[l], b_down[l])
        x = x + y.reshape(B, S, D)
    return x
```

```cpp
#include <hip/hip_runtime.h>
#include <cstdio>
#include <cstdint>

#ifndef MK_N_LAUNCHES
#define MK_N_LAUNCHES 1
#endif
#ifndef DUP_PHASE
#define DUP_PHASE -1
#endif
#ifndef DUP_TIMES
#define DUP_TIMES 2
#endif
constexpr int PER_PHASE = 10;
constexpr int N_LAUNCHES = MK_N_LAUNCHES;

#define GAS __attribute__((address_space(1)))
#define LAS __attribute__((address_space(3)))
typedef unsigned short bf16_t;
typedef short bf16x8 __attribute__((ext_vector_type(8)));
typedef short s16x4 __attribute__((ext_vector_type(4)));
typedef float f32x2 __attribute__((ext_vector_type(2)));
typedef float f32x4 __attribute__((ext_vector_type(4)));
typedef float f32x8 __attribute__((ext_vector_type(8)));
typedef float f32x16 __attribute__((ext_vector_type(16)));
typedef unsigned u32x2 __attribute__((ext_vector_type(2)));
typedef unsigned u32x4 __attribute__((ext_vector_type(4)));
typedef int i32x2 __attribute__((ext_vector_type(2)));
typedef int i32x4 __attribute__((ext_vector_type(4)));
typedef int i32x8 __attribute__((ext_vector_type(8)));
typedef GAS unsigned gu32;
constexpr int F8_ONE = 127, F8_W = 121, F8_Y = 121, F8_M = 123;
constexpr float F8_WMUL = 64.0f, F8_YMUL = 64.0f, F8_MMUL = 16.0f;

constexpr int D = 2048, NTOK = 32768, SEQ = 16384, GW = 64, ROWS = 256, HD = 128;
constexpr int NCOLS = 8704;
constexpr int C_QA = 0, C_KA = 1024, C_VA = 1280, C_QB = 1536, C_KB = 2560, C_VB = 3584, C_GA = 4608, C_GB = 6656;
constexpr int NE = 32, DE = 2048, LCAP = 32768;
constexpr int MAXT = 544;
constexpr float EPS = 1e-6f;
constexpr int NWAVES = 8;

constexpr size_t MiB = 1u << 20;
constexpr size_t WS_CTL = 0, CTL_ZERO_BYTES = 1 * MiB;
constexpr size_t WS_TAB = 1 * MiB;
constexpr size_t WS_TOKEP = 1 * MiB + 128 * 1024;
constexpr size_t WS_LTOK = 2 * MiB;
constexpr size_t WS_LW = 6 * MiB;
constexpr size_t WS_WIN = 10 * MiB;
constexpr size_t WS_WPA = 44 * MiB, WS_WPB = 48 * MiB, WS_WOUT = 52 * MiB;
constexpr size_t WS_WD = 64 * MiB;
constexpr size_t WS_WGU = 320 * MiB;
constexpr size_t WS_MERGED = 832 * MiB;
constexpr size_t WS_X1B = 832 * MiB;
constexpr size_t WS_MERGED8 = 1760 * MiB;
constexpr size_t WS_Y = 320 * MiB;
constexpr size_t WS_H = 960 * MiB;
constexpr size_t WS_H8 = 1024 * MiB;
constexpr size_t WS_PROJ = 1088 * MiB;
constexpr size_t WS_QA = WS_PROJ, WS_KA = WS_PROJ + 64 * MiB, WS_VA = WS_PROJ + 80 * MiB, WS_QB = WS_PROJ + 96 * MiB, WS_KB = WS_PROJ + 160 * MiB, WS_VB = WS_PROJ + 224 * MiB, WS_G = WS_PROJ + 288 * MiB;
constexpr size_t WS_ACT = 1088 * MiB;
constexpr size_t WS_YA = 1632 * MiB, WS_YB = 1696 * MiB;
constexpr size_t WS_Q8 = 1824 * MiB;
constexpr size_t WS_K8 = 1856 * MiB;
constexpr size_t WS_VT8 = 1864 * MiB;
constexpr size_t WS_END = 1872 * MiB;
static_assert(WS_Y + (size_t)MAXT * 256 * 2048 * 2 <= WS_H && WS_ACT + (size_t)MAXT * 256 * 2048 * 2 <= WS_YA, "ws map");
static_assert(WS_Y + (size_t)MAXT * 256 * 2048 <= WS_X1B && WS_X1B + (size_t)NTOK * D * 2 <= WS_H, "ws map: fp8 Y below the bf16 residual stream");
constexpr int CW_TMO = 0, CW_CODE = 1;
constexpr int CW_BAR = 4096;
constexpr int CW_CNT = 16384;

constexpr int RING_OFF = 0, RING_BYTES = 131072;
constexpr int PART_OFF = 131072;
constexpr int ASG_OFF = 147456;
constexpr int TAB_OFF = 155648;
constexpr int HIST_OFF = 156672;
constexpr int MISC_OFF = 156928;
constexpr int LDS_BYTES = 157696;
constexpr int LDSCTL_OFF = HIST_OFF;

#define RLX_AGENT __ATOMIC_RELAXED, __HIP_MEMORY_SCOPE_AGENT
#define LDS_WAIT() asm volatile("s_waitcnt lgkmcnt(0)" ::: "memory")
#define VM_WAIT() asm volatile("s_waitcnt vmcnt(0)" ::: "memory")
__device__ __forceinline__ unsigned cvt_pk_bf16(float lo, float hi) { unsigned r; asm volatile("v_cvt_pk_bf16_f32 %0, %1, %2" : "=v"(r) : "v"(lo), "v"(hi)); return r; }
__device__ __forceinline__ unsigned f6_e2m3(float v) {
    const float y = fminf(__builtin_fabsf(v), 7.5f);
    const unsigned eb = __float_as_uint(fmaxf(y, 1.0f)) >> 23;
    const float q = __builtin_rintf(y * __uint_as_float((257u - eb) << 23));
    return ((unsigned)(int)q + 8u * eb - 1016u) | ((__float_as_uint(v) >> 26) & 32u);
}
__device__ __forceinline__ unsigned pk4_fp8(float a, float b, float c, float d) { int w = __builtin_amdgcn_cvt_pk_fp8_f32(a, b, 0, false); w = __builtin_amdgcn_cvt_pk_fp8_f32(c, d, w, true); return (unsigned)w; }
__device__ __forceinline__ int lane_now() { int l; asm volatile("v_mbcnt_lo_u32_b32 %0, -1, 0\n\tv_mbcnt_hi_u32_b32 %0, -1, %0" : "=v"(l)); return l; }
__device__ __forceinline__ float bf_lo(unsigned w) { return __uint_as_float(w << 16); }
__device__ __forceinline__ float bf_hi(unsigned w) { return __uint_as_float(w & 0xffff0000u); }
__device__ __forceinline__ float sigmoidf_(float x) { return __builtin_amdgcn_rcpf(1.0f + __builtin_amdgcn_exp2f(-1.4426950408889634f * x)); }

namespace pg8 {
constexpr int BM = 256, BK = 64, HALF = 128, HTB = HALF * BK * 2, STAGE_BYTES = 8 * HTB, NXCD = 8, WGM = 8;
__host__ __device__ __forceinline__ int lds_byte(int r, int c) { const int st = (r >> 4) * 2 + (c >> 5), rr = r & 15, cc = c & 31, ob = rr * 64 + cc * 2; return st * 1024 + (ob ^ (((ob >> 9) & 1) << 5)); }
__host__ __device__ __forceinline__ void stage_rc(int b, int& R, int& C) { const int st = b / 1024, sb = b % 1024, swz = sb ^ (((sb >> 9) & 1) << 5); R = (st >> 1) * 16 + swz / 64; C = (st & 1) * 32 + (swz % 64) / 2; }
__host__ __device__ __forceinline__ int perm32(int rho) { const int n = rho >> 4, i = rho & 15; return 8 * (i >> 2) + 4 * n + (i & 3); }

struct Unit { int pm, pn, e, cnt; };
struct Gemm { const void* A; const void* Bt; int rb; int sa, sb; long long dA = 0, dB = 0; };

__device__ __forceinline__ bool tile_order(int i, int G, int c, int nM, int nN, int& pm, int& pn) {
    const int nwg = nM * nN; const long L = (long)i * G + c; if (L >= nwg) return false;
    int wgid = (int)L; { const int q = nwg / NXCD, r = nwg % NXCD, xcd = wgid % NXCD, off = wgid / NXCD; wgid = (xcd < r ? xcd * (q + 1) : r * (q + 1) + (xcd - r) * q) + off; }
    const int nig = WGM * nN, gid = wgid / nig, fm = gid * WGM, gsz = (nM - fm) < WGM ? (nM - fm) : WGM;
    pm = fm + ((wgid % nig) % gsz); pn = (wgid % nig) / gsz; return true;
}
struct StaticOrder {
    int nM, nN, G, c;
    __device__ void init(int M, int N, int G_, int c_) { nM = M / BM; nN = N / BM; G = G_; c = c_; }
    __device__ __forceinline__ bool next(int i, Unit& u) const { u.e = 0; u.cnt = 256; return tile_order(i, G, c, nM, nN, u.pm, u.pn); }
    __device__ __forceinline__ void a_offs(const Gemm& g, const Unit& u, const int (&R)[2], const int (&C)[2], unsigned (&ao)[2][2]) const {
#pragma unroll
        for (int h = 0; h < 2; ++h)
#pragma unroll
            for (int i = 0; i < 2; ++i) ao[h][i] = (unsigned)((u.pm * BM + h * HALF + R[i]) * g.rb + C[i] * 2);
    }
    __device__ __forceinline__ const char* b_ptr(const Gemm& g, const Unit& u) const { return (const char*)g.Bt + (size_t)u.pn * BM * g.rb; }
};

template <class Epi, class Sched, bool ALIGN_EPI, bool FP8 = false, bool DUAL = false>
__device__ __forceinline__ void gemm_phase(LAS unsigned char* lds, const Gemm g, const Sched& S, const Epi& E, const int wid) {
    const int lane = lane_now(), tid = wid * 64 + lane, wr = wid >> 2, wc = wid & 3, fr = lane & 15, fq = lane >> 4;
    const int rb = g.rb, nt1 = rb / (BK * 2), nt = DUAL ? 2 * nt1 : nt1;
    unsigned voffB[2]; int RR[2], CC[2];
#pragma unroll
    for (int i = 0; i < 2; ++i) { int R, C; stage_rc(tid * 16 + i * 8192, R, C); const int Rb = Epi::PERM ? ((R & ~31) + perm32(R & 31)) : R;
        RR[i] = R; CC[i] = C; voffB[i] = (unsigned)(Rb * rb + C * 2); }
    const size_t kstep = (size_t)(BK * 2);
    const size_t hstep = (size_t)HALF * rb;
    const unsigned ldsw = (unsigned)wid * 1024u;
    const int aoff = lds_byte(wr * 64 + fr, fq * 8), boff = lds_byte(wc * 32 + fr, fq * 8);
#define PG8_SA(b, h) (((b) * 2 + (h)) * HTB)
#define PG8_SB(b, h) ((4 + (b) * 2 + (h)) * HTB)
#define PG8_STAGE(bufoff, gbase, voff) do { _Pragma("unroll") for (int _i = 0; _i < 2; ++_i) \
        __builtin_amdgcn_global_load_lds((const unsigned*)((const char*)(gbase) + (voff)[_i]), (LAS unsigned*)(lds + (bufoff) + ldsw + _i * 8192), 16, 0, 0); } while (0)
#define PG8_STAGE_A(bufoff, kb, ao, h) PG8_STAGE(bufoff, (const char*)g.A + (kb), (ao)[h])
#define PG8_LDA(dst, b, h) do { _Pragma("unroll") for (int m = 0; m < 4; ++m) { if constexpr (FP8) { const i32x4 lo_ = *(const LAS i32x4*)(lds + PG8_SA(b, h) + aoff + m * 2048), hi_ = *(const LAS i32x4*)(lds + PG8_SA(b, h) + aoff + m * 2048 + 1024); \
            dst##8[m] = __builtin_shufflevector(lo_, hi_, 0, 1, 2, 3, 4, 5, 6, 7); } else { _Pragma("unroll") for (int k = 0; k < 2; ++k) dst[m][k] = *(const LAS bf16x8*)(lds + PG8_SA(b, h) + aoff + m * 2048 + k * 1024); } } } while (0)
#define PG8_LDB(dst, b, h) do { _Pragma("unroll") for (int n = 0; n < 2; ++n) { if constexpr (FP8) { const i32x4 lo_ = *(const LAS i32x4*)(lds + PG8_SB(b, h) + boff + n * 2048), hi_ = *(const LAS i32x4*)(lds + PG8_SB(b, h) + boff + n * 2048 + 1024); \
            dst##8[n] = __builtin_shufflevector(lo_, hi_, 0, 1, 2, 3, 4, 5, 6, 7); } else { _Pragma("unroll") for (int k = 0; k < 2; ++k) dst[n][k] = *(const LAS bf16x8*)(lds + PG8_SB(b, h) + boff + n * 2048 + k * 1024); } } } while (0)
#define PG8_MMA(ai, bj, At, Bt) do { __builtin_amdgcn_s_setprio(1); if constexpr (FP8) { asm volatile("s_nop 1" ::: "memory"); }     \
          \
        _Pragma("unroll") for (int m_ = 0; m_ < 4; ++m_) _Pragma("unroll") for (int n_ = 0; n_ < 2; ++n_) { const int m = (bj) ? 3 - m_ : m_, n = (m_ & 1) ? 1 - n_ : n_; \
        if constexpr (FP8) { asm volatile("v_mfma_scale_f32_16x16x128_f8f6f4 %0, %1, %2, %0, %3, %4 op_sel_hi:[0,0,0]" : "+v"(acc[ai][bj][m][n]) : "v"(Bt##8[n]), "v"(At##8[m]), "v"(sclB), "v"(sclA)); } \
        else { _Pragma("unroll") for (int k = 0; k < 2; ++k) acc[ai][bj][m][n] = __builtin_amdgcn_mfma_f32_16x16x32_bf16(Bt[n][k], At[m][k], acc[ai][bj][m][n], 0, 0, 0); } } \
        __builtin_amdgcn_s_setprio(0); } while (0)
#define PG8_WAIT_V(n) asm volatile("s_waitcnt vmcnt(" #n ")" ::: "memory")
#define PG8_WAIT_L(n) asm volatile("s_waitcnt lgkmcnt(" #n ")" ::: "memory")
#define PG8_BAR __builtin_amdgcn_s_barrier()
#define PG8_SCHED __builtin_amdgcn_sched_barrier(0)
    Unit cur, nxt; int ui = 0;
    if (!S.next(0, cur)) return;
    f32x4 acc[2][2][4][2];
#pragma unroll
    for (int a = 0; a < 2; ++a)
#pragma unroll
        for (int b = 0; b < 2; ++b)
#pragma unroll
            for (int m = 0; m < 4; ++m)
#pragma unroll
                for (int n = 0; n < 2; ++n) acc[a][b][m][n] = (f32x4){0.f, 0.f, 0.f, 0.f};
    bf16x8 At[4][2], B0[2][2], B1[2][2]; i32x8 At8[4], B08[2], B18[2];
    int sclA = g.sa, sclB = g.sb; if constexpr (FP8) { asm volatile("" : "+v"(sclA), "+v"(sclB)); }
    unsigned aoC[2][2], aoN[2][2];
    S.a_offs(g, cur, RR, CC, aoC);
    const char* cB = S.b_ptr(g, cur);
    PG8_STAGE(PG8_SB(0, 0), cB, voffB); PG8_STAGE(PG8_SB(0, 1), cB + hstep, voffB); PG8_STAGE_A(PG8_SA(0, 0), 0, aoC, 0); PG8_STAGE_A(PG8_SA(0, 1), 0, aoC, 1);
    if (wr == 1) PG8_BAR;
    PG8_WAIT_V(2); PG8_BAR;
    PG8_STAGE(PG8_SB(1, 0), cB + kstep, voffB); PG8_STAGE_A(PG8_SA(1, 0), kstep, aoC, 0); PG8_STAGE(PG8_SB(1, 1), cB + hstep + kstep, voffB);
    PG8_WAIT_V(6); PG8_BAR;
    for (;;) {
        const bool has_next = S.next(ui + 1, nxt);
        const char* nB = cB;
#pragma unroll
        for (int h = 0; h < 2; ++h)
#pragma unroll
            for (int i = 0; i < 2; ++i) aoN[h][i] = aoC[h][i];
        if (has_next) { S.a_offs(g, nxt, RR, CC, aoN); nB = S.b_ptr(g, nxt); }
        for (int t = 0; t < nt; t += 2) {
            const bool last = (t == nt - 2);
            if constexpr (DUAL) { if (t == nt1) { asm volatile("s_nop 15\n\ts_nop 15" ::: "memory"); if (wr == 0) PG8_BAR; E.mid(acc, cur, wr, wc, fr, fq); asm volatile("s_nop 7" ::: "memory"); if (wr == 1) PG8_BAR; } }
            size_t k1 = (size_t)(t + 1) * kstep, kk2 = (size_t)(t + 2) * kstep, kb2 = kk2;
            if constexpr (DUAL) { if (t >= nt1) k1 = (size_t)g.dA + (size_t)(t + 1 - nt1) * kstep;
                                  if (t + 2 >= nt1) { kk2 = (size_t)g.dA + (size_t)(t + 2 - nt1) * kstep; kb2 = (size_t)g.dB + (size_t)(t + 2 - nt1) * kstep; } }
            const size_t k2 = last ? 0 : kk2, k3 = k2 + kstep;
            const char* b2 = last ? nB : cB + kb2; const char* b3 = b2 + kstep;
            unsigned ao2[2][2];
#pragma unroll
            for (int h = 0; h < 2; ++h)
#pragma unroll
                for (int i = 0; i < 2; ++i) ao2[h][i] = last ? aoN[h][i] : aoC[h][i];
            PG8_LDB(B0, 0, 0); PG8_LDB(B1, 0, 1); PG8_SCHED; PG8_LDA(At, 0, 0); PG8_STAGE_A(PG8_SA(1, 1), k1, aoC, 1);
            PG8_WAIT_V(8); PG8_WAIT_L(0); PG8_BAR; PG8_MMA(0, 0, At, B0); PG8_MMA(0, 1, At, B1); PG8_BAR; PG8_SCHED;
            PG8_LDA(At, 0, 1); PG8_STAGE(PG8_SB(0, 0), b2, voffB); PG8_STAGE(PG8_SB(0, 1), b2 + hstep, voffB); PG8_STAGE_A(PG8_SA(0, 0), k2, ao2, 0);
            PG8_WAIT_V(8); PG8_WAIT_L(0); PG8_BAR; PG8_MMA(1, 0, At, B0); PG8_MMA(1, 1, At, B1); PG8_BAR; PG8_SCHED;
            PG8_LDB(B0, 1, 0); PG8_LDB(B1, 1, 1); PG8_SCHED; PG8_LDA(At, 1, 0); PG8_STAGE_A(PG8_SA(0, 1), k2, ao2, 1);
            PG8_WAIT_V(8); PG8_WAIT_L(0); PG8_BAR; PG8_MMA(0, 0, At, B0); PG8_MMA(0, 1, At, B1); PG8_BAR; PG8_SCHED;
            PG8_LDA(At, 1, 1); PG8_STAGE(PG8_SB(1, 0), b3, voffB); PG8_STAGE(PG8_SB(1, 1), b3 + hstep, voffB); PG8_STAGE_A(PG8_SA(1, 0), k3, ao2, 0);
            PG8_WAIT_V(8); PG8_WAIT_L(0); PG8_BAR; PG8_MMA(1, 0, At, B0); PG8_MMA(1, 1, At, B1); PG8_BAR; PG8_SCHED;
        }
        if constexpr (FP8) { asm volatile("s_nop 15\n\ts_nop 15" ::: "memory"); }
        if constexpr (ALIGN_EPI) { if (wr == 0) PG8_BAR; }
        E(acc, cur, wr, wc, fr, fq);
        if (!has_next) break;
#pragma unroll
        for (int a = 0; a < 2; ++a)
#pragma unroll
            for (int b = 0; b < 2; ++b)
#pragma unroll
                for (int m = 0; m < 4; ++m)
#pragma unroll
                    for (int n = 0; n < 2; ++n) acc[a][b][m][n] = (f32x4){0.f, 0.f, 0.f, 0.f};
        cur = nxt; cB = nB; ++ui;
#pragma unroll
        for (int h = 0; h < 2; ++h)
#pragma unroll
            for (int i = 0; i < 2; ++i) aoC[h][i] = aoN[h][i];
        if constexpr (ALIGN_EPI) { if (wr == 1) PG8_BAR; }
    }
    PG8_WAIT_V(0);
    if constexpr (!ALIGN_EPI) { if (wr == 0) PG8_BAR; }
    PG8_BAR;
#undef PG8_SA
#undef PG8_SB
#undef PG8_STAGE
#undef PG8_STAGE_A
#undef PG8_LDA
#undef PG8_LDB
#undef PG8_MMA
#undef PG8_WAIT_V
#undef PG8_WAIT_L
#undef PG8_BAR
#undef PG8_SCHED
}

struct EpiBf16 {
    static constexpr bool PERM = true;
    bf16_t* O; int ldc;
    __device__ __forceinline__ void operator()(const f32x4 (&acc)[2][2][4][2], const Unit& u, int wr, int wc, int fr, int fq) const {
        const int row0 = u.pm * BM + wr * 64 + fr, col0 = u.pn * BM + wc * 32 + 8 * fq;
#pragma unroll
        for (int ai = 0; ai < 2; ++ai)
#pragma unroll
            for (int m = 0; m < 4; ++m) { bf16_t* rowp = O + (size_t)(row0 + ai * HALF + m * 16) * ldc + col0;
#pragma unroll
                for (int bj = 0; bj < 2; ++bj) { const f32x4 v0 = acc[ai][bj][m][0], v1 = acc[ai][bj][m][1];
                    u32x4 w; w.x = cvt_pk_bf16(v0[0], v0[1]); w.y = cvt_pk_bf16(v0[2], v0[3]); w.z = cvt_pk_bf16(v1[0], v1[1]); w.w = cvt_pk_bf16(v1[2], v1[3]);
                    *(u32x4*)(rowp + bj * HALF) = w; } }
    }
};
struct EpiProj {
    static constexpr bool PERM = true;
    unsigned char* ws;
    __device__ __forceinline__ void operator()(const f32x4 (&acc)[2][2][4][2], const Unit& u, int wr, int wc, int fr, int fq) const {
        const int pn = u.pn; size_t base; int H, h0; bool gate = false;
        if (pn < 4) { base = WS_QA; H = 8; h0 = 2 * pn; } else if (pn == 4) { base = WS_KA; H = 2; h0 = 0; } else if (pn == 5) { base = WS_VA; H = 2; h0 = 0; }
        else if (pn < 10) { base = WS_QB; H = 8; h0 = 2 * (pn - 6); } else if (pn < 14) { base = WS_KB; H = 8; h0 = 2 * (pn - 10); } else if (pn < 18) { base = WS_VB; H = 8; h0 = 2 * (pn - 14); }
        else { base = WS_G; H = 0; h0 = 0; gate = true; }
        const int row0 = u.pm * BM + wr * 64 + fr, cl = wc * 32 + 8 * fq;
        bf16_t* O = (bf16_t*)(ws + base); const size_t bjs = gate ? (size_t)HALF : (size_t)SEQ * HD;
        if (gate) O += (size_t)(pn - 18) * BM + cl; else O += (size_t)h0 * SEQ * HD + cl;
#pragma unroll
        for (int ai = 0; ai < 2; ++ai)
#pragma unroll
            for (int m = 0; m < 4; ++m) { const int r = row0 + ai * HALF + m * 16;
                bf16_t* rowp = O + (gate ? (size_t)r * 4096 : ((size_t)(r >> 14) * H * SEQ + (size_t)(r & (SEQ - 1))) * HD);
#pragma unroll
                for (int bj = 0; bj < 2; ++bj) { const f32x4 v0 = acc[ai][bj][m][0], v1 = acc[ai][bj][m][1];
                    if (gate) { u32x2 w8; w8.x = pk4_fp8(v0[0], v0[1], v0[2], v0[3]); w8.y = pk4_fp8(v1[0], v1[1], v1[2], v1[3]);
                        *(u32x2*)(ws + WS_G + (size_t)r * 4096 + (size_t)(pn - 18) * BM + cl + bj * HALF) = w8; }
                    else if (pn < 6) { u32x2 w8; w8.x = pk4_fp8(v0[0], v0[1], v0[2], v0[3]); w8.y = pk4_fp8(v1[0], v1[1], v1[2], v1[3]);
                        *(u32x2*)((unsigned char*)(ws + base) + (size_t)(rowp - (bf16_t*)(ws + base)) + bj * bjs) = w8; }
                    else { u32x4 w; w.x = cvt_pk_bf16(v0[0], v0[1]); w.y = cvt_pk_bf16(v0[2], v0[3]); w.z = cvt_pk_bf16(v1[0], v1[1]); w.w = cvt_pk_bf16(v1[2], v1[3]);
                        *(u32x4*)(rowp + bj * bjs) = w; } } }
    }
};
template <bool ADD> struct EpiGate {
    static constexpr bool PERM = true;
    bf16_t* O; unsigned char* O8; int ldc; const bf16_t* Gt; int ldg;
    __device__ __forceinline__ void operator()(const f32x4 (&acc)[2][2][4][2], const Unit& u, int wr, int wc, int fr, int fq) const {
        const int row0 = u.pm * BM + wr * 64 + fr, col0 = u.pn * BM + wc * 32 + 8 * fq;
#pragma unroll
        for (int ai = 0; ai < 2; ++ai)
#pragma unroll
            for (int m = 0; m < 4; ++m) { const size_t r = (size_t)(row0 + ai * HALF + m * 16);
#pragma unroll
                for (int bj = 0; bj < 2; ++bj) { const f32x4 v0 = acc[ai][bj][m][0], v1 = acc[ai][bj][m][1];
                    const u32x4 gw = *(const u32x4*)(Gt + r * ldg + col0 + bj * HALF);
                    bf16_t* op = O + r * ldc + col0 + bj * HALF;
                    float o[8] = {0.f, 0.f, 0.f, 0.f, 0.f, 0.f, 0.f, 0.f};
                    if (ADD) { const u32x4 ow = *(const u32x4*)op; o[0] = bf_lo(ow.x); o[1] = bf_hi(ow.x); o[2] = bf_lo(ow.y); o[3] = bf_hi(ow.y); o[4] = bf_lo(ow.z); o[5] = bf_hi(ow.z); o[6] = bf_lo(ow.w); o[7] = bf_hi(ow.w); }
                    o[0] += sigmoidf_(bf_lo(gw.x)) * v0[0]; o[1] += sigmoidf_(bf_hi(gw.x)) * v0[1]; o[2] += sigmoidf_(bf_lo(gw.y)) * v0[2]; o[3] += sigmoidf_(bf_hi(gw.y)) * v0[3];
                    o[4] += sigmoidf_(bf_lo(gw.z)) * v1[0]; o[5] += sigmoidf_(bf_hi(gw.z)) * v1[1]; o[6] += sigmoidf_(bf_lo(gw.w)) * v1[2]; o[7] += sigmoidf_(bf_hi(gw.w)) * v1[3];
                    if (ADD) { u32x2 w; w.x = pk4_fp8(o[0] * F8_MMUL, o[1] * F8_MMUL, o[2] * F8_MMUL, o[3] * F8_MMUL); w.y = pk4_fp8(o[4] * F8_MMUL, o[5] * F8_MMUL, o[6] * F8_MMUL, o[7] * F8_MMUL);
                        *(u32x2*)(O8 + r * ldc + col0 + bj * HALF) = w; }
                    else { u32x4 w; w.x = cvt_pk_bf16(o[0], o[1]); w.y = cvt_pk_bf16(o[2], o[3]); w.z = cvt_pk_bf16(o[4], o[5]); w.w = cvt_pk_bf16(o[6], o[7]);
                        *(u32x4*)op = w; } } }
    }
};
struct EpiGateDual {
    static constexpr bool PERM = true;
    static constexpr int LDC = 2048, LDG = 4096;
    unsigned char* O8; const unsigned char* Gt;
    static __device__ __forceinline__ float eneg(float g) { return __builtin_amdgcn_exp2f(-1.4426950408889634f * g); }
    static __device__ __forceinline__ float clampb(float g) { return fmaxf(g, -30.0f); }
#define GD8(w, b) __builtin_amdgcn_cvt_f32_fp8((int)(w), b)
    __device__ __forceinline__ void mid(f32x4 (&acc)[2][2][4][2], const Unit& u, int wr, int wc, int fr, int fq) const {
        unsigned gb0 = (unsigned)((u.pm * BM + wr * 64 + fr) * LDG + u.pn * BM + wc * 32 + 8 * fq);
        asm volatile("" : "+v"(gb0));
        const unsigned char* gt = Gt;
#pragma unroll
        for (int ai = 0; ai < 2; ++ai)
#pragma unroll
            for (int m = 0; m < 4; ++m)
#pragma unroll
                for (int bj = 0; bj < 2; ++bj) { const unsigned off = gb0 + (unsigned)((ai * HALF + m * 16) * LDG + bj * HALF);
                    const u32x2 ga = *(const u32x2*)(gt + off), gb = *(const u32x2*)(gt + off + 2048u);
#define GDR(wa, wb, b) ((1.0f + eneg(clampb(GD8(wb, b)))) * __builtin_amdgcn_rcpf(1.0f + eneg(GD8(wa, b))))
                    acc[ai][bj][m][0][0] *= GDR(ga.x, gb.x, 0); acc[ai][bj][m][0][1] *= GDR(ga.x, gb.x, 1); acc[ai][bj][m][0][2] *= GDR(ga.x, gb.x, 2); acc[ai][bj][m][0][3] *= GDR(ga.x, gb.x, 3);
                    acc[ai][bj][m][1][0] *= GDR(ga.y, gb.y, 0); acc[ai][bj][m][1][1] *= GDR(ga.y, gb.y, 1); acc[ai][bj][m][1][2] *= GDR(ga.y, gb.y, 2); acc[ai][bj][m][1][3] *= GDR(ga.y, gb.y, 3);
#undef GDR
                }
    }
    __device__ __forceinline__ void operator()(const f32x4 (&acc)[2][2][4][2], const Unit& u, int wr, int wc, int fr, int fq) const {
        unsigned rc0 = (unsigned)((u.pm * BM + wr * 64 + fr) * LDC + u.pn * BM + wc * 32 + 8 * fq);
        asm volatile("" : "+v"(rc0));
        const unsigned row0 = rc0 / LDC, col0 = rc0 % LDC;
        const unsigned char* gt = Gt;
#pragma unroll
        for (int ai = 0; ai < 2; ++ai)
#pragma unroll
            for (int m = 0; m < 4; ++m) { const unsigned r = row0 + ai * HALF + m * 16;
#pragma unroll
                for (int bj = 0; bj < 2; ++bj) { const f32x4 v0 = acc[ai][bj][m][0], v1 = acc[ai][bj][m][1];
                    const u32x2 gw = *(const u32x2*)(gt + (r * LDG + 2048u + col0 + bj * HALF));
                    float o[8];
                    o[0] = sigmoidf_(clampb(GD8(gw.x, 0))) * v0[0]; o[1] = sigmoidf_(clampb(GD8(gw.x, 1))) * v0[1]; o[2] = sigmoidf_(clampb(GD8(gw.x, 2))) * v0[2]; o[3] = sigmoidf_(clampb(GD8(gw.x, 3))) * v0[3];
                    o[4] = sigmoidf_(clampb(GD8(gw.y, 0))) * v1[0]; o[5] = sigmoidf_(clampb(GD8(gw.y, 1))) * v1[1]; o[6] = sigmoidf_(clampb(GD8(gw.y, 2))) * v1[2]; o[7] = sigmoidf_(clampb(GD8(gw.y, 3))) * v1[3];
                    u32x2 w; w.x = pk4_fp8(o[0] * F8_MMUL, o[1] * F8_MMUL, o[2] * F8_MMUL, o[3] * F8_MMUL); w.y = pk4_fp8(o[4] * F8_MMUL, o[5] * F8_MMUL, o[6] * F8_MMUL, o[7] * F8_MMUL);
                    *(u32x2*)(O8 + (r * LDC + col0 + bj * HALF)) = w; } }
    }
#undef GD8
};
struct EpiResid {
    static constexpr bool PERM = false;
    const float* base; float* out; int ldc;
    __device__ __forceinline__ void operator()(const f32x4 (&acc)[2][2][4][2], const Unit& u, int wr, int wc, int fr, int fq) const {
        const int row0 = u.pm * BM + wr * 64 + fr, col0 = u.pn * BM + wc * 32 + 4 * fq;
#pragma unroll
        for (int ai = 0; ai < 2; ++ai)
#pragma unroll
            for (int m = 0; m < 4; ++m) { const size_t off = (size_t)(row0 + ai * HALF + m * 16) * ldc + col0;
#pragma unroll
                for (int bj = 0; bj < 2; ++bj)
#pragma unroll
                    for (int n = 0; n < 2; ++n) { const f32x4 b = *(const f32x4*)(base + off + bj * HALF + n * 16); *(f32x4*)(out + off + bj * HALF + n * 16) = b + acc[ai][bj][m][n]; } }
    }
};
struct EpiResidB {
    static constexpr bool PERM = true;
    const float* base; bf16_t* out; int ldc;
    __device__ __forceinline__ void operator()(const f32x4 (&acc)[2][2][4][2], const Unit& u, int wr, int wc, int fr, int fq) const {
        const int row0 = u.pm * BM + wr * 64 + fr, col0 = u.pn * BM + wc * 32 + 8 * fq;
#pragma unroll
        for (int ai = 0; ai < 2; ++ai)
#pragma unroll
            for (int m = 0; m < 4; ++m) { const size_t off = (size_t)(row0 + ai * HALF + m * 16) * ldc + col0;
#pragma unroll
                for (int bj = 0; bj < 2; ++bj) { const f32x4 v0 = *(const f32x4*)(base + off + bj * HALF) + acc[ai][bj][m][0], v1 = *(const f32x4*)(base + off + bj * HALF + 4) + acc[ai][bj][m][1];
                    u32x4 w; w.x = cvt_pk_bf16(v0[0], v0[1]); w.y = cvt_pk_bf16(v0[2], v0[3]); w.z = cvt_pk_bf16(v1[0], v1[1]); w.w = cvt_pk_bf16(v1[2], v1[3]);
                    *(u32x4*)(out + off + bj * HALF) = w; } }
    }
};
struct EpiSwiglu {
    static constexpr bool PERM = true;
    unsigned char* act; const float* bg; const float* bu;
    __device__ __forceinline__ void operator()(const f32x4 (&acc)[2][2][4][2], const Unit& u, int wr, int wc, int fr, int fq) const {
        const int row0 = u.pm * BM + wr * 64 + fr, j0 = u.pn * HALF + wc * 32 + 8 * fq;
        const f32x4 g0 = *(const f32x4*)(bg + (size_t)u.e * DE + j0), g1 = *(const f32x4*)(bg + (size_t)u.e * DE + j0 + 4);
        const f32x4 u0 = *(const f32x4*)(bu + (size_t)u.e * DE + j0), u1 = *(const f32x4*)(bu + (size_t)u.e * DE + j0 + 4);
#pragma unroll
        for (int ai = 0; ai < 2; ++ai)
#pragma unroll
            for (int m = 0; m < 4; ++m) {
                float o[8];
#pragma unroll
                for (int n = 0; n < 2; ++n)
#pragma unroll
                    for (int i = 0; i < 4; ++i) {
                        float gt = acc[ai][0][m][n][i] + (n ? g1[i] : g0[i]), up = acc[ai][1][m][n][i] + (n ? u1[i] : u0[i]);
                        gt = fminf(gt, 7.0f); up = fminf(fmaxf(up, -7.0f), 7.0f);
                        o[n * 4 + i] = gt * sigmoidf_(1.702f * gt) * (up + 1.0f); }
                u32x2 w; w.x = pk4_fp8(o[0], o[1], o[2], o[3]); w.y = pk4_fp8(o[4], o[5], o[6], o[7]);
                *(u32x2*)(act + (size_t)(row0 + ai * HALF + m * 16) * DE + j0) = w; }
    }
};
struct EpiDown {
    static constexpr bool PERM = true;
    unsigned char* Y; const float* bd; const float* lw; const LAS int* tstart;
    __device__ __forceinline__ void operator()(const f32x4 (&acc)[2][2][4][2], const Unit& u, int wr, int wc, int fr, int fq) const {
        const int rl0 = wr * 64 + fr, col0 = u.pn * BM + wc * 32 + 8 * fq;
        const int lt = u.pm - tstart[u.e];
        f32x4 bv[2][2];
#pragma unroll
        for (int bj = 0; bj < 2; ++bj)
#pragma unroll
            for (int n = 0; n < 2; ++n) bv[bj][n] = *(const f32x4*)(bd + (size_t)u.e * D + col0 + bj * HALF + 4 * n);
#pragma unroll
        for (int ai = 0; ai < 2; ++ai)
#pragma unroll
            for (int m = 0; m < 4; ++m) { const int rl = rl0 + ai * HALF + m * 16;
                const float wl = lw[(size_t)u.e * LCAP + lt * 256 + (rl < u.cnt ? rl : u.cnt - 1)]; const float w = rl < u.cnt ? wl : 0.f;
                unsigned char* rowp = Y + (size_t)(u.pm * BM + rl) * D + col0; const float w16 = w * 16.0f;
#pragma unroll
                for (int bj = 0; bj < 2; ++bj) { const f32x4 v0 = (acc[ai][bj][m][0] + bv[bj][0]) * w16, v1 = (acc[ai][bj][m][1] + bv[bj][1]) * w16;
                    u32x2 q; q.x = pk4_fp8(v0[0], v0[1], v0[2], v0[3]); q.y = pk4_fp8(v1[0], v1[1], v1[2], v1[3]);
                    *(u32x2*)(rowp + bj * HALF) = q; } }
    }
};
struct MoeOrder {
    const LAS int* cnt; const LAS int* tstart; const LAS unsigned char* tile_e; int TT, NC, G, c;
    const int* ltok; bool gather; size_t brows;
    __device__ __forceinline__ bool next(int i, Unit& u) const {
        if (!tile_order(i, G, c, TT, NC, u.pm, u.pn)) return false;
        u.e = tile_e[u.pm]; const int lt = u.pm - tstart[u.e]; const int rem = cnt[u.e] - lt * 256; u.cnt = rem < 256 ? rem : 256; return true;
    }
    __device__ __forceinline__ void a_offs(const Gemm& g, const Unit& u, const int (&R)[2], const int (&C)[2], unsigned (&ao)[2][2]) const {
        const int lt = u.pm - tstart[u.e];
#pragma unroll
        for (int h = 0; h < 2; ++h)
#pragma unroll
            for (int i = 0; i < 2; ++i) {
                int row;
                if (gather) { int rl = h * HALF + R[i]; rl = rl < u.cnt ? rl : u.cnt - 1;
                    row = ltok[(size_t)u.e * LCAP + lt * 256 + rl]; }
                else row = u.pm * BM + h * HALF + R[i];
                ao[h][i] = (unsigned)(row * g.rb + C[i] * 2); }
    }
    __device__ __forceinline__ const char* b_ptr(const Gemm& g, const Unit& u) const { return (const char*)g.Bt + ((size_t)u.e * brows + (size_t)u.pn * BM) * g.rb; }
};
}

namespace att {
constexpr int NW = 8, QBLK = 32, KVBLK = 64;
constexpr float SCALE = 0.088388347648318440f;
constexpr float THR = 8.f;
constexpr float QMUL = 0.088388347648318440f * 1.4426950408889634f * 16.0f;
constexpr float PTHR = 0.75f, PHEAD0 = 2.0f, PHEAD = 1.0f;
constexpr float KMUL = 2.0f, VMUL = 2.0f;
constexpr size_t SHM_V = KVBLK * HD * 2, SHM_K = KVBLK * HD * 2, SHM_ATTN = 2 * SHM_V + 2 * SHM_K + NW * 64 * 4;
constexpr int BIAS_OFF = 67584;
#define KSWZ(row, colB) ((row) * 256 + ((colB) ^ (((row) & 15) << 4)))
#define SBAR() __builtin_amdgcn_sched_barrier(0)
__device__ __forceinline__ int crow(int r, int hi) { return (r & 3) + 8 * (r >> 2) + 4 * hi; }
__device__ __forceinline__ unsigned cvtpk(float lo, float hi) { unsigned r; asm volatile("v_cvt_pk_bf16_f32 %0, %1, %2" : "=v"(r) : "v"(lo), "v"(hi)); return r; }
__device__ __forceinline__ bf16x8 ld8(const bf16_t* p) { return *reinterpret_cast<const bf16x8*>(p); }

__device__ __forceinline__ void partialSM(f32x16& p0, f32x16& p1, float& m_reg, float& mn, float& alpha) {
  constexpr float C = SCALE * 1.4426950408889634f;
  float pmax = p0[0]; for (int r = 1; r < 16; ++r) pmax = fmaxf(pmax, p0[r]); for (int r = 0; r < 16; ++r) pmax = fmaxf(pmax, p1[r]);
  { auto rr = __builtin_amdgcn_permlane32_swap(__float_as_uint(pmax), __float_as_uint(pmax), false, false);
    pmax = fmaxf(__uint_as_float(rr[0]), __uint_as_float(rr[1])); }
  if (__builtin_expect(__all(pmax - m_reg <= THR / SCALE), 1)) { mn = m_reg; alpha = 1.f; }
  else { mn = fmaxf(m_reg, pmax); alpha = __builtin_amdgcn_exp2f((m_reg - mn) * C); m_reg = mn; }
  float mnC = -mn * C;
  for (int r = 0; r < 16; ++r) p0[r] = fmaf(p0[r], C, mnC); for (int r = 0; r < 16; ++r) p1[r] = fmaf(p1[r], C, mnC);
  for (int r = 0; r < 16; ++r) p0[r] = __builtin_amdgcn_exp2f(p0[r]);
}
__device__ __forceinline__ void finishSM(f32x16& p0, f32x16& p1, float alpha, float& l_reg, bf16x8& pa0, bf16x8& pa1, bf16x8& pa2, bf16x8& pa3) {
  for (int r = 0; r < 16; ++r) p1[r] = __builtin_amdgcn_exp2f(p1[r]);
  float ps = 0; for (int r = 0; r < 16; ++r) ps += p0[r]; for (int r = 0; r < 16; ++r) ps += p1[r];
  { auto rr = __builtin_amdgcn_permlane32_swap(__float_as_uint(ps), __float_as_uint(ps), false, false);
    ps = __uint_as_float(rr[0]) + __uint_as_float(rr[1]); }
  l_reg = l_reg * alpha + ps;
#define PK4(P, BASE, OUT) do { unsigned a0 = cvtpk(P[BASE + 0], P[BASE + 1]), a1 = cvtpk(P[BASE + 2], P[BASE + 3]);   \
    unsigned b0 = cvtpk(P[BASE + 4], P[BASE + 5]), b1 = cvtpk(P[BASE + 6], P[BASE + 7]);                              \
    auto r0 = __builtin_amdgcn_permlane32_swap(a0, b0, false, false); auto r1 = __builtin_amdgcn_permlane32_swap(a1, b1, false, false); \
    u32x4 w = {r0[0], r1[0], r0[1], r1[1]}; OUT = *reinterpret_cast<bf16x8*>(&w); } while (0)
  PK4(p0, 0, pa0); PK4(p0, 8, pa1); PK4(p1, 0, pa2); PK4(p1, 8, pa3);
#undef PK4
}
__device__ __forceinline__ void qkt(f32x16& p0, f32x16& p1, const bf16_t* Ks, const bf16x8* qr, int r32, int hi) {
  p0 = f32x16{}; p1 = f32x16{};
  for (int d0 = 0; d0 < 8; ++d0) { int cb = (d0 * 16 + hi * 8) * 2;
    bf16x8 b0 = *reinterpret_cast<const bf16x8*>((const char*)Ks + KSWZ(r32, cb));
    bf16x8 b1 = *reinterpret_cast<const bf16x8*>((const char*)Ks + KSWZ(32 + r32, cb));
    p0 = __builtin_amdgcn_mfma_f32_32x32x16_bf16(b0, qr[d0], p0, 0, 0, 0);
    p1 = __builtin_amdgcn_mfma_f32_32x32x16_bf16(b1, qr[d0], p1, 0, 0, 0); }
}
__device__ __forceinline__ int v_st(int k, int c) { const int kk = (k & ~0xC) | ((k & 4) << 1) | ((k & 8) >> 1); return ((kk >> 3) * 4 + (c >> 5)) * 512 + ((kk & 7) * 32 + (c & 31)) * 2; }
__device__ __forceinline__ int v_rd_base(int lane) { return ((lane & 3) << 3) | (((lane >> 2) & 3) << 6) | (((lane >> 4) & 1) << 5) | (((lane >> 5) & 1) << 8); }
constexpr int v_rd_off(int d0, int ks, int half) { return d0 * 512 + ks * 4096 + half * 2048; }
template <int OFF> __device__ __forceinline__ s16x4 tr_read(int vb) {
  s16x4 r; asm volatile("ds_read_b64_tr_b16 %0, %1 offset:%2" : "=&v"(r) : "v"(vb), "i"(OFF) : "memory"); return r;
}
template <int D0> __device__ __forceinline__ void pv_one(f32x16& od, int vb, bf16x8 pa0, bf16x8 pa1, bf16x8 pa2, bf16x8 pa3) {
  const s16x4 l0 = tr_read<v_rd_off(D0, 0, 0)>(vb), h0 = tr_read<v_rd_off(D0, 0, 1)>(vb), l1 = tr_read<v_rd_off(D0, 1, 0)>(vb), h1 = tr_read<v_rd_off(D0, 1, 1)>(vb);
  const s16x4 l2 = tr_read<v_rd_off(D0, 2, 0)>(vb), h2 = tr_read<v_rd_off(D0, 2, 1)>(vb), l3 = tr_read<v_rd_off(D0, 3, 0)>(vb), h3 = tr_read<v_rd_off(D0, 3, 1)>(vb);
  asm volatile("s_waitcnt lgkmcnt(0)" ::: "memory"); SBAR();
#define PK(L, H) (bf16x8){L[0], L[1], L[2], L[3], H[0], H[1], H[2], H[3]}
  od = __builtin_amdgcn_mfma_f32_32x32x16_bf16(pa0, PK(l0, h0), od, 0, 0, 0);
  od = __builtin_amdgcn_mfma_f32_32x32x16_bf16(pa1, PK(l1, h1), od, 0, 0, 0);
  od = __builtin_amdgcn_mfma_f32_32x32x16_bf16(pa2, PK(l2, h2), od, 0, 0, 0);
  od = __builtin_amdgcn_mfma_f32_32x32x16_bf16(pa3, PK(l3, h3), od, 0, 0, 0);
#undef PK
}
__device__ __forceinline__ void pv_d0(f32x16* o, int vb, bf16x8 pa0, bf16x8 pa1, bf16x8 pa2, bf16x8 pa3) {
  pv_one<0>(o[0], vb, pa0, pa1, pa2, pa3); pv_one<1>(o[1], vb, pa0, pa1, pa2, pa3); pv_one<2>(o[2], vb, pa0, pa1, pa2, pa3); pv_one<3>(o[3], vb, pa0, pa1, pa2, pa3);
}
struct NoMask { __device__ __forceinline__ void operator()(f32x16&, f32x16&, int) const {} };
struct NaMask {
  const float* bias; int kr0, rq, c, cs, hi;
  __device__ __forceinline__ void operator()(f32x16& p0, f32x16& p1, int j) const {
    const int kr = kr0 + j; int rs = rq - 4; rs = rs < 0 ? 0 : (rs > ROWS - 8 ? ROWS - 8 : rs);
    const bool vrow = (kr >= rs) && (kr < rs + 8);
    int ro = kr - rq + 7; ro = ro < 0 ? 0 : (ro > 14 ? 14 : ro);
    const float* br = bias + ro * 32; const float ninf = -__builtin_inff();
#pragma unroll
    for (int r = 0; r < 16; ++r) { const int kc = crow(r, hi);
      { const bool v = vrow && ((unsigned)(kc - cs) < 16u); const int co = v ? (kc - c + 15) : 0; const float b = br[co]; p0[r] = v ? p0[r] + b : ninf; }
      { const int kc1 = kc + 32; const bool v = vrow && ((unsigned)(kc1 - cs) < 16u); const int co = v ? (kc1 - c + 15) : 0; const float b = br[co]; p1[r] = v ? p1[r] + b : ninf; } }
  }
};

template <int LDQ, int LDK, int LDO, class Mask>
__device__ __forceinline__ void attn_body(const bf16_t* __restrict__ Qb, const bf16_t* __restrict__ Kh, const bf16_t* __restrict__ Vh,
                                          unsigned char* __restrict__ Ob, int seq, char* lds, const Mask& MK, const int wid) {
  const int lane = lane_now(), tid = wid * 64 + lane, r32 = lane & 31, hi = lane >> 5;
  bf16_t* V_lds = (bf16_t*)lds; bf16_t* K_lds = (bf16_t*)(lds + 2 * SHM_V);
  float* ws = (float*)(lds + 2 * SHM_V + 2 * SHM_K) + wid * 64; float* li_l = ws; float* al_l = ws + 32;
  float m_reg = -1e30f, l_reg = 0; f32x16 o[4] = {}; bf16x8 qr[8];
  const bf16_t* Qw = Qb + (long)(wid * QBLK + r32) * LDQ + hi * 8;
#pragma unroll
  for (int d0 = 0; d0 < 8; ++d0) qr[d0] = ld8(Qw + d0 * 16);
  const int sr = tid >> 4, sc = (tid & 15) * 8, vst0 = v_st(sr, sc), vst1 = v_st(32 + sr, sc);
  const unsigned lo0 = (unsigned)(sr * LDK + sc) * 2u, lo1 = lo0 + 32u * LDK * 2u;
  const int vb0 = (int)(uintptr_t)V_lds + v_rd_base(lane);
  constexpr int SDEPTH = 2;
  struct { bf16x8 vs0, vs1, ks0, ks1; } sr_[SDEPTH];
#define SLOAD(i, k0) do { const char* kb_ = (const char*)Kh + (size_t)(k0) * (LDK * 2); const char* vb_ = (const char*)Vh + (size_t)(k0) * (LDK * 2); \
    sr_[i].vs0 = *(const bf16x8*)(vb_ + lo0); sr_[i].vs1 = *(const bf16x8*)(vb_ + 32 * LDK * 2 + lo0); \
    sr_[i].ks0 = *(const bf16x8*)(kb_ + lo0); sr_[i].ks1 = *(const bf16x8*)(kb_ + 32 * LDK * 2 + lo0); } while (0)
#define SWRITE(b, i) do { *(bf16x8*)((char*)V_lds + (b) * SHM_V + vst0) = sr_[i].vs0;          \
    *(bf16x8*)((char*)V_lds + (b) * SHM_V + vst1) = sr_[i].vs1; int kc = sc * 2;               \
    *(bf16x8*)((char*)K_lds + (b) * SHM_K + KSWZ(sr, kc)) = sr_[i].ks0;                       \
    *(bf16x8*)((char*)K_lds + (b) * SHM_K + KSWZ(32 + sr, kc)) = sr_[i].ks1; } while (0)
#define SWAIT() do { if constexpr (SDEPTH == 2) asm volatile("s_waitcnt vmcnt(4)" ::: "memory"); else asm volatile("s_waitcnt vmcnt(0)" ::: "memory"); } while (0)
#define RESC(a) do { if (__any((a) < 1.f)) { const int ln_ = lane_now(), r32_ = ln_ & 31, hi_ = ln_ >> 5; float* al2_ = (float*)(lds + 2 * SHM_V + 2 * SHM_K) + wid * 64 + 32; \
    if (hi_ == 0) al2_[r32_] = (a); asm volatile("s_waitcnt lgkmcnt(0)" ::: "memory"); \
    for (int d = 0; d < 4; ++d) for (int r = 0; r < 16; ++r) o[d][r] *= al2_[crow(r, hi_)]; } } while (0)
  f32x16 pA0, pA1, pB0, pB1; float mnA, mnB, alA, alB; bf16x8 pa0, pa1, pa2, pa3; const int NT = seq / KVBLK;
  constexpr int SE = 0, SO = SDEPTH - 1;
  SLOAD(SE, 0); asm volatile("s_waitcnt vmcnt(0)" ::: "memory"); SWRITE(0, SE); __syncthreads();
  qkt(pA0, pA1, K_lds, qr, r32, hi); MK(pA0, pA1, 0); partialSM(pA0, pA1, m_reg, mnA, alA);
  SLOAD(SO, KVBLK); if constexpr (SDEPTH == 2) { if (2 < NT) SLOAD(SE, 2 * KVBLK); }
  SWAIT(); SWRITE(1, SO); __syncthreads();
  for (int j = 1; j + 1 < NT; j += 2) {
    SBAR(); qkt(pB0, pB1, (bf16_t*)((char*)K_lds + SHM_K), qr, r32, hi); MK(pB0, pB1, j);
    finishSM(pA0, pA1, alA, l_reg, pa0, pa1, pa2, pa3); SBAR();
    SLOAD(SO, (j + SDEPTH) * KVBLK); SBAR();
    pv_d0(o, vb0, pa0, pa1, pa2, pa3); partialSM(pB0, pB1, m_reg, mnB, alB);
    __syncthreads(); SWAIT(); SWRITE(0, SE);
    RESC(alB); __syncthreads();
    SBAR(); qkt(pA0, pA1, K_lds, qr, r32, hi); MK(pA0, pA1, j + 1);
    finishSM(pB0, pB1, alB, l_reg, pa0, pa1, pa2, pa3); SBAR();
    if (SDEPTH == 1 || j + 3 < NT) SLOAD(SE, (j + 1 + SDEPTH) * KVBLK); SBAR();
    pv_d0(o, vb0 + (int)SHM_V, pa0, pa1, pa2, pa3); partialSM(pA0, pA1, m_reg, mnA, alA);
    __syncthreads(); SWAIT(); SWRITE(1, SO);
    RESC(alA); __syncthreads();
  }
  SBAR(); qkt(pB0, pB1, (bf16_t*)((char*)K_lds + SHM_K), qr, r32, hi); MK(pB0, pB1, NT - 1);
  finishSM(pA0, pA1, alA, l_reg, pa0, pa1, pa2, pa3); SBAR();
  pv_d0(o, vb0, pa0, pa1, pa2, pa3); partialSM(pB0, pB1, m_reg, mnB, alB);
  __syncthreads(); RESC(alB);
  finishSM(pB0, pB1, alB, l_reg, pa0, pa1, pa2, pa3); SBAR();
  pv_d0(o, vb0 + (int)SHM_V, pa0, pa1, pa2, pa3);
  if (hi == 0) li_l[r32] = l_reg; asm volatile("s_waitcnt lgkmcnt(0)" ::: "memory");
  float rli[16];
#pragma unroll
  for (int r = 0; r < 16; ++r) rli[r] = __builtin_amdgcn_rcpf(li_l[crow(r, hi)]) * F8_YMUL;
  unsigned char* Ow = Ob + (long)(wid * QBLK) * LDO; const unsigned lane_off = (unsigned)(4 * hi * LDO + r32);
#pragma unroll
  for (int r = 0; r < 16; ++r) { unsigned char* rowb = Ow + ((r & 3) + 8 * (r >> 2)) * LDO;
#pragma unroll
    for (int d0 = 0; d0 < 4; ++d0) { const float v = o[d0][r] * rli[r]; rowb[lane_off + d0 * 32] = (unsigned char)(__builtin_amdgcn_cvt_pk_fp8_f32(v, v, 0, false) & 0xff); } }
#undef SLOAD
#undef SWRITE
#undef SWAIT
#undef RESC
}

template <int LDQ, int LDK, int LDO, class Mask>
__device__ __forceinline__ void attn_body_simple(const bf16_t* __restrict__ Qb, const bf16_t* __restrict__ Kh, const bf16_t* __restrict__ Vh,
                                                 unsigned char* __restrict__ Ob, int NT, char* lds, const Mask& MK, const int wid, const float* __restrict__ gq, const float* __restrict__ gk) {
  const int lane = lane_now(), tid = wid * 64 + lane, r32 = lane & 31, hi = lane >> 5;
  bf16_t* V_lds = (bf16_t*)lds; bf16_t* K_lds = (bf16_t*)(lds + 2 * SHM_V);
  float* ws = (float*)(lds + 2 * SHM_V + 2 * SHM_K) + wid * 64; float* li_l = ws; float* al_l = ws + 32;
  float m_reg = -1e30f, l_reg = 0; f32x16 o[4] = {}; bf16x8 qr[8];
  const bf16_t* Qw = Qb + (long)(wid * QBLK + r32) * LDQ + hi * 8;
#pragma unroll
  for (int d0 = 0; d0 < 8; ++d0) qr[d0] = ld8(Qw + d0 * 16);
  { float ss = 0.f;
#pragma unroll
    for (int d0 = 0; d0 < 8; ++d0) { const u32x4 w = __builtin_bit_cast(u32x4, qr[d0]); const float a0 = bf_lo(w.x), a1 = bf_hi(w.x), a2 = bf_lo(w.y), a3 = bf_hi(w.y), a4 = bf_lo(w.z), a5 = bf_hi(w.z), a6 = bf_lo(w.w), a7 = bf_hi(w.w);
        ss += (a0 * a0 + a1 * a1) + (a2 * a2 + a3 * a3) + (a4 * a4 + a5 * a5) + (a6 * a6 + a7 * a7); }
    { auto rr = __builtin_amdgcn_permlane32_swap(__float_as_uint(ss), __float_as_uint(ss), false, false); ss = __uint_as_float(rr[0]) + __uint_as_float(rr[1]); }
    const float rstd = 1.0f / sqrtf(ss * (1.f / 128.f) + EPS);
#pragma unroll
    for (int d0 = 0; d0 < 8; ++d0) { const u32x4 w = __builtin_bit_cast(u32x4, qr[d0]); const f32x4 g0 = *(const f32x4*)(gq + d0 * 16 + hi * 8), g1 = *(const f32x4*)(gq + d0 * 16 + hi * 8 + 4);
        u32x4 o; o.x = cvtpk(bf_lo(w.x) * rstd * g0.x, bf_hi(w.x) * rstd * g0.y); o.y = cvtpk(bf_lo(w.y) * rstd * g0.z, bf_hi(w.y) * rstd * g0.w);
        o.z = cvtpk(bf_lo(w.z) * rstd * g1.x, bf_hi(w.z) * rstd * g1.y); o.w = cvtpk(bf_lo(w.w) * rstd * g1.z, bf_hi(w.w) * rstd * g1.w); qr[d0] = __builtin_bit_cast(bf16x8, o); } }
  const int sr = tid >> 4, sc = (tid & 15) * 8, vst0 = v_st(sr, sc), vst1 = v_st(32 + sr, sc);
  const unsigned lo0 = (unsigned)(sr * LDK + sc) * 2u, lo1 = lo0 + 32u * LDK * 2u;
  const int vb0 = (int)(uintptr_t)V_lds + v_rd_base(lane);
  const f32x4 gk0 = *(const f32x4*)(gk + sc), gk1 = *(const f32x4*)(gk + sc + 4);
  bf16x8 vs0, vs1, ks0, ks1;
#define KNORM(kv) do { const u32x4 w_ = __builtin_bit_cast(u32x4, kv); const float a0 = bf_lo(w_.x), a1 = bf_hi(w_.x), a2 = bf_lo(w_.y), a3 = bf_hi(w_.y), a4 = bf_lo(w_.z), a5 = bf_hi(w_.z), a6 = bf_lo(w_.w), a7 = bf_hi(w_.w); \
    float ss_ = (a0 * a0 + a1 * a1) + (a2 * a2 + a3 * a3) + (a4 * a4 + a5 * a5) + (a6 * a6 + a7 * a7); ss_ += __shfl_xor(ss_, 1); ss_ += __shfl_xor(ss_, 2); ss_ += __shfl_xor(ss_, 4); ss_ += __shfl_xor(ss_, 8); \
    const float r_ = 1.0f / sqrtf(ss_ * (1.f / 128.f) + EPS); u32x4 o_; o_.x = cvtpk(a0 * r_ * gk0.x, a1 * r_ * gk0.y); o_.y = cvtpk(a2 * r_ * gk0.z, a3 * r_ * gk0.w); o_.z = cvtpk(a4 * r_ * gk1.x, a5 * r_ * gk1.y); o_.w = cvtpk(a6 * r_ * gk1.z, a7 * r_ * gk1.w); \
    kv = __builtin_bit_cast(bf16x8, o_); } while (0)
#define NLOAD(k0) do { const char* kb_ = (const char*)Kh + (size_t)(k0) * (LDK * 2); const char* vb_ = (const char*)Vh + (size_t)(k0) * (LDK * 2); \
    vs0 = *(const bf16x8*)(vb_ + lo0); vs1 = *(const bf16x8*)(vb_ + lo1); ks0 = *(const bf16x8*)(kb_ + lo0); ks1 = *(const bf16x8*)(kb_ + lo1); } while (0)
#define NWRITE(b) do { KNORM(ks0); KNORM(ks1); *(bf16x8*)((char*)V_lds + (b) * SHM_V + vst0) = vs0; *(bf16x8*)((char*)V_lds + (b) * SHM_V + vst1) = vs1; const int kc = sc * 2; \
    *(bf16x8*)((char*)K_lds + (b) * SHM_K + KSWZ(sr, kc)) = ks0; *(bf16x8*)((char*)K_lds + (b) * SHM_K + KSWZ(32 + sr, kc)) = ks1; } while (0)
  NLOAD(0); asm volatile("s_waitcnt vmcnt(0)" ::: "memory"); NWRITE(0); __syncthreads();
  for (int j = 0; j < NT; ++j) {
    const int bsel = j & 1;
    if (j + 1 < NT) NLOAD((j + 1) * KVBLK);
    f32x16 p0, p1; float mn, al; bf16x8 pa0, pa1, pa2, pa3;
    qkt(p0, p1, (const bf16_t*)((const char*)K_lds + bsel * SHM_K), qr, r32, hi); MK(p0, p1, j);
    partialSM(p0, p1, m_reg, mn, al);
    if (__any(al < 1.f)) { if (hi == 0) al_l[r32] = al; asm volatile("s_waitcnt lgkmcnt(0)" ::: "memory");
      for (int d = 0; d < 4; ++d) for (int r = 0; r < 16; ++r) o[d][r] *= al_l[crow(r, hi)]; }
    finishSM(p0, p1, al, l_reg, pa0, pa1, pa2, pa3); SBAR();
    pv_d0(o, vb0 + bsel * (int)SHM_V, pa0, pa1, pa2, pa3);
    if (j + 1 < NT) { asm volatile("s_waitcnt vmcnt(0)" ::: "memory"); NWRITE(bsel ^ 1); }
    __syncthreads();
  }
  if (hi == 0) li_l[r32] = l_reg; asm volatile("s_waitcnt lgkmcnt(0)" ::: "memory");
  float rli[16];
#pragma unroll
  for (int r = 0; r < 16; ++r) rli[r] = __builtin_amdgcn_rcpf(li_l[crow(r, hi)]) * F8_YMUL;
  unsigned char* Ow = Ob + (long)(wid * QBLK) * LDO; const unsigned lane_off = (unsigned)(4 * hi * LDO + r32);
#pragma unroll
  for (int r = 0; r < 16; ++r) { unsigned char* rowb = Ow + ((r & 3) + 8 * (r >> 2)) * LDO;
#pragma unroll
    for (int d0 = 0; d0 < 4; ++d0) { const float v = o[d0][r] * rli[r]; rowb[lane_off + d0 * 32] = (unsigned char)(__builtin_amdgcn_cvt_pk_fp8_f32(v, v, 0, false) & 0xff); } }
#undef NLOAD
#undef NWRITE
#undef KNORM
}
constexpr int F8_KT = 8192, F8_SCR = 49152;
#define MF8(a, b, c, sa, sb) __builtin_amdgcn_mfma_scale_f32_32x32x64_f8f6f4(a, b, c, 0, 0, 0, sa, 0, sb)
#define MFPV(a, b, c, sa, sb) __builtin_amdgcn_mfma_scale_f32_32x32x64_f8f6f4(a, b, c, 3, 2, 0, sa, 0, sb)
#define MF6(a, b, c, sa, sb) __builtin_amdgcn_mfma_scale_f32_32x32x64_f8f6f4(a, b, c, 2, 2, 0, sa, 0, sb)
__device__ __forceinline__ i32x8 cat8(const i32x4 lo, const i32x4 hi) { return __builtin_shufflevector(lo, hi, 0, 1, 2, 3, 4, 5, 6, 7); }
__device__ __forceinline__ i32x8 cat6(const i32x4 lo, const i32x2 hi) { i32x8 r; r[0] = lo[0]; r[1] = lo[1]; r[2] = lo[2]; r[3] = lo[3]; r[4] = hi[0]; r[5] = hi[1]; int u0, u1; asm volatile("" : "=v"(u0), "=v"(u1)); r[6] = u0; r[7] = u1; return r; }
template <bool REL>
__device__ __forceinline__ void qkt8(f32x16& p0, f32x16& p1, const char* Kt, const i32x8 (&qf)[2], const int (&ka)[2][2], const f32x16& negm) {
  const i32x8 k00 = cat6(*(const i32x4*)(Kt + ka[0][0]), *(const i32x2*)(Kt + ka[0][1])), k10 = cat6(*(const i32x4*)(Kt + 4096 + ka[0][0]), *(const i32x2*)(Kt + 4096 + ka[0][1]));
  const i32x8 k01 = cat6(*(const i32x4*)(Kt + ka[1][0]), *(const i32x2*)(Kt + ka[1][1])), k11 = cat6(*(const i32x4*)(Kt + 4096 + ka[1][0]), *(const i32x2*)(Kt + 4096 + ka[1][1]));
  asm volatile("" ::: "memory");
  const f32x16 zero = {};
  p0 = MF6(k00, qf[0], REL ? negm : zero, 126, 123); p1 = MF6(k10, qf[0], REL ? negm : zero, 126, 123); p0 = MF6(k01, qf[1], p0, 126, 123); p1 = MF6(k11, qf[1], p1, 126, 123);
}
__device__ __forceinline__ void partial8(f32x16& p0, f32x16& p1, float& m_reg, float& alpha) {
  float pmax = p0[0]; for (int r = 1; r < 16; ++r) pmax = fmaxf(pmax, p0[r]); for (int r = 0; r < 16; ++r) pmax = fmaxf(pmax, p1[r]);
  { auto rr = __builtin_amdgcn_permlane32_swap(__float_as_uint(pmax), __float_as_uint(pmax), false, false);
    pmax = fmaxf(__uint_as_float(rr[0]), __uint_as_float(rr[1])); }
  float mn;
  if (__builtin_expect(__all(pmax - m_reg <= PTHR), 1)) { mn = m_reg; alpha = 1.f; }
  else { mn = fmaxf(m_reg, pmax) + PHEAD0; alpha = __builtin_amdgcn_exp2f(m_reg - mn); m_reg = mn; }
  const float mb = mn - 4.0f;
  for (int r = 0; r < 16; ++r) p0[r] = p0[r] - mb; for (int r = 0; r < 16; ++r) p1[r] = p1[r] - mb;
  for (int r = 0; r < 16; ++r) p0[r] = __builtin_amdgcn_exp2f(p0[r]);
}
__device__ __forceinline__ void partial8r(f32x16& p0, f32x16& p1, float& m_reg, float& alpha, f32x16& negm) {
  float pmax = p0[0]; for (int r = 1; r < 16; ++r) pmax = fmaxf(pmax, p0[r]); for (int r = 0; r < 16; ++r) pmax = fmaxf(pmax, p1[r]);
  { auto rr = __builtin_amdgcn_permlane32_swap(__float_as_uint(pmax), __float_as_uint(pmax), false, false);
    pmax = fmaxf(__uint_as_float(rr[0]), __uint_as_float(rr[1])); }
  if (__builtin_expect(__all(pmax <= 4.0f + PTHR), 1)) { alpha = 1.f; }
  else { const float d = fmaxf(pmax - 4.0f + PHEAD, 0.f); alpha = __builtin_amdgcn_exp2f(-d); m_reg += d;
    for (int r = 0; r < 16; ++r) { p0[r] -= d; p1[r] -= d; negm[r] -= d; } }
  for (int r = 0; r < 16; ++r) p0[r] = __builtin_amdgcn_exp2f(p0[r]);
}
__device__ __forceinline__ int pk4_fp8_nz(float a, float b, float c, float d, int old) { int w = __builtin_amdgcn_cvt_pk_fp8_f32(a, b, old, false); return __builtin_amdgcn_cvt_pk_fp8_f32(c, d, w, true); }
__device__ __forceinline__ void finish8(const f32x16& p0, f32x16& p1, i32x8& pa) {
  for (int r = 0; r < 16; ++r) p1[r] = __builtin_amdgcn_exp2f(p1[r]);
  typedef unsigned u32x6_ __attribute__((ext_vector_type(6)));
  const u32x6_ pk = __builtin_amdgcn_cvt_scalef32_2xpk16_bf6_f32(p0, p1, 1.0f);
#pragma unroll
  for (int i = 0; i < 6; ++i) pa[i] = (int)pk[i];
  { int u0, u1; asm volatile("" : "=v"(u0), "=v"(u1)); pa[6] = u0; pa[7] = u1; }
}
__device__ __forceinline__ void pv8(f32x16 (&o)[4], f32x16& lacc, const char* Vt, const i32x8& pa, const int (&va)[2], const i32x8& ones) {
  lacc = MFPV(pa, ones, lacc, 127, 127);
#pragma unroll
  for (int d0 = 0; d0 < 4; ++d0) { const i32x8 vf = cat6(*(const i32x4*)(Vt + d0 * 2048 + va[0]), *(const i32x2*)(Vt + d0 * 2048 + va[1]));
    o[d0] = MFPV(pa, vf, o[d0], 127, 126); }
}
struct NoConv { static constexpr bool ON = false; __device__ __forceinline__ bool on() const { return false; } __device__ __forceinline__ void step(int, int) {} __device__ __forceinline__ void end() {} };
template <int LDO, class CV>
__device__ __forceinline__ void attn_body_f8(const unsigned char* __restrict__ Q8b, const unsigned char* __restrict__ K8h, const unsigned char* __restrict__ Vt8h,
                                             unsigned char* __restrict__ Ob, int seq, char* lds, LAS unsigned char* ldsl, const int wid, CV& cvx) {
  const int lane = lane_now(), tid = wid * 64 + lane, r32 = lane & 31, hi = lane >> 5;
  char* K_lds = lds; char* V_lds = lds + 3 * F8_KT;
  float m_reg = -1e30f; f32x16 o[4] = {}; f32x16 lacc = {}; i32x8 qf[2];
  { const unsigned char* qrow = Q8b + (size_t)(wid * QBLK + r32) * HD + hi * 32;
#pragma unroll
    for (int dh = 0; dh < 2; ++dh) qf[dh] = cat8(*(const i32x4*)(qrow + dh * 64), *(const i32x4*)(qrow + dh * 64 + 16)); }
  int ka[2][2]; { const int sw = (r32 >> 1) & 7;
#pragma unroll
    for (int dh = 0; dh < 2; ++dh)
#pragma unroll
      for (int e = 0; e < 2; ++e) ka[dh][e] = r32 * 128 + (((dh * 4 + hi * 2 + e) ^ sw) << 4); }
  int va[2]; { const int sw = (r32 >> 2) & 3;
#pragma unroll
    for (int e = 0; e < 2; ++e) va[e] = r32 * 64 + (((hi * 2 + e) ^ sw) << 4); }
  const int kp_row = wid * 8 + (lane >> 3), kp_c = (lane & 7) ^ ((kp_row >> 1) & 7); const unsigned kgo = (unsigned)(kp_row * 128 + kp_c * 16);
  const int vp_d = wid * 16 + (lane >> 2), vp_c = (lane & 3) ^ ((vp_d >> 2) & 3); const unsigned vgo = (unsigned)(vp_d * 64 + vp_c * 16);
#define DMA8(slot, t) do { \
    __builtin_amdgcn_global_load_lds((const unsigned*)(K8h + (size_t)(t) * 8192 + kgo), (LAS unsigned*)(ldsl + (slot) * F8_KT + wid * 1024), 16, 0, 0); \
    __builtin_amdgcn_global_load_lds((const unsigned*)(Vt8h + (size_t)(t) * 8192 + vgo), (LAS unsigned*)(ldsl + (3 + (slot)) * F8_KT + wid * 1024), 16, 0, 0); } while (0)
#define TBAR() do { if (cvx.on()) asm volatile("s_waitcnt vmcnt(1) lgkmcnt(0)" ::: "memory"); else asm volatile("s_waitcnt vmcnt(0) lgkmcnt(0)" ::: "memory"); \
    __builtin_amdgcn_s_barrier(); asm volatile("" ::: "memory"); } while (0)
#define RESC8(a) do { if (__any((a) < 1.f)) { const int ln_ = lane_now(), r32_ = ln_ & 31, hi_ = ln_ >> 5; float* al2_ = (float*)(lds + F8_SCR) + wid * 64; \
    if (hi_ == 0) al2_[r32_] = (a); asm volatile("s_waitcnt lgkmcnt(0)" ::: "memory"); \
    for (int r = 0; r < 16; ++r) { const float f_ = al2_[crow(r, hi_)]; for (int d = 0; d < 4; ++d) o[d][r] *= f_; lacc[r] *= f_; } } } while (0)
  f32x16 pA0, pA1, pB0, pB1; float alA, alB; i32x8 pa; const int NT = seq / KVBLK;
  i32x8 ones = {(int)0x08208208, (int)0x82082082, (int)0x20820820, (int)0x08208208, (int)0x82082082, (int)0x20820820, 0, 0};
  asm volatile("" : "+v"(ones));
  DMA8(0, 0); DMA8(1, 1);
  cvx.step(0, 0);
  asm volatile("s_waitcnt vmcnt(0)" ::: "memory"); __builtin_amdgcn_s_barrier(); asm volatile("" ::: "memory");
  f32x16 negm = {};
  qkt8<false>(pA0, pA1, K_lds, qf, ka, negm); partial8(pA0, pA1, m_reg, alA);
  { const float nm = 4.0f - m_reg; for (int r = 0; r < 16; ++r) negm[r] = nm; }
  int ks = 1, vs = 0, wsl = 2;
#define RING_NEXT() do { ks = (ks == 2) ? 0 : ks + 1; vs = (vs == 2) ? 0 : vs + 1; wsl = (wsl == 2) ? 0 : wsl + 1; } while (0)
  for (int j = 1; j + 1 < NT; j += 2) {
    TBAR(); DMA8(wsl, j + 1);
    cvx.step(j, 2);
    SBAR(); qkt8<true>(pB0, pB1, K_lds + ks * F8_KT, qf, ka, negm);
    finish8(pA0, pA1, pa); SBAR();
    pv8(o, lacc, V_lds + vs * F8_KT, pa, va, ones); partial8r(pB0, pB1, m_reg, alB, negm);
    RESC8(alB); RING_NEXT();
    TBAR(); const bool more = j + 2 < NT; if (more) DMA8(wsl, j + 2);
    cvx.step(j + 1, more ? 2 : 0);
    SBAR(); qkt8<true>(pA0, pA1, K_lds + ks * F8_KT, qf, ka, negm);
    finish8(pB0, pB1, pa); SBAR();
    pv8(o, lacc, V_lds + vs * F8_KT, pa, va, ones); partial8r(pA0, pA1, m_reg, alA, negm);
    RESC8(alA); RING_NEXT();
  }
  TBAR();
  cvx.step(NT - 1, 0);
  SBAR(); qkt8<true>(pB0, pB1, K_lds + ks * F8_KT, qf, ka, negm);
  finish8(pA0, pA1, pa); SBAR();
  pv8(o, lacc, V_lds + vs * F8_KT, pa, va, ones); partial8r(pB0, pB1, m_reg, alB, negm);
  RESC8(alB); RING_NEXT();
  finish8(pB0, pB1, pa); SBAR();
  pv8(o, lacc, V_lds + vs * F8_KT, pa, va, ones);
#undef RING_NEXT
  cvx.end();
  const int le_ = lane_now();
  unsigned char* Ow = Ob + (long)(wid * QBLK) * LDO; const unsigned lane_off = (unsigned)(4 * (le_ >> 5) * LDO + (le_ & 31));
#pragma unroll
  for (int r = 0; r < 16; ++r) { unsigned char* rowb = Ow + ((r & 3) + 8 * (r >> 2)) * LDO; const float rl = __builtin_amdgcn_rcpf(lacc[r]) * F8_YMUL;
#pragma unroll
    for (int d0 = 0; d0 < 4; ++d0) { const float v = o[d0][r] * rl; rowb[lane_off + d0 * 32] = (unsigned char)(__builtin_amdgcn_cvt_pk_fp8_f32(v, v, 0, false) & 0xff); } }
#undef DMA8
#undef TBAR
#undef RESC8
}
}

#define XB_TMO      128
#define XB_XCNT(j)  (256  + 64 * (j))
#define XB_XSUB(j)  (1280 + 64 * (j))
#define XB_XGEN(j)  (2304 + 64 * (j))
#define XB_TOP      3328
#define XB_TOPGEN   3392
#define XCD_BAR_WORDS 3456
#define XB_SPIN_CAP (1u << 18)
__device__ __forceinline__ unsigned xb_ld(unsigned* p)              { return __hip_atomic_load(p, __ATOMIC_RELAXED, __HIP_MEMORY_SCOPE_AGENT); }
__device__ __forceinline__ unsigned xb_add(unsigned* p, unsigned v) { return __hip_atomic_fetch_add(p, v, __ATOMIC_RELAXED, __HIP_MEMORY_SCOPE_AGENT); }
__device__ __forceinline__ unsigned xb_xcc_id() { return (unsigned)__builtin_amdgcn_s_getreg((3 << 11) | 20) & 0xFu; }
#define XB_SPIN(cond, bar) do { unsigned _sp = 0; while (cond) { __builtin_amdgcn_s_sleep(1); \
    if ((++_sp & 255u) == 0u) { if (xb_ld(&(bar)[XB_TMO])) break; if (_sp > XB_SPIN_CAP) { atomicAdd(&(bar)[XB_TMO], 1u); break; } } } } while (0)
struct XcdBarrier { unsigned* bar; unsigned x; volatile LAS unsigned* st; };
__device__ __forceinline__ XcdBarrier xcd_barrier_post(unsigned* bar, volatile LAS unsigned* st, const bool t0) {
    XcdBarrier b; b.bar = bar; b.x = xb_xcc_id(); b.st = st;
    if (t0) (void)xb_add(&bar[XB_XCNT(b.x)], 1u);
    return b;
}
__device__ __forceinline__ void xcd_barrier_complete(unsigned* bar, unsigned x, unsigned& nloc, unsigned& nx) {
    const unsigned G = gridDim.x * gridDim.y * gridDim.z;
    unsigned sum, cnt, mine, sp = 0u;
    for (;;) {
        sum = 0u; cnt = 0u; mine = 0u;
#pragma unroll
        for (unsigned j = 0; j < 16; ++j) { const unsigned c = xb_ld(&bar[XB_XCNT(j)]); sum += c; cnt += (c > 0u) ? 1u : 0u; mine = (j == x) ? c : mine; }
        if (sum == G) break;
        __builtin_amdgcn_s_sleep(1);
        if ((++sp & 255u) == 0u) { if (xb_ld(&bar[XB_TMO])) break; if (sp > XB_SPIN_CAP) { atomicAdd(&bar[XB_TMO], 1u); break; } }
    }
    nloc = mine > 0u ? mine : 1u; nx = cnt > 0u ? cnt : 1u;
}
__device__ __forceinline__ void xcd_barrier(const XcdBarrier& b, const bool t0) {
    asm volatile("s_waitcnt vmcnt(0)" ::: "memory");
    __syncthreads();
    if (t0) {
        unsigned* bar = b.bar;
        __builtin_amdgcn_s_waitcnt(0);
        unsigned nloc = b.st[0], nx = b.st[1];
        if (nloc == 0u) { xcd_barrier_complete(bar, b.x, nloc, nx); b.st[0] = nloc; b.st[1] = nx; }
        const unsigned old = xb_add(&bar[XB_XSUB(b.x)], 1u);
        const unsigned gen = old / nloc;
        if (old + 1u == (gen + 1u) * nloc) {
            __builtin_amdgcn_fence(__ATOMIC_RELEASE, "agent");
            asm volatile("s_waitcnt vmcnt(0)" ::: "memory");
            const unsigned og = xb_add(&bar[XB_TOP], 1u);
            const unsigned tg = og / nx;
            if (og + 1u == (tg + 1u) * nx) xb_add(&bar[XB_TOPGEN], 1u);
            else XB_SPIN(xb_ld(&bar[XB_TOPGEN]) == tg, bar);
            __builtin_amdgcn_fence(__ATOMIC_ACQUIRE, "agent");
            xb_add(&bar[XB_XGEN(b.x)], 1u);
            asm volatile("s_waitcnt vmcnt(0)" ::: "memory");
        } else {
            XB_SPIN(xb_ld(&bar[XB_XGEN(b.x)]) == gen, bar);
            __builtin_amdgcn_fence(__ATOMIC_ACQUIRE, "agent");
            asm volatile("s_waitcnt vmcnt(0)" ::: "memory");
        }
    }
    __syncthreads();
}

struct Frame {
    LAS unsigned char* lds;
    volatile LAS unsigned* MISC;
    gu32* ctl;
    int tid, lane, wave, G, bx;
    float* out; unsigned char* ws;
};
__device__ __forceinline__ const float* inp(int k) {
    const __attribute__((address_space(4))) char* kp = (const __attribute__((address_space(4))) char*)__builtin_amdgcn_kernarg_segment_ptr();
    asm volatile("" : "+s"(kp));
    return *(const float* const __attribute__((address_space(4)))*)(kp + 8 * k);
}
__device__ __forceinline__ float wave_sum(float v) {
#pragma unroll
    for (int o = 1; o < 64; o <<= 1) v += __shfl_xor(v, o);
    return v;
}
__device__ __forceinline__ unsigned f2bf(float f) { unsigned u = __builtin_bit_cast(unsigned, f); return (u + 0x7fffu + ((u >> 16) & 1u)) >> 16; }
__device__ __forceinline__ unsigned pk2(float lo, float hi) { return f2bf(lo) | (f2bf(hi) << 16); }

__device__ __forceinline__ void tr_item(const float* W, int N, bf16_t* WT, int K, int k0, int n0, size_t dst_row0, LAS float* scr, int lane) {
#pragma unroll
    for (int i = 0; i < 32; ++i) { const int kk = 2 * i + (lane >> 5); scr[kk * 33 + (lane & 31)] = W[(size_t)(k0 + kk) * N + n0 + (lane & 31)]; }
    LDS_WAIT(); asm volatile("" ::: "memory");
    const int c = lane & 7;
#pragma unroll
    for (int j = 0; j < 4; ++j) { const int n = (lane >> 3) + 8 * j; const LAS float* s = scr + (8 * c) * 33 + n;
        u32x4 o; o.x = pk2(s[0 * 33], s[1 * 33]); o.y = pk2(s[2 * 33], s[3 * 33]); o.z = pk2(s[4 * 33], s[5 * 33]); o.w = pk2(s[6 * 33], s[7 * 33]);
        *(GAS u32x4*)(WT + (dst_row0 + n) * K + k0 + 8 * c) = o; }
    LDS_WAIT(); asm volatile("" ::: "memory");
}
template <bool KG> __device__ __forceinline__ void tr_item_f8(const float* W, int N, unsigned char* WT, int K, int k0, int n0, size_t dst_row0, LAS float* scr, int lane, const float* kg = nullptr) {
#pragma unroll
    for (int i = 0; i < 32; ++i) { const int kk = 2 * i + (lane >> 5); scr[kk * 33 + (lane & 31)] = W[(size_t)(k0 + kk) * N + n0 + (lane & 31)]; }
    LDS_WAIT(); asm volatile("" ::: "memory");
    const int c = lane & 7;
    f32x4 m0 = {F8_WMUL, F8_WMUL, F8_WMUL, F8_WMUL}, m1 = m0;
    if (KG) { m0 = *(const f32x4*)(kg + k0 + 8 * c) * F8_WMUL; m1 = *(const f32x4*)(kg + k0 + 8 * c + 4) * F8_WMUL; }
#pragma unroll
    for (int j = 0; j < 4; ++j) { const int n = (lane >> 3) + 8 * j; const LAS float* s = scr + (8 * c) * 33 + n;
        u32x2 o; o.x = pk4_fp8(s[0 * 33] * m0.x, s[1 * 33] * m0.y, s[2 * 33] * m0.z, s[3 * 33] * m0.w); o.y = pk4_fp8(s[4 * 33] * m1.x, s[5 * 33] * m1.y, s[6 * 33] * m1.z, s[7 * 33] * m1.w);
        *(GAS u32x2*)(WT + (dst_row0 + n) * K + k0 + 8 * c) = o; }
    LDS_WAIT(); asm volatile("" ::: "memory");
}
__device__ __forceinline__ void rms_row_to_fp8(int lane, const float* xrow, const float* g, unsigned char* orow) {
    const GAS f32x4* xr = (const GAS f32x4*)xrow + lane; const GAS f32x4* gr = (const GAS f32x4*)g + lane;
    f32x4 v[8]; float s = 0.f;
#pragma unroll
    for (int j = 0; j < 8; ++j) { v[j] = xr[64 * j]; s += (v[j].x * v[j].x + v[j].y * v[j].y) + (v[j].z * v[j].z + v[j].w * v[j].w); }
    const float rstd = 1.0f / sqrtf(wave_sum(s) * (1.f / D) + EPS);
    GAS unsigned* o8 = (GAS unsigned*)orow + lane;
#pragma unroll
    for (int j = 0; j < 8; ++j) { const f32x4 gg = gr[64 * j]; o8[64 * j] = pk4_fp8(v[j].x * rstd * gg.x, v[j].y * rstd * gg.y, v[j].z * rstd * gg.z, v[j].w * rstd * gg.w); }
}
__device__ __forceinline__ void sincos_d(double a, float& c, float& s) {
    const double TWO_OVER_PI = 0.63661977236758134308, PIO2_HI = 1.57079632679489655800e+00, PIO2_LO = 6.12323399573676603587e-17;
    const double q = __builtin_rint(a * TWO_OVER_PI); const double r = (a - q * PIO2_HI) - q * PIO2_LO; const int n = (int)q & 3;
    const double r2 = r * r;
    double sp = -1.0 / 1307674368000.0; sp = sp * r2 + 1.0 / 6227020800.0; sp = sp * r2 - 1.0 / 39916800.0; sp = sp * r2 + 1.0 / 362880.0; sp = sp * r2 - 1.0 / 5040.0; sp = sp * r2 + 1.0 / 120.0; sp = sp * r2 - 1.0 / 6.0; sp = sp * r2 + 1.0;
    const double sn = sp * r;
    double cp = 1.0 / 20922789888000.0; cp = cp * r2 - 1.0 / 87178291200.0; cp = cp * r2 + 1.0 / 479001600.0; cp = cp * r2 - 1.0 / 3628800.0; cp = cp * r2 + 1.0 / 40320.0; cp = cp * r2 - 1.0 / 720.0; cp = cp * r2 + 1.0 / 24.0; cp = cp * r2 - 0.5; cp = cp * r2 + 1.0;
    const double cs = cp;
    double so, co;
    if (n == 0) { so = sn; co = cs; } else if (n == 1) { so = cs; co = -sn; } else if (n == 2) { so = -sn; co = -cs; } else { so = -cs; co = sn; }
    c = (float)co; s = (float)so;
}
__device__ __forceinline__ double inv_freq_d(int f) {
    const double t[32] = {1.0, 0.7498942093324559, 0.5623413251903491, 0.4216965034285822, 0.31622776601683794, 0.23713737056616552, 0.1778279410038923, 0.1333521432163324, 0.09999999999999999, 0.07498942093324558, 0.056234132519034905, 0.042169650342858224, 0.03162277660168379, 0.023713737056616554, 0.01778279410038923, 0.013335214321633239, 0.01, 0.007498942093324559, 0.005623413251903491, 0.004216965034285822, 0.0031622776601683794, 0.002371373705661655, 0.0017782794100389228, 0.0013335214321633238, 0.001, 0.0007498942093324559, 0.000562341325190349, 0.00042169650342858224, 0.00031622776601683794, 0.00023713737056616554, 0.0001778279410038923, 0.0001333521432163324};
    double r = t[0];
#pragma unroll
    for (int i = 1; i < 32; ++i) r = (f == i) ? t[i] : r;
    return r;
}

struct P0Item { const float* src; unsigned char* dst; const float* kg; int N, K, k0, n0; size_t drow0; };
__device__ __forceinline__ void p0_decode(int it, unsigned char* ws, P0Item& d) {
    constexpr int I_IN = 32 * 272, I_PA = 16 * 64, I_OUT = 32 * 64, I_EX = NE * 32 * 64;
    int r = it; d.kg = nullptr;
    if (r < I_IN) { const int kb = r / 272, nb = r % 272; d.src = inp(2); d.N = NCOLS; d.dst = ws + WS_WIN; d.K = D; d.k0 = 64 * kb; d.n0 = 32 * nb; d.drow0 = (size_t)32 * nb; return; } r -= I_IN;
    if (r < I_PA) { const int kb = r / 64, nb = r % 64; d.src = inp(8); d.N = D; d.dst = ws + WS_WPA; d.K = 1024; d.k0 = 64 * kb; d.n0 = 32 * nb; d.drow0 = (size_t)32 * nb; return; } r -= I_PA;
    if (r < I_PA) { const int kb = r / 64, nb = r % 64; d.src = inp(9); d.N = D; d.dst = ws + WS_WPB; d.K = 1024; d.k0 = 64 * kb; d.n0 = 32 * nb; d.drow0 = (size_t)32 * nb; return; } r -= I_PA;
    if (r < I_OUT) { const int kb = r / 64, nb = r % 64; d.src = inp(10); d.N = D; d.dst = ws + WS_WOUT; d.K = D; d.k0 = 64 * kb; d.n0 = 32 * nb; d.drow0 = (size_t)32 * nb; return; } r -= I_OUT;
    const int which = r / I_EX; r -= which * I_EX; const int e = r / 2048, rr = r % 2048, kb = rr / 64, nb = rr % 64, n0 = 32 * nb;
    d.k0 = 64 * kb; d.n0 = n0;
    if (which == 0) { d.src = inp(14) + (size_t)e * D * DE; d.N = DE; d.dst = ws + WS_WGU + (size_t)e * 4096 * D; d.K = D; d.drow0 = (size_t)((n0 >> 7) * 256 + (n0 & 127)); d.kg = inp(11); }
    else if (which == 1) { d.src = inp(16) + (size_t)e * D * DE; d.N = DE; d.dst = ws + WS_WGU + (size_t)e * 4096 * D; d.K = D; d.drow0 = (size_t)((n0 >> 7) * 256 + 128 + (n0 & 127)); d.kg = inp(11); }
    else { d.src = inp(18) + (size_t)e * DE * D; d.N = D; d.dst = ws + WS_WD + (size_t)e * 2048 * DE; d.K = DE; d.drow0 = (size_t)n0; }
}
__device__ __forceinline__ void p0_load(const P0Item& d, float (&v)[32], int lane) {
    const float* p = d.src + (size_t)(d.k0 + (lane >> 5)) * d.N + d.n0 + (lane & 31);
#pragma unroll
    for (int i = 0; i < 32; ++i) v[i] = p[(size_t)(2 * i) * d.N];
}
__device__ __forceinline__ void p0_finish(const P0Item& d, const float (&v)[32], LAS float* scr, int lane) {
#pragma unroll
    for (int i = 0; i < 32; ++i) scr[(2 * i + (lane >> 5)) * 33 + (lane & 31)] = v[i];
    LDS_WAIT(); asm volatile("" ::: "memory");
    const int c = lane & 7;
    f32x4 m0 = {F8_WMUL, F8_WMUL, F8_WMUL, F8_WMUL}, m1 = m0;
    if (d.kg) { m0 = *(const f32x4*)(d.kg + d.k0 + 8 * c) * F8_WMUL; m1 = *(const f32x4*)(d.kg + d.k0 + 8 * c + 4) * F8_WMUL; }
#pragma unroll
    for (int j = 0; j < 4; ++j) { const int n = (lane >> 3) + 8 * j; const LAS float* s = scr + (8 * c) * 33 + n;
        u32x2 o; o.x = pk4_fp8(s[0 * 33] * m0.x, s[1 * 33] * m0.y, s[2 * 33] * m0.z, s[3 * 33] * m0.w); o.y = pk4_fp8(s[4 * 33] * m1.x, s[5 * 33] * m1.y, s[6 * 33] * m1.z, s[7 * 33] * m1.w);
        *(GAS u32x2*)(d.dst + (d.drow0 + n) * d.K + d.k0 + 8 * c) = o; }
    LDS_WAIT(); asm volatile("" ::: "memory");
}
constexpr int P0_I_FIRST = 32 * 272 + 2 * 16 * 64 + 32 * 64, P0_I_ALL = P0_I_FIRST + 3 * NE * 32 * 64;
struct ConvW {
    static constexpr bool ON = true;
    const float* src0; unsigned char* dst0; size_t sstride, dstride; int N, K, k0; size_t drow0; bool kgf, act;
    LAS float* scr; const LAS float* gl;
    __device__ __forceinline__ void init(unsigned char* ws, int unit, int slot) {
        P0Item d; p0_decode(P0_I_FIRST + (unit * 32) * 2048 + slot, ws, d);
        src0 = d.src + (size_t)d.k0 * d.N + d.n0; dst0 = d.dst; N = d.N; K = d.K; k0 = d.k0; drow0 = d.drow0; kgf = d.kg != nullptr;
        sstride = (size_t)D * DE; dstride = (unit < 2) ? (size_t)4096 * D : (size_t)2048 * DE;
    }
    __device__ __forceinline__ bool on() const { return act; }
    __device__ __forceinline__ void finish(int q) {
        const int lane = lane_now(), c = lane & 7;
        f32x4 m0 = {F8_WMUL, F8_WMUL, F8_WMUL, F8_WMUL}, m1 = m0;
        if (kgf) { m0 = *(const LAS f32x4*)(gl + k0 + 8 * c) * F8_WMUL; m1 = *(const LAS f32x4*)(gl + k0 + 8 * c + 4) * F8_WMUL; }
        unsigned char* dq = dst0 + (size_t)q * dstride;
#pragma unroll
        for (int j = 0; j < 4; ++j) { const int n = (lane >> 3) + 8 * j; const LAS float* s = scr + c * 256 + ((((n >> 2) + c) & 7) << 2) + (n & 3);
            u32x2 o; o.x = pk4_fp8(s[0 * 32] * m0.x, s[1 * 32] * m0.y, s[2 * 32] * m0.z, s[3 * 32] * m0.w); o.y = pk4_fp8(s[4 * 32] * m1.x, s[5 * 32] * m1.y, s[6 * 32] * m1.z, s[7 * 32] * m1.w);
            __builtin_nontemporal_store(o, (GAS u32x2*)(dq + (drow0 + n) * K + k0 + 8 * c)); }
    }
    __device__ __forceinline__ void step(int c, int newer) {
        if (!act) return;
        if ((c & 7) == 0 && c > 0) { if (newer == 2) asm volatile("s_waitcnt vmcnt(2)" ::: "memory"); else asm volatile("s_waitcnt vmcnt(0)" ::: "memory");
            finish((c >> 3) - 1); }
        const int lane = lane_now(), sblk = c & 7;
        const float* src = src0 + (size_t)(c >> 3) * sstride + (size_t)(8 * sblk + (lane >> 3)) * N + 4 * (((lane & 7) - sblk) & 7);
        __builtin_amdgcn_global_load_lds((const unsigned*)src, (LAS unsigned*)(scr + sblk * 256), 16, 0, 2);
    }
    __device__ __forceinline__ void end() { if (!act) return; asm volatile("s_waitcnt vmcnt(0)" ::: "memory"); finish(31); }
};
__device__ __forceinline__ void p0_prologue(Frame& F) {
    LAS float* scr = (LAS float*)(F.lds + RING_OFF + F.wave * 16384);
    const int gw = F.bx * NWAVES + F.wave, NGW = F.G * NWAVES;
    unsigned char* ws = F.ws;
    const int NITEMS = (F.G == 256) ? P0_I_FIRST : P0_I_ALL;
    { P0Item A, B; float va[32], vb[32]; int it = gw;
      if (it < NITEMS) { p0_decode(it, ws, A); p0_load(A, va, F.lane);
        for (;;) {
            const bool hb = it + NGW < NITEMS; if (hb) { p0_decode(it + NGW, ws, B); p0_load(B, vb, F.lane); }
            p0_finish(A, va, scr, F.lane); if (!hb) break;
            it += 2 * NGW; const bool ha = it < NITEMS; if (ha) { p0_decode(it, ws, A); p0_load(A, va, F.lane); }
            p0_finish(B, vb, scr, F.lane); if (!ha) break;
        } } }
    for (int m = gw; m < NTOK; m += NGW) rms_row_to_fp8(F.lane, inp(0) + (size_t)m * D, inp(1), (unsigned char*)(ws + WS_H) + (size_t)m * D);
    { float* tab = (float*)(ws + WS_TAB); const int gid = F.bx * 512 + F.tid;
      if (gid < 320 * 32) { const int pos = gid >> 5, f = gid & 31; const int p = pos < 256 ? pos : pos - 256; float c, s; sincos_d((double)p * inv_freq_d(f), c, s);
        if (pos < 256) { tab[pos * 32 + f] = c; tab[8192 + pos * 32 + f] = s; } else { tab[16384 + p * 32 + f] = c; tab[16384 + 2048 + p * 32 + f] = s; } } }
}

#define F8D(w, b) __builtin_amdgcn_cvt_f32_fp8((int)(w), b)
__device__ __forceinline__ void p2_qknorm(Frame& F) {
    const float* tab = (const float*)(F.ws + WS_TAB);
    const int l16 = F.lane & 15, g4 = F.lane >> 4, gw = F.bx * NWAVES + F.wave, NGW = F.G * NWAVES;
    constexpr int R_QA = 2 * 8 * SEQ, R_KA = 2 * 2 * SEQ, NCH = (R_QA + R_KA) / 16;
    const int axis = l16 >> 3, half = (l16 >> 2) & 1;
    const int cch = gw, cstep = NGW, cend = NCH;
    u32x2 w[4];
#define P2_LOAD(dst, chx) do { int r_ = (chx) * 16; const unsigned char* b_ = F.ws + WS_QA; if (r_ >= R_QA) { r_ -= R_QA; b_ = F.ws + WS_KA; } \
        _Pragma("unroll") for (int k = 0; k < 4; ++k) dst[k] = *(const u32x2*)(b_ + (size_t)(r_ + 4 * k + g4) * HD + 8 * l16); } while (0)
    if (cch < cend) P2_LOAD(w, cch);
    for (int ch = cch; ch < cend; ch += cstep) {
        int r0 = ch * 16; const float* g; unsigned char* o8; float omul = 1.0f;
        if (r0 < R_QA) { g = inp(3); o8 = F.ws + WS_Q8; omul = att::QMUL; }
        else { r0 -= R_QA; g = inp(4); o8 = F.ws + WS_K8; omul = att::KMUL; }
        u32x2 wn[4];
#pragma unroll
        for (int k = 0; k < 4; ++k) wn[k] = w[k];
        if (ch + cstep < cend) P2_LOAD(wn, ch + cstep);
        const f32x4 g0 = *(const f32x4*)(g + 8 * l16), g1 = *(const f32x4*)(g + 8 * l16 + 4);
#pragma unroll
        for (int k = 0; k < 4; ++k) {
            const int row = r0 + 4 * k + g4;
            float x[8] = {F8D(w[k].x, 0), F8D(w[k].x, 1), F8D(w[k].x, 2), F8D(w[k].x, 3), F8D(w[k].y, 0), F8D(w[k].y, 1), F8D(w[k].y, 2), F8D(w[k].y, 3)};
            float ss = 0.f;
#pragma unroll
            for (int i = 0; i < 8; ++i) ss += x[i] * x[i];
            ss += __shfl_xor(ss, 1); ss += __shfl_xor(ss, 2); ss += __shfl_xor(ss, 4); ss += __shfl_xor(ss, 8);
            const float rstd = 1.0f / sqrtf(ss * (1.f / 128.f) + EPS);
#pragma unroll
            for (int i = 0; i < 4; ++i) { x[i] = x[i] * rstd * g0[i]; x[4 + i] = x[4 + i] * rstd * g1[i]; }
            const int sq = row & (SEQ - 1), pos = axis ? (sq & 63) : (sq >> 6);
            const float* ct = tab + (axis ? 16384 : 0) + pos * 32 + 8 * (l16 & 3); const float* st = ct + (axis ? 2048 : 8192);
            const f32x4 c0 = *(const f32x4*)ct, c1 = *(const f32x4*)(ct + 4), s0 = *(const f32x4*)st, s1 = *(const f32x4*)(st + 4);
            float y[8];
#pragma unroll
            for (int i = 0; i < 8; ++i) { const float pr = __shfl_xor(x[i], 4); const float cc = i < 4 ? c0[i & 3] : c1[i & 3], sn = i < 4 ? s0[i & 3] : s1[i & 3];
                y[i] = half ? (x[i] * cc + pr * sn) : (x[i] * cc - pr * sn); }
            unsigned c6[8];
#pragma unroll
            for (int i = 0; i < 8; ++i) c6[i] = f6_e2m3(y[i] * omul);
            const unsigned lo = c6[0] | (c6[1] << 6) | (c6[2] << 12) | (c6[3] << 18) | (c6[4] << 24) | (c6[5] << 30), hi16 = (c6[5] >> 2) | (c6[6] << 4) | (c6[7] << 10);
            const unsigned plo = (unsigned)__builtin_amdgcn_update_dpp(0, (int)lo, 0xB1, 0xf, 0xf, false), phi = (unsigned)__builtin_amdgcn_update_dpp(0, (int)hi16, 0xB1, 0xf, 0xf, false);
            if (!(l16 & 1)) { unsigned* dst = (unsigned*)(o8 + (size_t)row * HD + (l16 >> 2) * 32 + ((l16 & 3) >> 1) * 12);
                dst[0] = lo; dst[1] = hi16 | (plo << 16); dst[2] = (plo >> 16) | (phi << 16); }
        }
#pragma unroll
        for (int k = 0; k < 4; ++k) w[k] = wn[k];
    }
#undef P2_LOAD
    LAS unsigned char* vt = F.lds + RING_OFF + F.wave * 16384;
    for (int T = gw; T < 2 * 2 * (SEQ / 64); T += NGW) {
        const unsigned char* vsrc = F.ws + WS_VA + ((size_t)T * 64 + F.lane) * HD;
#pragma unroll
        for (int c = 0; c < 16; ++c) { const u32x2 w = *(const u32x2*)(vsrc + 8 * c);
            u32x2 q;
            q.x = f6_e2m3(F8D(w.x, 0) * att::VMUL) | (f6_e2m3(F8D(w.x, 1) * att::VMUL) << 8) | (f6_e2m3(F8D(w.x, 2) * att::VMUL) << 16) | (f6_e2m3(F8D(w.x, 3) * att::VMUL) << 24);
            q.y = f6_e2m3(F8D(w.y, 0) * att::VMUL) | (f6_e2m3(F8D(w.y, 1) * att::VMUL) << 8) | (f6_e2m3(F8D(w.y, 2) * att::VMUL) << 16) | (f6_e2m3(F8D(w.y, 3) * att::VMUL) << 24);
            *(LAS u32x2*)(vt + F.lane * 144 + 8 * c) = q; }
        LDS_WAIT(); asm volatile("" ::: "memory");
#pragma unroll
        for (int dd = 0; dd < 2; ++dd) { const int d = F.lane + 64 * dd;
            unsigned char* dst = F.ws + WS_VT8 + (size_t)T * 8192 + (size_t)d * 64;
#pragma unroll
            for (int hh = 0; hh < 2; ++hh) { unsigned wv[6] = {0u, 0u, 0u, 0u, 0u, 0u};
#pragma unroll
                for (int j = 0; j < 32; ++j) { const int key = (j < 16) ? att::crow(j, hh) : 32 + att::crow(j - 16, hh); const unsigned code = vt[key * 144 + d];
                    const int fld = (j < 16) ? 2 * j : 2 * (j - 16) + 1;
                    const int bit = 6 * fld, wi = bit >> 5, sh = bit & 31; wv[wi] |= code << sh; if (sh > 26) wv[wi + 1] |= code >> (32 - sh); }
                *(u32x4*)(dst + 32 * hh) = (u32x4){wv[0], wv[1], wv[2], wv[3]}; *(u32x2*)(dst + 32 * hh + 16) = (u32x2){wv[4], wv[5]}; } }
        LDS_WAIT(); asm volatile("" ::: "memory");
    }
}

__device__ __forceinline__ void p3_attention(Frame& F, char* lds) {
    unsigned char* ya = (unsigned char*)(F.ws + WS_YA); unsigned char* yb = (unsigned char*)(F.ws + WS_YB);
    { const int tl = F.wave * 64 + lane_now(); *(LAS f32x4*)(F.lds + RING_OFF + 116736 + tl * 16) = *(const f32x4*)(inp(11) + tl * 4); }
    for (int i = 0; ; ++i) {
        int b, h, qb;
        if (F.G == 256) { if (i >= 4) break; const int x = F.bx & 7, combo = x & 3, cu = (x >> 2) * 32 + (F.bx >> 3); b = combo >> 1; h = (combo & 1) * 4 + i; qb = cu; }
        else { const int u = F.bx + i * F.G; if (u >= 1024) break; b = u >> 9; h = (u >> 6) & 7; qb = u & 63; }
        const size_t t0 = (size_t)b * SEQ;
        __syncthreads();
        ConvW cvx; cvx.scr = (LAS float*)(F.lds + RING_OFF + 51200 + F.wave * 8192); cvx.gl = (const LAS float*)(F.lds + RING_OFF + 116736);
        cvx.act = (F.G == 256) && (i < 3); cvx.init(F.ws, i < 3 ? i : 0, F.bx * NWAVES + F.wave);
        att::attn_body_f8<1024, ConvW>(F.ws + WS_Q8 + ((size_t)(b * 8 + h) * SEQ + (size_t)qb * 256) * HD, F.ws + WS_K8 + (size_t)(b * 2 + (h >> 2)) * SEQ * HD,
                                F.ws + WS_VT8 + (size_t)(b * 2 + (h >> 2)) * (SEQ / 64) * 8192, ya + (t0 + (size_t)qb * 256) * 1024 + 128 * h, SEQ, lds, F.lds + RING_OFF, F.wave, cvx);
    }
    float* bias_l = (float*)(lds + att::BIAS_OFF);
    for (int i = 0; ; ++i) {
        int u = F.bx + i * F.G;
        if (F.G == 256) { if (i >= 4) break; u = (F.bx & 7) * 128 + i * 32 + (F.bx >> 3); }
        if (u >= 1024) break;
        const int b = u >> 9, h = (u >> 6) & 7, rb = u & 63, R0 = rb * 4;
        int kr0 = R0 - 4; kr0 = kr0 < 0 ? 0 : (kr0 > ROWS - 12 ? ROWS - 12 : kr0);
        __syncthreads();
        const int lane = lane_now(), wid = F.wave, tl = wid * 64 + lane;
        if (tl < 15 * 32) { const int ro = tl >> 5, co = tl & 31; bias_l[tl] = co < 31 ? inp(7)[(h * 15 + ro) * 31 + co] * (1.0f / att::SCALE) : 0.f; }
        const size_t t0 = (size_t)b * SEQ;
        const int c = 32 * (wid & 1) + (lane & 31); int cs = c - 8; cs = cs < 0 ? 0 : (cs > GW - 16 ? GW - 16 : cs);
        att::NaMask mk{bias_l, kr0, R0 + (wid >> 1), c, cs, lane >> 5};
        att::attn_body_simple<HD, HD, 1024, att::NaMask>((const bf16_t*)(F.ws + WS_QB) + ((size_t)(b * 8 + h) * SEQ + (size_t)R0 * 64) * HD, (const bf16_t*)(F.ws + WS_KB) + ((size_t)(b * 8 + h) * SEQ + (size_t)kr0 * 64) * HD,
                                                            (const bf16_t*)(F.ws + WS_VB) + ((size_t)(b * 8 + h) * SEQ + (size_t)kr0 * 64) * HD, yb + (t0 + (size_t)R0 * 64) * 1024 + 128 * h, 12, lds, mk, F.wave, inp(5), inp(6));
    }
}

__device__ __forceinline__ void p6_router(Frame& F) {
    const bf16_t* x1 = (const bf16_t*)(F.ws + WS_X1B); const float* g2 = inp(11); const float* wr = inp(12); const float* br = inp(13);
    unsigned char* h2 = (unsigned char*)(F.ws + WS_H8);
    LAS unsigned char* tile = F.lds + RING_OFF;
    LAS float* part = (LAS float*)(F.lds + PART_OFF);
    LAS unsigned* asg = (LAS unsigned*)(F.lds + ASG_OFF);
    LAS unsigned* hist = (LAS unsigned*)(F.lds + HIST_OFF);
    const int lane = F.lane, w = F.wave, row = lane & 15, kq = lane >> 4;
    if (F.tid < 64) hist[F.tid] = 0u;
    float Breg[16][4][2];
#pragma unroll
    for (int s = 0; s < 16; ++s)
#pragma unroll
        for (int i = 0; i < 4; ++i)
#pragma unroll
            for (int hf = 0; hf < 2; ++hf) { const int k = 256 * w + 16 * s + 4 * kq + i; Breg[s][i][hf] = wr[(size_t)k * NE + row + 16 * hf] * g2[k]; }
    int nasg = 0;
    u32x2 va[8], vb[8];
    const unsigned lofs = (unsigned)lane * 16u;
    { const int ch = F.bx; if (ch < NTOK / 16) { const char* xa = (const char*)(x1 + ((size_t)ch * 16 + 2 * w) * D);
#pragma unroll
        for (int j = 0; j < 8; ++j) { va[j] = *(const u32x2*)(xa + (lofs >> 1) + 512 * j); vb[j] = *(const u32x2*)(xa + 4096 + (lofs >> 1) + 512 * j); } } }
    for (int ch = F.bx; ch < NTOK / 16; ch += F.G) {
        __syncthreads();
#define P6_ROW(vr, tt) do { const int tl = 2 * w + (tt); const size_t tok = (size_t)ch * 16 + tl; float ss = 0.f; f32x4 v[8]; \
            _Pragma("unroll") for (int j = 0; j < 8; ++j) { v[j] = (f32x4){bf_lo(vr[j].x), bf_hi(vr[j].x), bf_lo(vr[j].y), bf_hi(vr[j].y)}; ss += (v[j].x * v[j].x + v[j].y * v[j].y) + (v[j].z * v[j].z + v[j].w * v[j].w); } \
            const float rstd = 1.0f / sqrtf(wave_sum(ss) * (1.f / D) + EPS); unsigned char* o8 = h2 + tok * D; \
            _Pragma("unroll") for (int j = 0; j < 8; ++j) { const f32x4 y = v[j] * rstd;     \
                *(unsigned*)(o8 + (lofs >> 2) + 256 * j) = pk4_fp8(y.x, y.y, y.z, y.w); *(LAS f32x4*)(tile + tl * 8192 + (((lofs >> 4) ^ tl) << 4) + 1024 * j) = y; } } while (0)
        P6_ROW(va, 0); P6_ROW(vb, 1);
#undef P6_ROW
        __syncthreads();
        { const int chn = ch + F.G; if (chn < NTOK / 16) { const char* xa = (const char*)(x1 + ((size_t)chn * 16 + 2 * w) * D);
            const unsigned lo2 = (unsigned)lane_now() * 16u;
#pragma unroll
            for (int j = 0; j < 8; ++j) { va[j] = *(const u32x2*)(xa + (lo2 >> 1) + 512 * j); vb[j] = *(const u32x2*)(xa + 4096 + (lo2 >> 1) + 512 * j); } } }
        f32x4 a0 = {0.f, 0.f, 0.f, 0.f}, a1 = {0.f, 0.f, 0.f, 0.f};
        f32x4 ab[2][2];
        unsigned abase[4];
        { const int ln = lane_now(), rw = ln & 15, kk = ln >> 4;
#pragma unroll
          for (int q = 0; q < 4; ++q) abase[q] = (unsigned)(rw * 8192 + ((64 * w + ((4 * q + kk) ^ rw)) << 4)); }
#define P6_LDA(g) do { _Pragma("unroll") for (int q = 0; q < 2; ++q) { const int s_ = 2 * (g) + q; ab[(g) & 1][q] = *(const LAS f32x4*)(tile + abase[s_ & 3] + (s_ >> 2) * 256); } } while (0)
        P6_LDA(0);
#pragma unroll
        for (int g = 0; g < 8; ++g) {
            if (g < 7) P6_LDA(g + 1);
#pragma unroll
            for (int q = 0; q < 2; ++q)
#pragma unroll
                for (int i = 0; i < 4; ++i) { a0 = __builtin_amdgcn_mfma_f32_16x16x4f32(ab[g & 1][q][i], Breg[2 * g + q][i][0], a0, 0, 0, 0); a1 = __builtin_amdgcn_mfma_f32_16x16x4f32(ab[g & 1][q][i], Breg[2 * g + q][i][1], a1, 0, 0, 0); }
            __builtin_amdgcn_sched_barrier(0);
        }
#undef P6_LDA
#pragma unroll
        for (int j = 0; j < 4; ++j) { part[(w * 16 + 4 * kq + j) * 32 + row] = a0[j]; part[(w * 16 + 4 * kq + j) * 32 + 16 + row] = a1[j]; }
        __syncthreads();
        { const int tl = F.tid >> 5, e = F.tid & 31; float lg = br[e];
#pragma unroll
          for (int ww = 0; ww < 8; ++ww) lg += part[(ww * 16 + tl) * 32 + e];
          float tv[4]; int ti[4]; bool taken = false;
#pragma unroll
          for (int r = 0; r < 4; ++r) { float bv = taken ? -__builtin_inff() : lg; int bi = e;
#define P6_STEP(EXPR_F, EXPR_I) do { const float ov = __int_as_float(EXPR_F); const int oi = (EXPR_I); if (ov > bv || (ov == bv && oi < bi)) { bv = ov; bi = oi; } } while (0)
#define P6_DPP(v, c) __builtin_amdgcn_update_dpp((v), (v), (c), 0xf, 0xf, false)
              P6_STEP(P6_DPP(__float_as_int(bv), 0xB1), P6_DPP(bi, 0xB1));
              P6_STEP(P6_DPP(__float_as_int(bv), 0x4E), P6_DPP(bi, 0x4E));
              P6_STEP(P6_DPP(__float_as_int(bv), 0x141), P6_DPP(bi, 0x141));
              P6_STEP(P6_DPP(__float_as_int(bv), 0x140), P6_DPP(bi, 0x140));
              P6_STEP(__builtin_amdgcn_ds_swizzle(__float_as_int(bv), 0x401F), __builtin_amdgcn_ds_swizzle(bi, 0x401F));
#undef P6_STEP
#undef P6_DPP
              tv[r] = bv; ti[r] = bi; if (bi == e) taken = true; }
          const float e1 = __expf(tv[1] - tv[0]), e2 = __expf(tv[2] - tv[0]), e3 = __expf(tv[3] - tv[0]); const float inv = 1.0f / (1.0f + e1 + e2 + e3);
          if (e < 4) { const float wt = (e == 0 ? 1.0f : e == 1 ? e1 : e == 2 ? e2 : e3) * inv; const int ex = e == 0 ? ti[0] : e == 1 ? ti[1] : e == 2 ? ti[2] : ti[3];
              const int n = nasg * 64 + tl * 4 + e; asg[n * 4 + 0] = (unsigned)(ch * 16 + tl) * 4u + (unsigned)e; asg[n * 4 + 1] = (unsigned)ex; asg[n * 4 + 2] = __float_as_uint(wt); } }
        ++nasg;
        if (nasg == 8) {
            __syncthreads();
            const int tf = F.wave * 64 + lane_now();
            { const unsigned ex = asg[tf * 4 + 1]; asg[tf * 4 + 3] = __hip_atomic_fetch_add((LAS unsigned*)&hist[ex], 1u, __ATOMIC_RELAXED, __HIP_MEMORY_SCOPE_WORKGROUP); }
            __syncthreads();
            if (tf < 32) { const unsigned n = hist[tf]; hist[32 + tf] = n ? __hip_atomic_fetch_add((unsigned*)(F.ctl + CW_CNT + 64 * tf), n, RLX_AGENT) : 0u; }
            __syncthreads();
            { const unsigned tk = asg[tf * 4 + 0], ex = asg[tf * 4 + 1], wb = asg[tf * 4 + 2], pos = hist[32 + ex] + asg[tf * 4 + 3];
              ((int*)(F.ws + WS_LTOK))[(size_t)ex * LCAP + pos] = (int)(tk >> 2); ((unsigned*)(F.ws + WS_LW))[(size_t)ex * LCAP + pos] = wb;
              ((unsigned*)(F.ws + WS_TOKEP))[tk] = (ex << 16) | pos; }
            __syncthreads();
            if (tf < 64) hist[tf] = 0u;
            nasg = 0;
        }
    }
    if (nasg) {
        __syncthreads();
        const int tf = F.wave * 64 + lane_now();
        const bool act = tf < nasg * 64;
        if (act) { const unsigned ex = asg[tf * 4 + 1]; asg[tf * 4 + 3] = __hip_atomic_fetch_add((LAS unsigned*)&hist[ex], 1u, __ATOMIC_RELAXED, __HIP_MEMORY_SCOPE_WORKGROUP); }
        __syncthreads();
        if (tf < 32) { const unsigned n = hist[tf]; hist[32 + tf] = n ? __hip_atomic_fetch_add((unsigned*)(F.ctl + CW_CNT + 64 * tf), n, RLX_AGENT) : 0u; }
        __syncthreads();
        if (act) { const unsigned tk = asg[tf * 4 + 0], ex = asg[tf * 4 + 1], wb = asg[tf * 4 + 2], pos = hist[32 + ex] + asg[tf * 4 + 3];
          ((int*)(F.ws + WS_LTOK))[(size_t)ex * LCAP + pos] = (int)(tk >> 2); ((unsigned*)(F.ws + WS_LW))[(size_t)ex * LCAP + pos] = wb;
          ((unsigned*)(F.ws + WS_TOKEP))[tk] = (ex << 16) | pos; }
        __syncthreads();
    }
}

__device__ __forceinline__ int moe_tables(Frame& F) {
    LAS int* cnt = (LAS int*)(F.lds + TAB_OFF); LAS int* tstart = cnt + 32; LAS unsigned char* tile_e = (LAS unsigned char*)(F.lds + TAB_OFF + 384);
    __syncthreads();
    if (F.tid < 32) cnt[F.tid] = (int)__hip_atomic_load((unsigned*)(F.ctl + CW_CNT + 64 * F.tid), RLX_AGENT);
    __syncthreads();
    if (F.tid == 0) { int s = 0; for (int e = 0; e < NE; ++e) { tstart[e] = s; s += (cnt[e] + 255) >> 8; } tstart[NE] = s; }
    __syncthreads();
    const int TT = tstart[NE];
    for (int t = F.tid; t < TT; t += 512) { int e = 0;
#pragma unroll
        for (int k = 1; k < NE; ++k) e += (tstart[k] <= t) ? 1 : 0;
        tile_e[t] = (unsigned char)e; }
    __syncthreads();
    return TT;
}

#define f8lo(w, b) __builtin_amdgcn_cvt_f32_fp8((int)(w), b)
__device__ __forceinline__ void p9_combine(Frame& F) {
    const LAS int* tstart = (const LAS int*)(F.lds + TAB_OFF) + 32;
    const unsigned char* Y = (const unsigned char*)(F.ws + WS_Y); const unsigned* tokep = (const unsigned*)(F.ws + WS_TOKEP);
    const int gw = F.bx * NWAVES + F.wave, NGW = F.G * NWAVES, lane = F.lane;
    for (int t0 = gw; t0 < NTOK; t0 += 16 * NGW) {
        const int tk = t0 + (lane & 15) * NGW; u32x4 ep = {0u, 0u, 0u, 0u};
        if (tk < NTOK) ep = *(const u32x4*)(tokep + (size_t)tk * 4);
        unsigned so0 = (unsigned)tstart[ep.x >> 16] * 256u + (ep.x & 0xffffu), so1 = (unsigned)tstart[ep.y >> 16] * 256u + (ep.y & 0xffffu);
        unsigned so2 = (unsigned)tstart[ep.z >> 16] * 256u + (ep.z & 0xffffu), so3 = (unsigned)tstart[ep.w >> 16] * 256u + (ep.w & 0xffffu);
#pragma unroll 2
        for (int k = 0; k < 16; ++k) {
            const int t = t0 + k * NGW; if (t >= NTOK) break;
            const size_t s0 = (size_t)__builtin_amdgcn_readlane((int)so0, k), s1 = (size_t)__builtin_amdgcn_readlane((int)so1, k), s2 = (size_t)__builtin_amdgcn_readlane((int)so2, k), s3 = (size_t)__builtin_amdgcn_readlane((int)so3, k);
            float* xo = F.out + (size_t)t * D; const bf16_t* xi = (const bf16_t*)(F.ws + WS_X1B) + (size_t)t * D;
            u32x2 y0[4], y1[4], y2[4], y3[4]; f32x4 a[4], b[4];
#pragma unroll
            for (int j = 0; j < 4; ++j) { const int c = (lane + 64 * j) * 8;
                y0[j] = *(const u32x2*)(Y + s0 * D + c); y1[j] = *(const u32x2*)(Y + s1 * D + c); y2[j] = *(const u32x2*)(Y + s2 * D + c); y3[j] = *(const u32x2*)(Y + s3 * D + c);
                const u32x4 xw = *(const u32x4*)(xi + c); a[j] = (f32x4){bf_lo(xw.x), bf_hi(xw.x), bf_lo(xw.y), bf_hi(xw.y)}; b[j] = (f32x4){bf_lo(xw.z), bf_hi(xw.z), bf_lo(xw.w), bf_hi(xw.w)}; }
#pragma unroll
            for (int j = 0; j < 4; ++j) { const int c = (lane + 64 * j) * 8;
#define Y4(w, i) ((f8lo(y0[j].w, i) + f8lo(y1[j].w, i)) + (f8lo(y2[j].w, i) + f8lo(y3[j].w, i))) * 0.0625f
                a[j].x += Y4(x, 0); a[j].y += Y4(x, 1); a[j].z += Y4(x, 2); a[j].w += Y4(x, 3);
                b[j].x += Y4(y, 0); b[j].y += Y4(y, 1); b[j].z += Y4(y, 2); b[j].w += Y4(y, 3);
#undef Y4
                *(f32x4*)(xo + c) = a[j]; *(f32x4*)(xo + c + 4) = b[j]; }
        }
    }
}

struct Args { const float* in[20]; float* out; unsigned char* ws; int ph_lo, ph_hi, li, pad; };
__global__ void __launch_bounds__(NWAVES * 64, 2) mk_fwd(Args args) {
    extern __shared__ __attribute__((aligned(16))) unsigned char lds[];
    Frame F;
    F.lds = (LAS unsigned char*)lds;
    F.MISC = (volatile LAS unsigned*)(F.lds + MISC_OFF);
    F.tid = threadIdx.x; F.lane = F.tid & 63; F.wave = __builtin_amdgcn_readfirstlane(F.tid >> 6);
    F.G = gridDim.x; F.bx = blockIdx.x;
    F.out = args.out; F.ws = args.ws; F.ctl = (gu32*)(args.ws + WS_CTL);
    for (int u = F.tid; u < (LDS_BYTES - LDSCTL_OFF) / 4; u += NWAVES * 64) ((LAS unsigned*)(F.lds + LDSCTL_OFF))[u] = 0u;
    __syncthreads();
    XcdBarrier bar; bar.bar = (unsigned*)(F.ctl + CW_BAR); bar.x = 0; bar.st = nullptr;
    if (N_LAUNCHES != PER_PHASE) bar = xcd_barrier_post((unsigned*)(F.ctl + CW_BAR), F.MISC + 8, F.tid == 0);
#define GRID_BAR(seam) do { if (N_LAUNCHES == PER_PHASE) { if (F.tid == 0) __hip_atomic_store(F.ctl + CW_TMO, 0xBADBA0u | (unsigned)(seam), RLX_AGENT); } else { xcd_barrier(bar, F.wave == 0 && lane_now() == 0); } } while (0)
    const int lo = args.ph_lo, hi = args.ph_hi;
#ifndef PH_MASK
#define PH_MASK 0x3ff
#endif
#define IN(k) (((PH_MASK >> (k)) & 1) && lo <= (k) && (k) < hi)
#define BOTH(k) (IN(k) && IN((k) + 1))
#define REFRESH() do { F.lane = lane_now(); F.tid = F.wave * 64 + F.lane; } while (0)
    unsigned char* ws = args.ws;

    if (IN(0)) { REFRESH(); p0_prologue(F); if (BOTH(0)) GRID_BAR(0); }

    if (IN(1)) { REFRESH();
        pg8::Gemm g{ws + WS_H, ws + WS_WIN, D, F8_ONE, F8_W}; pg8::StaticOrder S; S.init(NTOK, NCOLS, F.G, F.bx);
        pg8::EpiProj E{ws};
        pg8::gemm_phase<pg8::EpiProj, pg8::StaticOrder, true, true>(F.lds + RING_OFF, g, S, E, F.wave);
        if (BOTH(1)) GRID_BAR(1);
    }
    if (IN(2)) { REFRESH(); p2_qknorm(F); if (BOTH(2)) GRID_BAR(2); }
    if (IN(3)) { REFRESH(); p3_attention(F, (char*)lds + RING_OFF); if (BOTH(3)) GRID_BAR(3); }
    if (IN(4)) { REFRESH();
        { pg8::Gemm g{ws + WS_YA, ws + WS_WPA, 1024, F8_Y, F8_W, (long long)(WS_YB - WS_YA), (long long)(WS_WPB - WS_WPA)}; pg8::StaticOrder S; S.init(NTOK, D, F.G, F.bx);
          pg8::EpiGateDual E{(unsigned char*)(ws + WS_MERGED8), (const unsigned char*)(ws + WS_G)};
          pg8::gemm_phase<pg8::EpiGateDual, pg8::StaticOrder, true, true, true>(F.lds + RING_OFF, g, S, E, F.wave); }
        if (BOTH(4)) GRID_BAR(4);
    }
    if (IN(5)) { REFRESH();
        pg8::Gemm g{ws + WS_MERGED8, ws + WS_WOUT, D, F8_M, F8_W}; pg8::StaticOrder S; S.init(NTOK, D, F.G, F.bx);
        pg8::EpiResidB E{inp(0), (bf16_t*)(ws + WS_X1B), D};
        pg8::gemm_phase<pg8::EpiResidB, pg8::StaticOrder, true, true>(F.lds + RING_OFF, g, S, E, F.wave);
        if (BOTH(5)) GRID_BAR(5);
    }
    if (IN(6)) { REFRESH(); p6_router(F); if (BOTH(6)) GRID_BAR(6); }
    if (IN(7)) { REFRESH();
        const int TT = moe_tables(F);
        const LAS int* cnt = (const LAS int*)(F.lds + TAB_OFF);
        pg8::Gemm g{ws + WS_H8, ws + WS_WGU, D, F8_ONE, F8_W};
        pg8::MoeOrder S{cnt, cnt + 32, (const LAS unsigned char*)(F.lds + TAB_OFF + 384), TT, 16, F.G, F.bx, (const int*)(ws + WS_LTOK), true, (size_t)4096};
        pg8::EpiSwiglu E{(unsigned char*)(ws + WS_ACT), inp(15), inp(17)};
        pg8::gemm_phase<pg8::EpiSwiglu, pg8::MoeOrder, true, true>(F.lds + RING_OFF, g, S, E, F.wave);
        if (BOTH(7)) GRID_BAR(7);
    }
    if (IN(8)) { REFRESH();
        const int TT = moe_tables(F);
        const LAS int* cnt = (const LAS int*)(F.lds + TAB_OFF);
        pg8::Gemm g{ws + WS_ACT, ws + WS_WD, DE, F8_ONE, F8_W};
        pg8::MoeOrder S{cnt, cnt + 32, (const LAS unsigned char*)(F.lds + TAB_OFF + 384), TT, 8, F.G, F.bx, (const int*)(ws + WS_LTOK), false, (size_t)2048};
        pg8::EpiDown E{(unsigned char*)(ws + WS_Y), inp(19), (const float*)(ws + WS_LW), cnt + 32};
        pg8::gemm_phase<pg8::EpiDown, pg8::MoeOrder, true, true>(F.lds + RING_OFF, g, S, E, F.wave);
        if (BOTH(8)) GRID_BAR(8);
    }
    if (IN(9)) { REFRESH(); (void)moe_tables(F); p9_combine(F); }
#undef IN
#undef BOTH
}

extern "C" void kernel_launch(void* const* d_in, const int* in_sizes, int n_in, void* d_out, int out_size, void* d_ws, size_t ws_size, hipStream_t stream) {
    static int grid = 0;
    if (grid == 0) {
        if (n_in != 20 || out_size != NTOK * D || ws_size < WS_END) { fprintf(stderr, "kernel_launch: shape mismatch n_in %d out %d ws %zu (need %zu)\n", n_in, out_size, ws_size, (size_t)WS_END); grid = -1; return; }
        int dev = 0, cus = 0, per_cu = 0;
        if (hipGetDevice(&dev) != hipSuccess || hipDeviceGetAttribute(&cus, hipDeviceAttributeMultiprocessorCount, dev) != hipSuccess) { grid = -1; return; }
        if (hipFuncSetAttribute((const void*)mk_fwd, hipFuncAttributeMaxDynamicSharedMemorySize, LDS_BYTES) != hipSuccess) { fprintf(stderr, "kernel_launch: hipFuncSetAttribute failed\n"); grid = -1; return; }
        if (hipOccupancyMaxActiveBlocksPerMultiprocessor(&per_cu, (const void*)mk_fwd, NWAVES * 64, LDS_BYTES) != hipSuccess || per_cu < 1) fprintf(stderr, "kernel_launch: occupancy query reports %d\n", per_cu);
        (void)hipGetLastError();
        grid = cus < 256 ? cus : 256;
    }
    if (grid < 0) return;
    if (hipMemsetAsync((char*)d_ws + WS_CTL, 0, CTL_ZERO_BYTES, stream) != hipSuccess) return;
    Args a{};
    for (int i = 0; i < 20; ++i) a.in[i] = (const float*)d_in[i];
    a.out = (float*)d_out; a.ws = (unsigned char*)d_ws;
    for (int li = 0; li < N_LAUNCHES; ++li) {
        a.ph_lo = (N_LAUNCHES == PER_PHASE) ? li : 0; a.ph_hi = (N_LAUNCHES == PER_PHASE) ? li + 1 : PER_PHASE; a.li = li; a.pad = 0;
        for (int rep = 0; rep < ((N_LAUNCHES == PER_PHASE && li == DUP_PHASE) ? DUP_TIMES : 1) - 1; ++rep) hipLaunchKernelGGL(mk_fwd, dim3(grid), dim3(NWAVES * 64), LDS_BYTES, stream, a);
        hipLaunchKernelGGL(mk_fwd, dim3(grid), dim3(NWAVES * 64), LDS_BYTES, stream, a);
        const hipError_t le = hipPeekAtLastError();
        if (le != hipSuccess) { fprintf(stderr, "kernel_launch: launch %d failed: %s\n", li, hipGetErrorName(le)); break; }
    }
}
```

```cpp
#include <hip/hip_runtime.h>
#include <cstdio>
#include <cstdint>

#ifndef MK_N_LAUNCHES
#define MK_N_LAUNCHES 1
#endif
#ifndef DUP_PHASE
#define DUP_PHASE -1
#endif
#ifndef DUP_TIMES
#define DUP_TIMES 2
#endif
constexpr int PER_PHASE = 10;
constexpr int N_LAUNCHES = MK_N_LAUNCHES;

#define GAS __attribute__((address_space(1)))
#define LAS __attribute__((address_space(3)))
typedef unsigned short bf16_t;
typedef short bf16x8 __attribute__((ext_vector_type(8)));
typedef short s16x4 __attribute__((ext_vector_type(4)));
typedef float f32x2 __attribute__((ext_vector_type(2)));
typedef float f32x4 __attribute__((ext_vector_type(4)));
typedef float f32x8 __attribute__((ext_vector_type(8)));
typedef float f32x16 __attribute__((ext_vector_type(16)));
typedef unsigned u32x2 __attribute__((ext_vector_type(2)));
typedef unsigned u32x4 __attribute__((ext_vector_type(4)));
typedef int i32x2 __attribute__((ext_vector_type(2)));
typedef int i32x4 __attribute__((ext_vector_type(4)));
typedef int i32x8 __attribute__((ext_vector_type(8)));
typedef GAS unsigned gu32;
constexpr int F8_ONE = 127, F8_W = 121, F8_Y = 121, F8_M = 123;
constexpr float F8_WMUL = 64.0f, F8_YMUL = 64.0f, F8_MMUL = 16.0f;

constexpr int D = 2048, NTOK = 32768, SEQ = 16384, GW = 64, ROWS = 256, HD = 128;
constexpr int NCOLS = 8704;
constexpr int C_QA = 0, C_KA = 1024, C_VA = 1280, C_QB = 1536, C_KB = 2560, C_VB = 3584, C_GA = 4608, C_GB = 6656;
constexpr int NE = 32, DE = 2048, LCAP = 32768;
constexpr int MAXT = 544;
constexpr float EPS = 1e-6f;
constexpr int NWAVES = 8;

constexpr size_t MiB = 1u << 20;
constexpr size_t WS_CTL = 0, CTL_ZERO_BYTES = 1 * MiB;
constexpr size_t WS_TAB = 1 * MiB;
constexpr size_t WS_TOKEP = 1 * MiB + 128 * 1024;
constexpr size_t WS_LTOK = 2 * MiB;
constexpr size_t WS_LW = 6 * MiB;
constexpr size_t WS_WIN = 10 * MiB;
constexpr size_t WS_WPA = 44 * MiB, WS_WPB = 48 * MiB, WS_WOUT = 52 * MiB;
constexpr size_t WS_WD = 64 * MiB;
constexpr size_t WS_WGU = 320 * MiB;
constexpr size_t WS_MERGED = 832 * MiB;
constexpr size_t WS_X1B = 832 * MiB;
constexpr size_t WS_MERGED8 = 1760 * MiB;
constexpr size_t WS_Y = 320 * MiB;
constexpr size_t WS_H = 960 * MiB;
constexpr size_t WS_H8 = 1024 * MiB;
constexpr size_t WS_PROJ = 1088 * MiB;
constexpr size_t WS_QA = WS_PROJ, WS_KA = WS_PROJ + 64 * MiB, WS_VA = WS_PROJ + 80 * MiB, WS_QB = WS_PROJ + 96 * MiB, WS_KB = WS_PROJ + 160 * MiB, WS_VB = WS_PROJ + 224 * MiB, WS_G = WS_PROJ + 288 * MiB;
constexpr size_t WS_ACT = 1088 * MiB;
constexpr size_t WS_YA = 1632 * MiB, WS_YB = 1696 * MiB;
constexpr size_t WS_Q8 = 1824 * MiB;
constexpr size_t WS_K8 = 1856 * MiB;
constexpr size_t WS_VT8 = 1864 * MiB;
constexpr size_t WS_END = 1872 * MiB;
static_assert(WS_Y + (size_t)MAXT * 256 * 2048 * 2 <= WS_H && WS_ACT + (size_t)MAXT * 256 * 2048 * 2 <= WS_YA, "ws map");
static_assert(WS_Y + (size_t)MAXT * 256 * 2048 <= WS_X1B && WS_X1B + (size_t)NTOK * D * 2 <= WS_H, "ws map: fp8 Y below the bf16 residual stream");
constexpr int CW_TMO = 0, CW_CODE = 1;
constexpr int CW_BAR = 4096;
constexpr int CW_CNT = 16384;

constexpr int RING_OFF = 0, RING_BYTES = 131072;
constexpr int PART_OFF = 131072;
constexpr int ASG_OFF = 147456;
constexpr int TAB_OFF = 155648;
constexpr int HIST_OFF = 156672;
constexpr int MISC_OFF = 156928;
constexpr int LDS_BYTES = 157696;
constexpr int LDSCTL_OFF = HIST_OFF;

#define RLX_AGENT __ATOMIC_RELAXED, __HIP_MEMORY_SCOPE_AGENT
#define LDS_WAIT() asm volatile("s_waitcnt lgkmcnt(0)" ::: "memory")
#define VM_WAIT() asm volatile("s_waitcnt vmcnt(0)" ::: "memory")
__device__ __forceinline__ unsigned cvt_pk_bf16(float lo, float hi) { unsigned r; asm volatile("v_cvt_pk_bf16_f32 %0, %1, %2" : "=v"(r) : "v"(lo), "v"(hi)); return r; }
__device__ __forceinline__ unsigned f6_e2m3(float v) {
    const float y = fminf(__builtin_fabsf(v), 7.5f);
    const unsigned eb = __float_as_uint(fmaxf(y, 1.0f)) >> 23;
    const float q = __builtin_rintf(y * __uint_as_float((257u - eb) << 23));
    return ((unsigned)(int)q + 8u * eb - 1016u) | ((__float_as_uint(v) >> 26) & 32u);
}
__device__ __forceinline__ unsigned f6x4_bytes(float a, float b, float c, float d, float mul) {
    const float lim = 7.5f * 0.015625f, m = mul * 0.015625f;
    int w = __builtin_amdgcn_cvt_pk_fp8_f32(__builtin_amdgcn_fmed3f(a * m, -lim, lim), __builtin_amdgcn_fmed3f(b * m, -lim, lim), 0, false);
    w = __builtin_amdgcn_cvt_pk_fp8_f32(__builtin_amdgcn_fmed3f(c * m, -lim, lim), __builtin_amdgcn_fmed3f(d * m, -lim, lim), w, true);
    return ((unsigned)w & 0x1f1f1f1fu) | (((unsigned)w >> 2) & 0x20202020u);
}
__device__ __forceinline__ unsigned f6pack24(unsigned t) { return (t & 0x3fu) | ((t >> 2) & 0xfc0u) | ((t >> 4) & 0x3f000u) | ((t >> 6) & 0xfc0000u); }
__device__ __forceinline__ unsigned pk4_fp8(float a, float b, float c, float d) { int w = __builtin_amdgcn_cvt_pk_fp8_f32(a, b, 0, false); w = __builtin_amdgcn_cvt_pk_fp8_f32(c, d, w, true); return (unsigned)w; }
__device__ __forceinline__ int lane_now() { int l; asm volatile("v_mbcnt_lo_u32_b32 %0, -1, 0\n\tv_mbcnt_hi_u32_b32 %0, -1, %0" : "=v"(l)); return l; }
__device__ __forceinline__ float bf_lo(unsigned w) { return __uint_as_float(w << 16); }
__device__ __forceinline__ float bf_hi(unsigned w) { return __uint_as_float(w & 0xffff0000u); }
__device__ __forceinline__ float sigmoidf_(float x) { return __builtin_amdgcn_rcpf(1.0f + __builtin_amdgcn_exp2f(-1.4426950408889634f * x)); }

namespace pg8 {
constexpr int BM = 256, BK = 64, HALF = 128, HTB = HALF * BK * 2, STAGE_BYTES = 8 * HTB, NXCD = 8, WGM = 8;
__host__ __device__ __forceinline__ int lds_byte(int r, int c) { const int st = (r >> 4) * 2 + (c >> 5), rr = r & 15, cc = c & 31, ob = rr * 64 + cc * 2; return st * 1024 + (ob ^ (((ob >> 9) & 1) << 5)); }
__host__ __device__ __forceinline__ void stage_rc(int b, int& R, int& C) { const int st = b / 1024, sb = b % 1024, swz = sb ^ (((sb >> 9) & 1) << 5); R = (st >> 1) * 16 + swz / 64; C = (st & 1) * 32 + (swz % 64) / 2; }
__host__ __device__ __forceinline__ int perm32(int rho) { const int n = rho >> 4, i = rho & 15; return 8 * (i >> 2) + 4 * n + (i & 3); }

struct Unit { int pm, pn, e, cnt; };
struct Gemm { const void* A; const void* Bt; int rb; int sa, sb; long long dA = 0, dB = 0; };

__device__ __forceinline__ bool tile_order(int i, int G, int c, int nM, int nN, int& pm, int& pn) {
    const int nwg = nM * nN; const long L = (long)i * G + c; if (L >= nwg) return false;
    int wgid = (int)L; { const int q = nwg / NXCD, r = nwg % NXCD, xcd = wgid % NXCD, off = wgid / NXCD; wgid = (xcd < r ? xcd * (q + 1) : r * (q + 1) + (xcd - r) * q) + off; }
    const int nig = WGM * nN, gid = wgid / nig, fm = gid * WGM, gsz = (nM - fm) < WGM ? (nM - fm) : WGM;
    pm = fm + ((wgid % nig) % gsz); pn = (wgid % nig) / gsz; return true;
}
struct StaticOrder {
    int nM, nN, G, c;
    __device__ void init(int M, int N, int G_, int c_) { nM = M / BM; nN = N / BM; G = G_; c = c_; }
    __device__ __forceinline__ bool next(int i, Unit& u) const { u.e = 0; u.cnt = 256; return tile_order(i, G, c, nM, nN, u.pm, u.pn); }
    __device__ __forceinline__ void a_offs(const Gemm& g, const Unit& u, const int (&R)[2], const int (&C)[2], unsigned (&ao)[2][2]) const {
#pragma unroll
        for (int h = 0; h < 2; ++h)
#pragma unroll
            for (int i = 0; i < 2; ++i) ao[h][i] = (unsigned)((u.pm * BM + h * HALF + R[i]) * g.rb + C[i] * 2);
    }
    __device__ __forceinline__ const char* b_ptr(const Gemm& g, const Unit& u) const { return (const char*)g.Bt + (size_t)u.pn * BM * g.rb; }
};

template <class Epi, class Sched, bool ALIGN_EPI, bool FP8 = false, bool DUAL = false>
__device__ __forceinline__ void gemm_phase(LAS unsigned char* lds, const Gemm g, const Sched& S, const Epi& E, const int wid) {
    const int lane = lane_now(), tid = wid * 64 + lane, wr = wid >> 2, wc = wid & 3, fr = lane & 15, fq = lane >> 4;
    const int rb = g.rb, nt1 = rb / (BK * 2), nt = DUAL ? 2 * nt1 : nt1;
    unsigned voffB[2]; int RR[2], CC[2];
#pragma unroll
    for (int i = 0; i < 2; ++i) { int R, C; stage_rc(tid * 16 + i * 8192, R, C); const int Rb = Epi::PERM ? ((R & ~31) + perm32(R & 31)) : R;
        RR[i] = R; CC[i] = C; voffB[i] = (unsigned)(Rb * rb + C * 2); }
    const size_t kstep = (size_t)(BK * 2);
    const size_t hstep = (size_t)HALF * rb;
    const unsigned ldsw = (unsigned)wid * 1024u;
    const int aoff = lds_byte(wr * 64 + fr, fq * 8), boff = lds_byte(wc * 32 + fr, fq * 8);
#define PG8_SA(b, h) (((b) * 2 + (h)) * HTB)
#define PG8_SB(b, h) ((4 + (b) * 2 + (h)) * HTB)
#define PG8_STAGE(bufoff, gbase, voff) do { _Pragma("unroll") for (int _i = 0; _i < 2; ++_i) \
        __builtin_amdgcn_global_load_lds((const unsigned*)((const char*)(gbase) + (voff)[_i]), (LAS unsigned*)(lds + (bufoff) + ldsw + _i * 8192), 16, 0, 0); } while (0)
#define PG8_STAGE_A(bufoff, kb, ao, h) PG8_STAGE(bufoff, (const char*)g.A + (kb), (ao)[h])
#define PG8_LDA(dst, b, h) do { _Pragma("unroll") for (int m = 0; m < 4; ++m) { if constexpr (FP8) { const i32x4 lo_ = *(const LAS i32x4*)(lds + PG8_SA(b, h) + aoff + m * 2048), hi_ = *(const LAS i32x4*)(lds + PG8_SA(b, h) + aoff + m * 2048 + 1024); \
            dst##8[m] = __builtin_shufflevector(lo_, hi_, 0, 1, 2, 3, 4, 5, 6, 7); } else { _Pragma("unroll") for (int k = 0; k < 2; ++k) dst[m][k] = *(const LAS bf16x8*)(lds + PG8_SA(b, h) + aoff + m * 2048 + k * 1024); } } } while (0)
#define PG8_LDB(dst, b, h) do { _Pragma("unroll") for (int n = 0; n < 2; ++n) { if constexpr (FP8) { const i32x4 lo_ = *(const LAS i32x4*)(lds + PG8_SB(b, h) + boff + n * 2048), hi_ = *(const LAS i32x4*)(lds + PG8_SB(b, h) + boff + n * 2048 + 1024); \
            dst##8[n] = __builtin_shufflevector(lo_, hi_, 0, 1, 2, 3, 4, 5, 6, 7); } else { _Pragma("unroll") for (int k = 0; k < 2; ++k) dst[n][k] = *(const LAS bf16x8*)(lds + PG8_SB(b, h) + boff + n * 2048 + k * 1024); } } } while (0)
#define PG8_MMA(ai, bj, At, Bt) do { __builtin_amdgcn_s_setprio(1); if constexpr (FP8) { asm volatile("s_nop 1" ::: "memory"); }     \
          \
        _Pragma("unroll") for (int m_ = 0; m_ < 4; ++m_) _Pragma("unroll") for (int n_ = 0; n_ < 2; ++n_) { const int m = (bj) ? 3 - m_ : m_, n = (m_ & 1) ? 1 - n_ : n_; \
        if constexpr (FP8) { asm volatile("v_mfma_scale_f32_16x16x128_f8f6f4 %0, %1, %2, %0, %3, %4 op_sel_hi:[0,0,0]" : "+v"(acc[ai][bj][m][n]) : "v"(Bt##8[n]), "v"(At##8[m]), "v"(sclB), "v"(sclA)); } \
        else { _Pragma("unroll") for (int k = 0; k < 2; ++k) acc[ai][bj][m][n] = __builtin_amdgcn_mfma_f32_16x16x32_bf16(Bt[n][k], At[m][k], acc[ai][bj][m][n], 0, 0, 0); } } \
        __builtin_amdgcn_s_setprio(0); } while (0)
#define PG8_WAIT_V(n) asm volatile("s_waitcnt vmcnt(" #n ")" ::: "memory")
#define PG8_WAIT_L(n) asm volatile("s_waitcnt lgkmcnt(" #n ")" ::: "memory")
#define PG8_BAR __builtin_amdgcn_s_barrier()
#define PG8_SCHED __builtin_amdgcn_sched_barrier(0)
    Unit cur, nxt; int ui = 0;
    if (!S.next(0, cur)) return;
    f32x4 acc[2][2][4][2];
#pragma unroll
    for (int a = 0; a < 2; ++a)
#pragma unroll
        for (int b = 0; b < 2; ++b)
#pragma unroll
            for (int m = 0; m < 4; ++m)
#pragma unroll
                for (int n = 0; n < 2; ++n) acc[a][b][m][n] = (f32x4){0.f, 0.f, 0.f, 0.f};
    bf16x8 At[4][2], B0[2][2], B1[2][2]; i32x8 At8[4], B08[2], B18[2];
    int sclA = g.sa, sclB = g.sb; if constexpr (FP8) { asm volatile("" : "+v"(sclA), "+v"(sclB)); }
    unsigned aoC[2][2], aoN[2][2];
    S.a_offs(g, cur, RR, CC, aoC);
    const char* cB = S.b_ptr(g, cur);
    PG8_STAGE(PG8_SB(0, 0), cB, voffB); PG8_STAGE(PG8_SB(0, 1), cB + hstep, voffB); PG8_STAGE_A(PG8_SA(0, 0), 0, aoC, 0); PG8_STAGE_A(PG8_SA(0, 1), 0, aoC, 1);
    if (wr == 1) PG8_BAR;
    PG8_WAIT_V(2); PG8_BAR;
    PG8_STAGE(PG8_SB(1, 0), cB + kstep, voffB); PG8_STAGE_A(PG8_SA(1, 0), kstep, aoC, 0); PG8_STAGE(PG8_SB(1, 1), cB + hstep + kstep, voffB);
    PG8_WAIT_V(6); PG8_BAR;
    for (;;) {
        const bool has_next = S.next(ui + 1, nxt);
        const char* nB = cB;
#pragma unroll
        for (int h = 0; h < 2; ++h)
#pragma unroll
            for (int i = 0; i < 2; ++i) aoN[h][i] = aoC[h][i];
        if (has_next) { S.a_offs(g, nxt, RR, CC, aoN); nB = S.b_ptr(g, nxt); }
        for (int t = 0; t < nt; t += 2) {
            const bool last = (t == nt - 2);
            if constexpr (DUAL) { if (t == nt1) { asm volatile("s_nop 15\n\ts_nop 15" ::: "memory"); if (wr == 0) PG8_BAR; E.mid(acc, cur, wr, wc, fr, fq); asm volatile("s_nop 7" ::: "memory"); if (wr == 1) PG8_BAR; } }
            size_t k1 = (size_t)(t + 1) * kstep, kk2 = (size_t)(t + 2) * kstep, kb2 = kk2;
            if constexpr (DUAL) { if (t >= nt1) k1 = (size_t)g.dA + (size_t)(t + 1 - nt1) * kstep;
                                  if (t + 2 >= nt1) { kk2 = (size_t)g.dA + (size_t)(t + 2 - nt1) * kstep; kb2 = (size_t)g.dB + (size_t)(t + 2 - nt1) * kstep; } }
            const size_t k2 = last ? 0 : kk2, k3 = k2 + kstep;
            const char* b2 = last ? nB : cB + kb2; const char* b3 = b2 + kstep;
            unsigned ao2[2][2];
#pragma unroll
            for (int h = 0; h < 2; ++h)
#pragma unroll
                for (int i = 0; i < 2; ++i) ao2[h][i] = last ? aoN[h][i] : aoC[h][i];
            PG8_LDB(B0, 0, 0); PG8_LDB(B1, 0, 1); PG8_SCHED; PG8_LDA(At, 0, 0); PG8_STAGE_A(PG8_SA(1, 1), k1, aoC, 1);
            PG8_WAIT_V(8); PG8_WAIT_L(0); PG8_BAR; PG8_MMA(0, 0, At, B0); PG8_MMA(0, 1, At, B1); PG8_BAR; PG8_SCHED;
            PG8_LDA(At, 0, 1); PG8_STAGE(PG8_SB(0, 0), b2, voffB); PG8_STAGE(PG8_SB(0, 1), b2 + hstep, voffB); PG8_STAGE_A(PG8_SA(0, 0), k2, ao2, 0);
            PG8_WAIT_V(8); PG8_WAIT_L(0); PG8_BAR; PG8_MMA(1, 0, At, B0); PG8_MMA(1, 1, At, B1); PG8_BAR; PG8_SCHED;
            PG8_LDB(B0, 1, 0); PG8_LDB(B1, 1, 1); PG8_SCHED; PG8_LDA(At, 1, 0); PG8_STAGE_A(PG8_SA(0, 1), k2, ao2, 1);
            PG8_WAIT_V(8); PG8_WAIT_L(0); PG8_BAR; PG8_MMA(0, 0, At, B0); PG8_MMA(0, 1, At, B1); PG8_BAR; PG8_SCHED;
            PG8_LDA(At, 1, 1); PG8_STAGE(PG8_SB(1, 0), b3, voffB); PG8_STAGE(PG8_SB(1, 1), b3 + hstep, voffB); PG8_STAGE_A(PG8_SA(1, 0), k3, ao2, 0);
            PG8_WAIT_V(8); PG8_WAIT_L(0); PG8_BAR; PG8_MMA(1, 0, At, B0); PG8_MMA(1, 1, At, B1); PG8_BAR; PG8_SCHED;
        }
        if constexpr (FP8) { asm volatile("s_nop 15\n\ts_nop 15" ::: "memory"); }
        if constexpr (ALIGN_EPI) { if (wr == 0) PG8_BAR; }
        E(acc, cur, wr, wc, fr, fq);
        if (!has_next) break;
#pragma unroll
        for (int a = 0; a < 2; ++a)
#pragma unroll
            for (int b = 0; b < 2; ++b)
#pragma unroll
                for (int m = 0; m < 4; ++m)
#pragma unroll
                    for (int n = 0; n < 2; ++n) acc[a][b][m][n] = (f32x4){0.f, 0.f, 0.f, 0.f};
        cur = nxt; cB = nB; ++ui;
#pragma unroll
        for (int h = 0; h < 2; ++h)
#pragma unroll
            for (int i = 0; i < 2; ++i) aoC[h][i] = aoN[h][i];
        if constexpr (ALIGN_EPI) { if (wr == 1) PG8_BAR; }
    }
    PG8_WAIT_V(0);
    if constexpr (!ALIGN_EPI) { if (wr == 0) PG8_BAR; }
    PG8_BAR;
#undef PG8_SA
#undef PG8_SB
#undef PG8_STAGE
#undef PG8_STAGE_A
#undef PG8_LDA
#undef PG8_LDB
#undef PG8_MMA
#undef PG8_WAIT_V
#undef PG8_WAIT_L
#undef PG8_BAR
#undef PG8_SCHED
}

struct EpiBf16 {
    static constexpr bool PERM = true;
    bf16_t* O; int ldc;
    __device__ __forceinline__ void operator()(const f32x4 (&acc)[2][2][4][2], const Unit& u, int wr, int wc, int fr, int fq) const {
        const int row0 = u.pm * BM + wr * 64 + fr, col0 = u.pn * BM + wc * 32 + 8 * fq;
#pragma unroll
        for (int ai = 0; ai < 2; ++ai)
#pragma unroll
            for (int m = 0; m < 4; ++m) { bf16_t* rowp = O + (size_t)(row0 + ai * HALF + m * 16) * ldc + col0;
#pragma unroll
                for (int bj = 0; bj < 2; ++bj) { const f32x4 v0 = acc[ai][bj][m][0], v1 = acc[ai][bj][m][1];
                    u32x4 w; w.x = cvt_pk_bf16(v0[0], v0[1]); w.y = cvt_pk_bf16(v0[2], v0[3]); w.z = cvt_pk_bf16(v1[0], v1[1]); w.w = cvt_pk_bf16(v1[2], v1[3]);
                    *(u32x4*)(rowp + bj * HALF) = w; } }
    }
};
struct EpiProj {
    static constexpr bool PERM = true;
    unsigned char* ws;
    __device__ __forceinline__ void operator()(const f32x4 (&acc)[2][2][4][2], const Unit& u, int wr, int wc, int fr, int fq) const {
        const int pn = u.pn; size_t base; int H, h0; bool gate = false;
        if (pn < 4) { base = WS_QA; H = 8; h0 = 2 * pn; } else if (pn == 4) { base = WS_KA; H = 2; h0 = 0; } else if (pn == 5) { base = WS_VA; H = 2; h0 = 0; }
        else if (pn < 10) { base = WS_QB; H = 8; h0 = 2 * (pn - 6); } else if (pn < 14) { base = WS_KB; H = 8; h0 = 2 * (pn - 10); } else if (pn < 18) { base = WS_VB; H = 8; h0 = 2 * (pn - 14); }
        else { base = WS_G; H = 0; h0 = 0; gate = true; }
        const int row0 = u.pm * BM + wr * 64 + fr, cl = wc * 32 + 8 * fq;
        bf16_t* O = (bf16_t*)(ws + base); const size_t bjs = gate ? (size_t)HALF : (size_t)SEQ * HD;
        if (gate) O += (size_t)(pn - 18) * BM + cl; else O += (size_t)h0 * SEQ * HD + cl;
#pragma unroll
        for (int ai = 0; ai < 2; ++ai)
#pragma unroll
            for (int m = 0; m < 4; ++m) { const int r = row0 + ai * HALF + m * 16;
                bf16_t* rowp = O + (gate ? (size_t)r * 4096 : ((size_t)(r >> 14) * H * SEQ + (size_t)(r & (SEQ - 1))) * HD);
#pragma unroll
                for (int bj = 0; bj < 2; ++bj) { const f32x4 v0 = acc[ai][bj][m][0], v1 = acc[ai][bj][m][1];
                    if (gate) { u32x2 w8; w8.x = pk4_fp8(v0[0], v0[1], v0[2], v0[3]); w8.y = pk4_fp8(v1[0], v1[1], v1[2], v1[3]);
                        *(u32x2*)(ws + WS_G + (size_t)r * 4096 + (size_t)(pn - 18) * BM + cl + bj * HALF) = w8; }
                    else { u32x4 w; w.x = cvt_pk_bf16(v0[0], v0[1]); w.y = cvt_pk_bf16(v0[2], v0[3]); w.z = cvt_pk_bf16(v1[0], v1[1]); w.w = cvt_pk_bf16(v1[2], v1[3]);
                        *(u32x4*)(rowp + bj * bjs) = w; } } }
    }
};
template <bool ADD> struct EpiGate {
    static constexpr bool PERM = true;
    bf16_t* O; unsigned char* O8; int ldc; const bf16_t* Gt; int ldg;
    __device__ __forceinline__ void operator()(const f32x4 (&acc)[2][2][4][2], const Unit& u, int wr, int wc, int fr, int fq) const {
        const int row0 = u.pm * BM + wr * 64 + fr, col0 = u.pn * BM + wc * 32 + 8 * fq;
#pragma unroll
        for (int ai = 0; ai < 2; ++ai)
#pragma unroll
            for (int m = 0; m < 4; ++m) { const size_t r = (size_t)(row0 + ai * HALF + m * 16);
#pragma unroll
                for (int bj = 0; bj < 2; ++bj) { const f32x4 v0 = acc[ai][bj][m][0], v1 = acc[ai][bj][m][1];
                    const u32x4 gw = *(const u32x4*)(Gt + r * ldg + col0 + bj * HALF);
                    bf16_t* op = O + r * ldc + col0 + bj * HALF;
                    float o[8] = {0.f, 0.f, 0.f, 0.f, 0.f, 0.f, 0.f, 0.f};
                    if (ADD) { const u32x4 ow = *(const u32x4*)op; o[0] = bf_lo(ow.x); o[1] = bf_hi(ow.x); o[2] = bf_lo(ow.y); o[3] = bf_hi(ow.y); o[4] = bf_lo(ow.z); o[5] = bf_hi(ow.z); o[6] = bf_lo(ow.w); o[7] = bf_hi(ow.w); }
                    o[0] += sigmoidf_(bf_lo(gw.x)) * v0[0]; o[1] += sigmoidf_(bf_hi(gw.x)) * v0[1]; o[2] += sigmoidf_(bf_lo(gw.y)) * v0[2]; o[3] += sigmoidf_(bf_hi(gw.y)) * v0[3];
                    o[4] += sigmoidf_(bf_lo(gw.z)) * v1[0]; o[5] += sigmoidf_(bf_hi(gw.z)) * v1[1]; o[6] += sigmoidf_(bf_lo(gw.w)) * v1[2]; o[7] += sigmoidf_(bf_hi(gw.w)) * v1[3];
                    if (ADD) { u32x2 w; w.x = pk4_fp8(o[0] * F8_MMUL, o[1] * F8_MMUL, o[2] * F8_MMUL, o[3] * F8_MMUL); w.y = pk4_fp8(o[4] * F8_MMUL, o[5] * F8_MMUL, o[6] * F8_MMUL, o[7] * F8_MMUL);
                        *(u32x2*)(O8 + r * ldc + col0 + bj * HALF) = w; }
                    else { u32x4 w; w.x = cvt_pk_bf16(o[0], o[1]); w.y = cvt_pk_bf16(o[2], o[3]); w.z = cvt_pk_bf16(o[4], o[5]); w.w = cvt_pk_bf16(o[6], o[7]);
                        *(u32x4*)op = w; } } }
    }
};
struct EpiGateDual {
    static constexpr bool PERM = true;
    static constexpr int LDC = 2048, LDG = 4096;
    unsigned char* O8; const unsigned char* Gt;
    static __device__ __forceinline__ float eneg(float g) { return __builtin_amdgcn_exp2f(-1.4426950408889634f * g); }
    static __device__ __forceinline__ float clampb(float g) { return fmaxf(g, -30.0f); }
#define GD8(w, b) __builtin_amdgcn_cvt_f32_fp8((int)(w), b)
    __device__ __forceinline__ void mid(f32x4 (&acc)[2][2][4][2], const Unit& u, int wr, int wc, int fr, int fq) const {
        unsigned gb0 = (unsigned)((u.pm * BM + wr * 64 + fr) * LDG + u.pn * BM + wc * 32 + 8 * fq);
        asm volatile("" : "+v"(gb0));
        const unsigned char* gt = Gt;
#pragma unroll
        for (int ai = 0; ai < 2; ++ai)
#pragma unroll
            for (int m = 0; m < 4; ++m)
#pragma unroll
                for (int bj = 0; bj < 2; ++bj) { const unsigned off = gb0 + (unsigned)((ai * HALF + m * 16) * LDG + bj * HALF);
                    const u32x2 ga = *(const u32x2*)(gt + off), gb = *(const u32x2*)(gt + off + 2048u);
#define GDR(wa, wb, b) ((1.0f + eneg(clampb(GD8(wb, b)))) * __builtin_amdgcn_rcpf(1.0f + eneg(GD8(wa, b))))
                    acc[ai][bj][m][0][0] *= GDR(ga.x, gb.x, 0); acc[ai][bj][m][0][1] *= GDR(ga.x, gb.x, 1); acc[ai][bj][m][0][2] *= GDR(ga.x, gb.x, 2); acc[ai][bj][m][0][3] *= GDR(ga.x, gb.x, 3);
                    acc[ai][bj][m][1][0] *= GDR(ga.y, gb.y, 0); acc[ai][bj][m][1][1] *= GDR(ga.y, gb.y, 1); acc[ai][bj][m][1][2] *= GDR(ga.y, gb.y, 2); acc[ai][bj][m][1][3] *= GDR(ga.y, gb.y, 3);
#undef GDR
                }
    }
    __device__ __forceinline__ void operator()(const f32x4 (&acc)[2][2][4][2], const Unit& u, int wr, int wc, int fr, int fq) const {
        unsigned rc0 = (unsigned)((u.pm * BM + wr * 64 + fr) * LDC + u.pn * BM + wc * 32 + 8 * fq);
        asm volatile("" : "+v"(rc0));
        const unsigned row0 = rc0 / LDC, col0 = rc0 % LDC;
        const unsigned char* gt = Gt;
#pragma unroll
        for (int ai = 0; ai < 2; ++ai)
#pragma unroll
            for (int m = 0; m < 4; ++m) { const unsigned r = row0 + ai * HALF + m * 16;
#pragma unroll
                for (int bj = 0; bj < 2; ++bj) { const f32x4 v0 = acc[ai][bj][m][0], v1 = acc[ai][bj][m][1];
                    const u32x2 gw = *(const u32x2*)(gt + (r * LDG + 2048u + col0 + bj * HALF));
                    float o[8];
                    o[0] = sigmoidf_(clampb(GD8(gw.x, 0))) * v0[0]; o[1] = sigmoidf_(clampb(GD8(gw.x, 1))) * v0[1]; o[2] = sigmoidf_(clampb(GD8(gw.x, 2))) * v0[2]; o[3] = sigmoidf_(clampb(GD8(gw.x, 3))) * v0[3];
                    o[4] = sigmoidf_(clampb(GD8(gw.y, 0))) * v1[0]; o[5] = sigmoidf_(clampb(GD8(gw.y, 1))) * v1[1]; o[6] = sigmoidf_(clampb(GD8(gw.y, 2))) * v1[2]; o[7] = sigmoidf_(clampb(GD8(gw.y, 3))) * v1[3];
                    u32x2 w; w.x = pk4_fp8(o[0] * F8_MMUL, o[1] * F8_MMUL, o[2] * F8_MMUL, o[3] * F8_MMUL); w.y = pk4_fp8(o[4] * F8_MMUL, o[5] * F8_MMUL, o[6] * F8_MMUL, o[7] * F8_MMUL);
                    *(u32x2*)(O8 + (r * LDC + col0 + bj * HALF)) = w; } }
    }
#undef GD8
};
struct EpiResid {
    static constexpr bool PERM = false;
    const float* base; float* out; int ldc;
    __device__ __forceinline__ void operator()(const f32x4 (&acc)[2][2][4][2], const Unit& u, int wr, int wc, int fr, int fq) const {
        const int row0 = u.pm * BM + wr * 64 + fr, col0 = u.pn * BM + wc * 32 + 4 * fq;
#pragma unroll
        for (int ai = 0; ai < 2; ++ai)
#pragma unroll
            for (int m = 0; m < 4; ++m) { const size_t off = (size_t)(row0 + ai * HALF + m * 16) * ldc + col0;
#pragma unroll
                for (int bj = 0; bj < 2; ++bj)
#pragma unroll
                    for (int n = 0; n < 2; ++n) { const f32x4 b = *(const f32x4*)(base + off + bj * HALF + n * 16); *(f32x4*)(out + off + bj * HALF + n * 16) = b + acc[ai][bj][m][n]; } }
    }
};
struct EpiResidB {
    static constexpr bool PERM = true;
    const float* base; bf16_t* out; int ldc;
    __device__ __forceinline__ void operator()(const f32x4 (&acc)[2][2][4][2], const Unit& u, int wr, int wc, int fr, int fq) const {
        const int row0 = u.pm * BM + wr * 64 + fr, col0 = u.pn * BM + wc * 32 + 8 * fq;
#pragma unroll
        for (int ai = 0; ai < 2; ++ai)
#pragma unroll
            for (int m = 0; m < 4; ++m) { const size_t off = (size_t)(row0 + ai * HALF + m * 16) * ldc + col0;
#pragma unroll
                for (int bj = 0; bj < 2; ++bj) { const f32x4 v0 = *(const f32x4*)(base + off + bj * HALF) + acc[ai][bj][m][0], v1 = *(const f32x4*)(base + off + bj * HALF + 4) + acc[ai][bj][m][1];
                    u32x4 w; w.x = cvt_pk_bf16(v0[0], v0[1]); w.y = cvt_pk_bf16(v0[2], v0[3]); w.z = cvt_pk_bf16(v1[0], v1[1]); w.w = cvt_pk_bf16(v1[2], v1[3]);
                    *(u32x4*)(out + off + bj * HALF) = w; } }
    }
};
struct EpiSwiglu {
    static constexpr bool PERM = true;
    unsigned char* act; const float* bg; const float* bu;
    __device__ __forceinline__ void operator()(const f32x4 (&acc)[2][2][4][2], const Unit& u, int wr, int wc, int fr, int fq) const {
        const int row0 = u.pm * BM + wr * 64 + fr, j0 = u.pn * HALF + wc * 32 + 8 * fq;
        const f32x4 g0 = *(const f32x4*)(bg + (size_t)u.e * DE + j0), g1 = *(const f32x4*)(bg + (size_t)u.e * DE + j0 + 4);
        const f32x4 u0 = *(const f32x4*)(bu + (size_t)u.e * DE + j0), u1 = *(const f32x4*)(bu + (size_t)u.e * DE + j0 + 4);
#pragma unroll
        for (int ai = 0; ai < 2; ++ai)
#pragma unroll
            for (int m = 0; m < 4; ++m) {
                float o[8];
#pragma unroll
                for (int n = 0; n < 2; ++n)
#pragma unroll
                    for (int i = 0; i < 4; ++i) {
                        float gt = acc[ai][0][m][n][i] + (n ? g1[i] : g0[i]), up = acc[ai][1][m][n][i] + (n ? u1[i] : u0[i]);
                        gt = fminf(gt, 7.0f); up = fminf(fmaxf(up, -7.0f), 7.0f);
                        o[n * 4 + i] = gt * sigmoidf_(1.702f * gt) * (up + 1.0f); }
                u32x2 w; w.x = pk4_fp8(o[0], o[1], o[2], o[3]); w.y = pk4_fp8(o[4], o[5], o[6], o[7]);
                *(u32x2*)(act + (size_t)(row0 + ai * HALF + m * 16) * DE + j0) = w; }
    }
};
struct EpiDown {
    static constexpr bool PERM = true;
    unsigned char* Y; const float* bd; const float* lw; const LAS int* tstart;
    __device__ __forceinline__ void operator()(const f32x4 (&acc)[2][2][4][2], const Unit& u, int wr, int wc, int fr, int fq) const {
        const int rl0 = wr * 64 + fr, col0 = u.pn * BM + wc * 32 + 8 * fq;
        const int lt = u.pm - tstart[u.e];
        f32x4 bv[2][2];
#pragma unroll
        for (int bj = 0; bj < 2; ++bj)
#pragma unroll
            for (int n = 0; n < 2; ++n) bv[bj][n] = *(const f32x4*)(bd + (size_t)u.e * D + col0 + bj * HALF + 4 * n);
#pragma unroll
        for (int ai = 0; ai < 2; ++ai)
#pragma unroll
            for (int m = 0; m < 4; ++m) { const int rl = rl0 + ai * HALF + m * 16;
                const float wl = lw[(size_t)u.e * LCAP + lt * 256 + (rl < u.cnt ? rl : u.cnt - 1)]; const float w = rl < u.cnt ? wl : 0.f;
                unsigned char* rowp = Y + (size_t)(u.pm * BM + rl) * D + col0; const float w16 = w * 16.0f;
#pragma unroll
                for (int bj = 0; bj < 2; ++bj) { const f32x4 v0 = (acc[ai][bj][m][0] + bv[bj][0]) * w16, v1 = (acc[ai][bj][m][1] + bv[bj][1]) * w16;
                    u32x2 q; q.x = pk4_fp8(v0[0], v0[1], v0[2], v0[3]); q.y = pk4_fp8(v1[0], v1[1], v1[2], v1[3]);
                    *(u32x2*)(rowp + bj * HALF) = q; } }
    }
};
struct MoeOrder {
    const LAS int* cnt; const LAS int* tstart; const LAS unsigned char* tile_e; int TT, NC, G, c;
    const int* ltok; bool gather; size_t brows;
    __device__ __forceinline__ bool next(int i, Unit& u) const {
        if (!tile_order(i, G, c, TT, NC, u.pm, u.pn)) return false;
        u.e = tile_e[u.pm]; const int lt = u.pm - tstart[u.e]; const int rem = cnt[u.e] - lt * 256; u.cnt = rem < 256 ? rem : 256; return true;
    }
    __device__ __forceinline__ void a_offs(const Gemm& g, const Unit& u, const int (&R)[2], const int (&C)[2], unsigned (&ao)[2][2]) const {
        const int lt = u.pm - tstart[u.e];
#pragma unroll
        for (int h = 0; h < 2; ++h)
#pragma unroll
            for (int i = 0; i < 2; ++i) {
                int row;
                if (gather) { int rl = h * HALF + R[i]; rl = rl < u.cnt ? rl : u.cnt - 1;
                    row = ltok[(size_t)u.e * LCAP + lt * 256 + rl]; }
                else row = u.pm * BM + h * HALF + R[i];
                ao[h][i] = (unsigned)(row * g.rb + C[i] * 2); }
    }
    __device__ __forceinline__ const char* b_ptr(const Gemm& g, const Unit& u) const { return (const char*)g.Bt + ((size_t)u.e * brows + (size_t)u.pn * BM) * g.rb; }
};
}

namespace att {
constexpr int NW = 8, QBLK = 32, KVBLK = 64;
constexpr float SCALE = 0.088388347648318440f;
constexpr float THR = 8.f;
constexpr float QMUL = 0.088388347648318440f * 1.4426950408889634f * 16.0f;
constexpr float PTHR = 0.75f, PHEAD0 = 2.0f, PHEAD = 1.0f;
constexpr float KMUL = 2.0f, VMUL = 2.0f;
constexpr size_t SHM_V = KVBLK * HD * 2, SHM_K = KVBLK * HD * 2, SHM_ATTN = 2 * SHM_V + 2 * SHM_K + NW * 64 * 4;
constexpr int BIAS_OFF = 67584;
#define KSWZ(row, colB) ((row) * 256 + ((colB) ^ (((row) & 15) << 4)))
#define SBAR() __builtin_amdgcn_sched_barrier(0)
__device__ __forceinline__ int crow(int r, int hi) { return (r & 3) + 8 * (r >> 2) + 4 * hi; }
__device__ __forceinline__ unsigned cvtpk(float lo, float hi) { unsigned r; asm volatile("v_cvt_pk_bf16_f32 %0, %1, %2" : "=v"(r) : "v"(lo), "v"(hi)); return r; }
__device__ __forceinline__ bf16x8 ld8(const bf16_t* p) { return *reinterpret_cast<const bf16x8*>(p); }

__device__ __forceinline__ void partialSM(f32x16& p0, f32x16& p1, float& m_reg, float& mn, float& alpha) {
  constexpr float C = SCALE * 1.4426950408889634f;
  float pmax = p0[0]; for (int r = 1; r < 16; ++r) pmax = fmaxf(pmax, p0[r]); for (int r = 0; r < 16; ++r) pmax = fmaxf(pmax, p1[r]);
  { auto rr = __builtin_amdgcn_permlane32_swap(__float_as_uint(pmax), __float_as_uint(pmax), false, false);
    pmax = fmaxf(__uint_as_float(rr[0]), __uint_as_float(rr[1])); }
  if (__builtin_expect(__all(pmax - m_reg <= THR / SCALE), 1)) { mn = m_reg; alpha = 1.f; }
  else { mn = fmaxf(m_reg, pmax); alpha = __builtin_amdgcn_exp2f((m_reg - mn) * C); m_reg = mn; }
  float mnC = -mn * C;
  for (int r = 0; r < 16; ++r) p0[r] = fmaf(p0[r], C, mnC); for (int r = 0; r < 16; ++r) p1[r] = fmaf(p1[r], C, mnC);
  for (int r = 0; r < 16; ++r) p0[r] = __builtin_amdgcn_exp2f(p0[r]);
}
__device__ __forceinline__ void finishSM(f32x16& p0, f32x16& p1, float alpha, float& l_reg, bf16x8& pa0, bf16x8& pa1, bf16x8& pa2, bf16x8& pa3) {
  for (int r = 0; r < 16; ++r) p1[r] = __builtin_amdgcn_exp2f(p1[r]);
  float ps = 0; for (int r = 0; r < 16; ++r) ps += p0[r]; for (int r = 0; r < 16; ++r) ps += p1[r];
  { auto rr = __builtin_amdgcn_permlane32_swap(__float_as_uint(ps), __float_as_uint(ps), false, false);
    ps = __uint_as_float(rr[0]) + __uint_as_float(rr[1]); }
  l_reg = l_reg * alpha + ps;
#define PK4(P, BASE, OUT) do { unsigned a0 = cvtpk(P[BASE + 0], P[BASE + 1]), a1 = cvtpk(P[BASE + 2], P[BASE + 3]);   \
    unsigned b0 = cvtpk(P[BASE + 4], P[BASE + 5]), b1 = cvtpk(P[BASE + 6], P[BASE + 7]);                              \
    auto r0 = __builtin_amdgcn_permlane32_swap(a0, b0, false, false); auto r1 = __builtin_amdgcn_permlane32_swap(a1, b1, false, false); \
    u32x4 w = {r0[0], r1[0], r0[1], r1[1]}; OUT = *reinterpret_cast<bf16x8*>(&w); } while (0)
  PK4(p0, 0, pa0); PK4(p0, 8, pa1); PK4(p1, 0, pa2); PK4(p1, 8, pa3);
#undef PK4
}
__device__ __forceinline__ void qkt(f32x16& p0, f32x16& p1, const bf16_t* Ks, const bf16x8* qr, int r32, int hi) {
  p0 = f32x16{}; p1 = f32x16{};
  for (int d0 = 0; d0 < 8; ++d0) { int cb = (d0 * 16 + hi * 8) * 2;
    bf16x8 b0 = *reinterpret_cast<const bf16x8*>((const char*)Ks + KSWZ(r32, cb));
    bf16x8 b1 = *reinterpret_cast<const bf16x8*>((const char*)Ks + KSWZ(32 + r32, cb));
    p0 = __builtin_amdgcn_mfma_f32_32x32x16_bf16(b0, qr[d0], p0, 0, 0, 0);
    p1 = __builtin_amdgcn_mfma_f32_32x32x16_bf16(b1, qr[d0], p1, 0, 0, 0); }
}
__device__ __forceinline__ int v_st(int k, int c) { const int kk = (k & ~0xC) | ((k & 4) << 1) | ((k & 8) >> 1); return ((kk >> 3) * 4 + (c >> 5)) * 512 + ((kk & 7) * 32 + (c & 31)) * 2; }
__device__ __forceinline__ int v_rd_base(int lane) { return ((lane & 3) << 3) | (((lane >> 2) & 3) << 6) | (((lane >> 4) & 1) << 5) | (((lane >> 5) & 1) << 8); }
constexpr int v_rd_off(int d0, int ks, int half) { return d0 * 512 + ks * 4096 + half * 2048; }
template <int OFF> __device__ __forceinline__ s16x4 tr_read(int vb) {
  s16x4 r; asm volatile("ds_read_b64_tr_b16 %0, %1 offset:%2" : "=&v"(r) : "v"(vb), "i"(OFF) : "memory"); return r;
}
template <int D0> __device__ __forceinline__ void pv_one(f32x16& od, int vb, bf16x8 pa0, bf16x8 pa1, bf16x8 pa2, bf16x8 pa3) {
  const s16x4 l0 = tr_read<v_rd_off(D0, 0, 0)>(vb), h0 = tr_read<v_rd_off(D0, 0, 1)>(vb), l1 = tr_read<v_rd_off(D0, 1, 0)>(vb), h1 = tr_read<v_rd_off(D0, 1, 1)>(vb);
  const s16x4 l2 = tr_read<v_rd_off(D0, 2, 0)>(vb), h2 = tr_read<v_rd_off(D0, 2, 1)>(vb), l3 = tr_read<v_rd_off(D0, 3, 0)>(vb), h3 = tr_read<v_rd_off(D0, 3, 1)>(vb);
  asm volatile("s_waitcnt lgkmcnt(0)" ::: "memory"); SBAR();
#define PK(L, H) (bf16x8){L[0], L[1], L[2], L[3], H[0], H[1], H[2], H[3]}
  od = __builtin_amdgcn_mfma_f32_32x32x16_bf16(pa0, PK(l0, h0), od, 0, 0, 0);
  od = __builtin_amdgcn_mfma_f32_32x32x16_bf16(pa1, PK(l1, h1), od, 0, 0, 0);
  od = __builtin_amdgcn_mfma_f32_32x32x16_bf16(pa2, PK(l2, h2), od, 0, 0, 0);
  od = __builtin_amdgcn_mfma_f32_32x32x16_bf16(pa3, PK(l3, h3), od, 0, 0, 0);
#undef PK
}
__device__ __forceinline__ void pv_d0(f32x16* o, int vb, bf16x8 pa0, bf16x8 pa1, bf16x8 pa2, bf16x8 pa3) {
  pv_one<0>(o[0], vb, pa0, pa1, pa2, pa3); pv_one<1>(o[1], vb, pa0, pa1, pa2, pa3); pv_one<2>(o[2], vb, pa0, pa1, pa2, pa3); pv_one<3>(o[3], vb, pa0, pa1, pa2, pa3);
}
struct NoMask { __device__ __forceinline__ void operator()(f32x16&, f32x16&, int) const {} };
struct NaMask {
  const float* bias; int kr0, rq, c, cs, hi;
  __device__ __forceinline__ void operator()(f32x16& p0, f32x16& p1, int j) const {
    const int kr = kr0 + j; int rs = rq - 4; rs = rs < 0 ? 0 : (rs > ROWS - 8 ? ROWS - 8 : rs);
    const bool vrow = (kr >= rs) && (kr < rs + 8);
    int ro = kr - rq + 7; ro = ro < 0 ? 0 : (ro > 14 ? 14 : ro);
    const float* br = bias + ro * 32; const float ninf = -__builtin_inff();
#pragma unroll
    for (int r = 0; r < 16; ++r) { const int kc = crow(r, hi);
      { const bool v = vrow && ((unsigned)(kc - cs) < 16u); const int co = v ? (kc - c + 15) : 0; const float b = br[co]; p0[r] = v ? p0[r] + b : ninf; }
      { const int kc1 = kc + 32; const bool v = vrow && ((unsigned)(kc1 - cs) < 16u); const int co = v ? (kc1 - c + 15) : 0; const float b = br[co]; p1[r] = v ? p1[r] + b : ninf; } }
  }
};

template <int LDQ, int LDK, int LDO, class Mask>
__device__ __forceinline__ void attn_body(const bf16_t* __restrict__ Qb, const bf16_t* __restrict__ Kh, const bf16_t* __restrict__ Vh,
                                          unsigned char* __restrict__ Ob, int seq, char* lds, const Mask& MK, const int wid) {
  const int lane = lane_now(), tid = wid * 64 + lane, r32 = lane & 31, hi = lane >> 5;
  bf16_t* V_lds = (bf16_t*)lds; bf16_t* K_lds = (bf16_t*)(lds + 2 * SHM_V);
  float* ws = (float*)(lds + 2 * SHM_V + 2 * SHM_K) + wid * 64; float* li_l = ws; float* al_l = ws + 32;
  float m_reg = -1e30f, l_reg = 0; f32x16 o[4] = {}; bf16x8 qr[8];
  const bf16_t* Qw = Qb + (long)(wid * QBLK + r32) * LDQ + hi * 8;
#pragma unroll
  for (int d0 = 0; d0 < 8; ++d0) qr[d0] = ld8(Qw + d0 * 16);
  const int sr = tid >> 4, sc = (tid & 15) * 8, vst0 = v_st(sr, sc), vst1 = v_st(32 + sr, sc);
  const unsigned lo0 = (unsigned)(sr * LDK + sc) * 2u, lo1 = lo0 + 32u * LDK * 2u;
  const int vb0 = (int)(uintptr_t)V_lds + v_rd_base(lane);
  constexpr int SDEPTH = 2;
  struct { bf16x8 vs0, vs1, ks0, ks1; } sr_[SDEPTH];
#define SLOAD(i, k0) do { const char* kb_ = (const char*)Kh + (size_t)(k0) * (LDK * 2); const char* vb_ = (const char*)Vh + (size_t)(k0) * (LDK * 2); \
    sr_[i].vs0 = *(const bf16x8*)(vb_ + lo0); sr_[i].vs1 = *(const bf16x8*)(vb_ + 32 * LDK * 2 + lo0); \
    sr_[i].ks0 = *(const bf16x8*)(kb_ + lo0); sr_[i].ks1 = *(const bf16x8*)(kb_ + 32 * LDK * 2 + lo0); } while (0)
#define SWRITE(b, i) do { *(bf16x8*)((char*)V_lds + (b) * SHM_V + vst0) = sr_[i].vs0;          \
    *(bf16x8*)((char*)V_lds + (b) * SHM_V + vst1) = sr_[i].vs1; int kc = sc * 2;               \
    *(bf16x8*)((char*)K_lds + (b) * SHM_K + KSWZ(sr, kc)) = sr_[i].ks0;                       \
    *(bf16x8*)((char*)K_lds + (b) * SHM_K + KSWZ(32 + sr, kc)) = sr_[i].ks1; } while (0)
#define SWAIT() do { if constexpr (SDEPTH == 2) asm volatile("s_waitcnt vmcnt(4)" ::: "memory"); else asm volatile("s_waitcnt vmcnt(0)" ::: "memory"); } while (0)
#define RESC(a) do { if (__any((a) < 1.f)) { const int ln_ = lane_now(), r32_ = ln_ & 31, hi_ = ln_ >> 5; float* al2_ = (float*)(lds + 2 * SHM_V + 2 * SHM_K) + wid * 64 + 32; \
    if (hi_ == 0) al2_[r32_] = (a); asm volatile("s_waitcnt lgkmcnt(0)" ::: "memory"); \
    for (int d = 0; d < 4; ++d) for (int r = 0; r < 16; ++r) o[d][r] *= al2_[crow(r, hi_)]; } } while (0)
  f32x16 pA0, pA1, pB0, pB1; float mnA, mnB, alA, alB; bf16x8 pa0, pa1, pa2, pa3; const int NT = seq / KVBLK;
  constexpr int SE = 0, SO = SDEPTH - 1;
  SLOAD(SE, 0); asm volatile("s_waitcnt vmcnt(0)" ::: "memory"); SWRITE(0, SE); __syncthreads();
  qkt(pA0, pA1, K_lds, qr, r32, hi); MK(pA0, pA1, 0); partialSM(pA0, pA1, m_reg, mnA, alA);
  SLOAD(SO, KVBLK); if constexpr (SDEPTH == 2) { if (2 < NT) SLOAD(SE, 2 * KVBLK); }
  SWAIT(); SWRITE(1, SO); __syncthreads();
  for (int j = 1; j + 1 < NT; j += 2) {
    SBAR(); qkt(pB0, pB1, (bf16_t*)((char*)K_lds + SHM_K), qr, r32, hi); MK(pB0, pB1, j);
    finishSM(pA0, pA1, alA, l_reg, pa0, pa1, pa2, pa3); SBAR();
    SLOAD(SO, (j + SDEPTH) * KVBLK); SBAR();
    pv_d0(o, vb0, pa0, pa1, pa2, pa3); partialSM(pB0, pB1, m_reg, mnB, alB);
    __syncthreads(); SWAIT(); SWRITE(0, SE);
    RESC(alB); __syncthreads();
    SBAR(); qkt(pA0, pA1, K_lds, qr, r32, hi); MK(pA0, pA1, j + 1);
    finishSM(pB0, pB1, alB, l_reg, pa0, pa1, pa2, pa3); SBAR();
    if (SDEPTH == 1 || j + 3 < NT) SLOAD(SE, (j + 1 + SDEPTH) * KVBLK); SBAR();
    pv_d0(o, vb0 + (int)SHM_V, pa0, pa1, pa2, pa3); partialSM(pA0, pA1, m_reg, mnA, alA);
    __syncthreads(); SWAIT(); SWRITE(1, SO);
    RESC(alA); __syncthreads();
  }
  SBAR(); qkt(pB0, pB1, (bf16_t*)((char*)K_lds + SHM_K), qr, r32, hi); MK(pB0, pB1, NT - 1);
  finishSM(pA0, pA1, alA, l_reg, pa0, pa1, pa2, pa3); SBAR();
  pv_d0(o, vb0, pa0, pa1, pa2, pa3); partialSM(pB0, pB1, m_reg, mnB, alB);
  __syncthreads(); RESC(alB);
  finishSM(pB0, pB1, alB, l_reg, pa0, pa1, pa2, pa3); SBAR();
  pv_d0(o, vb0 + (int)SHM_V, pa0, pa1, pa2, pa3);
  if (hi == 0) li_l[r32] = l_reg; asm volatile("s_waitcnt lgkmcnt(0)" ::: "memory");
  float rli[16];
#pragma unroll
  for (int r = 0; r < 16; ++r) rli[r] = __builtin_amdgcn_rcpf(li_l[crow(r, hi)]) * F8_YMUL;
  unsigned char* Ow = Ob + (long)(wid * QBLK) * LDO; const unsigned lane_off = (unsigned)(4 * hi * LDO + r32);
#pragma unroll
  for (int r = 0; r < 16; ++r) { unsigned char* rowb = Ow + ((r & 3) + 8 * (r >> 2)) * LDO;
#pragma unroll
    for (int d0 = 0; d0 < 4; ++d0) { const float v = o[d0][r] * rli[r]; rowb[lane_off + d0 * 32] = (unsigned char)(__builtin_amdgcn_cvt_pk_fp8_f32(v, v, 0, false) & 0xff); } }
#undef SLOAD
#undef SWRITE
#undef SWAIT
#undef RESC
}

template <int LDQ, int LDK, int LDO, class Mask>
__device__ __forceinline__ void attn_body_simple(const bf16_t* __restrict__ Qb, const bf16_t* __restrict__ Kh, const bf16_t* __restrict__ Vh,
                                                 unsigned char* __restrict__ Ob, int NT, char* lds, const Mask& MK, const int wid, const float* __restrict__ gq, const float* __restrict__ gk) {
  const int lane = lane_now(), tid = wid * 64 + lane, r32 = lane & 31, hi = lane >> 5;
  bf16_t* V_lds = (bf16_t*)lds; bf16_t* K_lds = (bf16_t*)(lds + 2 * SHM_V);
  float* ws = (float*)(lds + 2 * SHM_V + 2 * SHM_K) + wid * 64; float* li_l = ws; float* al_l = ws + 32;
  float m_reg = -1e30f, l_reg = 0; f32x16 o[4] = {}; bf16x8 qr[8];
  const bf16_t* Qw = Qb + (long)(wid * QBLK + r32) * LDQ + hi * 8;
#pragma unroll
  for (int d0 = 0; d0 < 8; ++d0) qr[d0] = ld8(Qw + d0 * 16);
  { float ss = 0.f;
#pragma unroll
    for (int d0 = 0; d0 < 8; ++d0) { const u32x4 w = __builtin_bit_cast(u32x4, qr[d0]); const float a0 = bf_lo(w.x), a1 = bf_hi(w.x), a2 = bf_lo(w.y), a3 = bf_hi(w.y), a4 = bf_lo(w.z), a5 = bf_hi(w.z), a6 = bf_lo(w.w), a7 = bf_hi(w.w);
        ss += (a0 * a0 + a1 * a1) + (a2 * a2 + a3 * a3) + (a4 * a4 + a5 * a5) + (a6 * a6 + a7 * a7); }
    { auto rr = __builtin_amdgcn_permlane32_swap(__float_as_uint(ss), __float_as_uint(ss), false, false); ss = __uint_as_float(rr[0]) + __uint_as_float(rr[1]); }
    const float rstd = 1.0f / sqrtf(ss * (1.f / 128.f) + EPS);
#pragma unroll
    for (int d0 = 0; d0 < 8; ++d0) { const u32x4 w = __builtin_bit_cast(u32x4, qr[d0]); const f32x4 g0 = *(const f32x4*)(gq + d0 * 16 + hi * 8), g1 = *(const f32x4*)(gq + d0 * 16 + hi * 8 + 4);
        u32x4 o; o.x = cvtpk(bf_lo(w.x) * rstd * g0.x, bf_hi(w.x) * rstd * g0.y); o.y = cvtpk(bf_lo(w.y) * rstd * g0.z, bf_hi(w.y) * rstd * g0.w);
        o.z = cvtpk(bf_lo(w.z) * rstd * g1.x, bf_hi(w.z) * rstd * g1.y); o.w = cvtpk(bf_lo(w.w) * rstd * g1.z, bf_hi(w.w) * rstd * g1.w); qr[d0] = __builtin_bit_cast(bf16x8, o); } }
  const int sr = tid >> 4, sc = (tid & 15) * 8, vst0 = v_st(sr, sc), vst1 = v_st(32 + sr, sc);
  const unsigned lo0 = (unsigned)(sr * LDK + sc) * 2u, lo1 = lo0 + 32u * LDK * 2u;
  const int vb0 = (int)(uintptr_t)V_lds + v_rd_base(lane);
  const f32x4 gk0 = *(const f32x4*)(gk + sc), gk1 = *(const f32x4*)(gk + sc + 4);
  bf16x8 vs0, vs1, ks0, ks1;
#define KNORM(kv) do { const u32x4 w_ = __builtin_bit_cast(u32x4, kv); const float a0 = bf_lo(w_.x), a1 = bf_hi(w_.x), a2 = bf_lo(w_.y), a3 = bf_hi(w_.y), a4 = bf_lo(w_.z), a5 = bf_hi(w_.z), a6 = bf_lo(w_.w), a7 = bf_hi(w_.w); \
    float ss_ = (a0 * a0 + a1 * a1) + (a2 * a2 + a3 * a3) + (a4 * a4 + a5 * a5) + (a6 * a6 + a7 * a7); ss_ += __shfl_xor(ss_, 1); ss_ += __shfl_xor(ss_, 2); ss_ += __shfl_xor(ss_, 4); ss_ += __shfl_xor(ss_, 8); \
    const float r_ = 1.0f / sqrtf(ss_ * (1.f / 128.f) + EPS); u32x4 o_; o_.x = cvtpk(a0 * r_ * gk0.x, a1 * r_ * gk0.y); o_.y = cvtpk(a2 * r_ * gk0.z, a3 * r_ * gk0.w); o_.z = cvtpk(a4 * r_ * gk1.x, a5 * r_ * gk1.y); o_.w = cvtpk(a6 * r_ * gk1.z, a7 * r_ * gk1.w); \
    kv = __builtin_bit_cast(bf16x8, o_); } while (0)
#define NLOAD(k0) do { const char* kb_ = (const char*)Kh + (size_t)(k0) * (LDK * 2); const char* vb_ = (const char*)Vh + (size_t)(k0) * (LDK * 2); \
    vs0 = *(const bf16x8*)(vb_ + lo0); vs1 = *(const bf16x8*)(vb_ + lo1); ks0 = *(const bf16x8*)(kb_ + lo0); ks1 = *(const bf16x8*)(kb_ + lo1); } while (0)
#define NWRITE(b) do { KNORM(ks0); KNORM(ks1); *(bf16x8*)((char*)V_lds + (b) * SHM_V + vst0) = vs0; *(bf16x8*)((char*)V_lds + (b) * SHM_V + vst1) = vs1; const int kc = sc * 2; \
    *(bf16x8*)((char*)K_lds + (b) * SHM_K + KSWZ(sr, kc)) = ks0; *(bf16x8*)((char*)K_lds + (b) * SHM_K + KSWZ(32 + sr, kc)) = ks1; } while (0)
  NLOAD(0); asm volatile("s_waitcnt vmcnt(0)" ::: "memory"); NWRITE(0); __syncthreads();
  for (int j = 0; j < NT; ++j) {
    const int bsel = j & 1;
    if (j + 1 < NT) NLOAD((j + 1) * KVBLK);
    f32x16 p0, p1; float mn, al; bf16x8 pa0, pa1, pa2, pa3;
    qkt(p0, p1, (const bf16_t*)((const char*)K_lds + bsel * SHM_K), qr, r32, hi); MK(p0, p1, j);
    partialSM(p0, p1, m_reg, mn, al);
    if (__any(al < 1.f)) { if (hi == 0) al_l[r32] = al; asm volatile("s_waitcnt lgkmcnt(0)" ::: "memory");
      for (int d = 0; d < 4; ++d) for (int r = 0; r < 16; ++r) o[d][r] *= al_l[crow(r, hi)]; }
    finishSM(p0, p1, al, l_reg, pa0, pa1, pa2, pa3); SBAR();
    pv_d0(o, vb0 + bsel * (int)SHM_V, pa0, pa1, pa2, pa3);
    if (j + 1 < NT) { asm volatile("s_waitcnt vmcnt(0)" ::: "memory"); NWRITE(bsel ^ 1); }
    __syncthreads();
  }
  if (hi == 0) li_l[r32] = l_reg; asm volatile("s_waitcnt lgkmcnt(0)" ::: "memory");
  float rli[16];
#pragma unroll
  for (int r = 0; r < 16; ++r) rli[r] = __builtin_amdgcn_rcpf(li_l[crow(r, hi)]) * F8_YMUL;
  unsigned char* Ow = Ob + (long)(wid * QBLK) * LDO; const unsigned lane_off = (unsigned)(4 * hi * LDO + r32);
#pragma unroll
  for (int r = 0; r < 16; ++r) { unsigned char* rowb = Ow + ((r & 3) + 8 * (r >> 2)) * LDO;
#pragma unroll
    for (int d0 = 0; d0 < 4; ++d0) { const float v = o[d0][r] * rli[r]; rowb[lane_off + d0 * 32] = (unsigned char)(__builtin_amdgcn_cvt_pk_fp8_f32(v, v, 0, false) & 0xff); } }
#undef NLOAD
#undef NWRITE
#undef KNORM
}
constexpr int F8_KT = 8192, F8_SCR = 49152;
#define MF8(a, b, c, sa, sb) __builtin_amdgcn_mfma_scale_f32_32x32x64_f8f6f4(a, b, c, 0, 0, 0, sa, 0, sb)
#define MFPV(a, b, c, sa, sb) __builtin_amdgcn_mfma_scale_f32_32x32x64_f8f6f4(a, b, c, 3, 2, 0, sa, 0, sb)
#define MF6(a, b, c, sa, sb) __builtin_amdgcn_mfma_scale_f32_32x32x64_f8f6f4(a, b, c, 2, 2, 0, sa, 0, sb)
__device__ __forceinline__ i32x8 cat8(const i32x4 lo, const i32x4 hi) { return __builtin_shufflevector(lo, hi, 0, 1, 2, 3, 4, 5, 6, 7); }
__device__ __forceinline__ i32x8 cat6(const i32x4 lo, const i32x2 hi) { i32x8 r; r[0] = lo[0]; r[1] = lo[1]; r[2] = lo[2]; r[3] = lo[3]; r[4] = hi[0]; r[5] = hi[1]; int u0, u1; asm volatile("" : "=v"(u0), "=v"(u1)); r[6] = u0; r[7] = u1; return r; }
template <bool REL>
__device__ __forceinline__ void qkt8(f32x16& p0, f32x16& p1, const char* Kt, const i32x8 (&qf)[2], const int (&ka)[2][2], const f32x16& negm) {
  const i32x8 k00 = cat6(*(const i32x4*)(Kt + ka[0][0]), *(const i32x2*)(Kt + ka[0][1])), k10 = cat6(*(const i32x4*)(Kt + 4096 + ka[0][0]), *(const i32x2*)(Kt + 4096 + ka[0][1]));
  const i32x8 k01 = cat6(*(const i32x4*)(Kt + ka[1][0]), *(const i32x2*)(Kt + ka[1][1])), k11 = cat6(*(const i32x4*)(Kt + 4096 + ka[1][0]), *(const i32x2*)(Kt + 4096 + ka[1][1]));
  asm volatile("" ::: "memory");
  const f32x16 zero = {};
  p0 = MF6(k00, qf[0], REL ? negm : zero, 126, 123); p1 = MF6(k10, qf[0], REL ? negm : zero, 126, 123); p0 = MF6(k01, qf[1], p0, 126, 123); p1 = MF6(k11, qf[1], p1, 126, 123);
}
__device__ __forceinline__ void partial8(f32x16& p0, f32x16& p1, float& m_reg, float& alpha) {
  float pmax = p0[0]; for (int r = 1; r < 16; ++r) pmax = fmaxf(pmax, p0[r]); for (int r = 0; r < 16; ++r) pmax = fmaxf(pmax, p1[r]);
  { auto rr = __builtin_amdgcn_permlane32_swap(__float_as_uint(pmax), __float_as_uint(pmax), false, false);
    pmax = fmaxf(__uint_as_float(rr[0]), __uint_as_float(rr[1])); }
  float mn;
  if (__builtin_expect(__all(pmax - m_reg <= PTHR), 1)) { mn = m_reg; alpha = 1.f; }
  else { mn = fmaxf(m_reg, pmax) + PHEAD0; alpha = __builtin_amdgcn_exp2f(m_reg - mn); m_reg = mn; }
  const float mb = mn - 4.0f;
  for (int r = 0; r < 16; ++r) p0[r] = p0[r] - mb; for (int r = 0; r < 16; ++r) p1[r] = p1[r] - mb;
  for (int r = 0; r < 16; ++r) p0[r] = __builtin_amdgcn_exp2f(p0[r]);
}
__device__ __forceinline__ void partial8r(f32x16& p0, f32x16& p1, float& m_reg, float& alpha, f32x16& negm) {
  float pmax = p0[0]; for (int r = 1; r < 16; ++r) pmax = fmaxf(pmax, p0[r]); for (int r = 0; r < 16; ++r) pmax = fmaxf(pmax, p1[r]);
  { auto rr = __builtin_amdgcn_permlane32_swap(__float_as_uint(pmax), __float_as_uint(pmax), false, false);
    pmax = fmaxf(__uint_as_float(rr[0]), __uint_as_float(rr[1])); }
  if (__builtin_expect(__all(pmax <= 4.0f + PTHR), 1)) { alpha = 1.f; }
  else { const float d = fmaxf(pmax - 4.0f + PHEAD, 0.f); alpha = __builtin_amdgcn_exp2f(-d); m_reg += d;
    for (int r = 0; r < 16; ++r) { p0[r] -= d; p1[r] -= d; negm[r] -= d; } }
  for (int r = 0; r < 16; ++r) p0[r] = __builtin_amdgcn_exp2f(p0[r]);
}
__device__ __forceinline__ int pk4_fp8_nz(float a, float b, float c, float d, int old) { int w = __builtin_amdgcn_cvt_pk_fp8_f32(a, b, old, false); return __builtin_amdgcn_cvt_pk_fp8_f32(c, d, w, true); }
__device__ __forceinline__ void finish8(const f32x16& p0, f32x16& p1, i32x8& pa) {
  for (int r = 0; r < 16; ++r) p1[r] = __builtin_amdgcn_exp2f(p1[r]);
  typedef unsigned u32x6_ __attribute__((ext_vector_type(6)));
  const u32x6_ pk = __builtin_amdgcn_cvt_scalef32_2xpk16_bf6_f32(p0, p1, 1.0f);
#pragma unroll
  for (int i = 0; i < 6; ++i) pa[i] = (int)pk[i];
  { int u0, u1; asm volatile("" : "=v"(u0), "=v"(u1)); pa[6] = u0; pa[7] = u1; }
}
__device__ __forceinline__ void pv8(f32x16 (&o)[4], f32x16& lacc, const char* Vt, const i32x8& pa, const int (&va)[2], const i32x8& ones) {
  lacc = MFPV(pa, ones, lacc, 127, 127);
#pragma unroll
  for (int d0 = 0; d0 < 4; ++d0) { const i32x8 vf = cat6(*(const i32x4*)(Vt + d0 * 2048 + va[0]), *(const i32x2*)(Vt + d0 * 2048 + va[1]));
    o[d0] = MFPV(pa, vf, o[d0], 127, 126); }
}
struct NoConv { static constexpr bool ON = false; __device__ __forceinline__ bool on() const { return false; } __device__ __forceinline__ void step(int, int) {} __device__ __forceinline__ void end() {} };
template <int LDO, class CV>
__device__ __forceinline__ void attn_body_f8(const unsigned char* __restrict__ Q8b, const unsigned char* __restrict__ K8h, const unsigned char* __restrict__ Vt8h,
                                             unsigned char* __restrict__ Ob, int seq, char* lds, LAS unsigned char* ldsl, const int wid, CV& cvx) {
  const int lane = lane_now(), tid = wid * 64 + lane, r32 = lane & 31, hi = lane >> 5;
  char* K_lds = lds; char* V_lds = lds + 3 * F8_KT;
  float m_reg = -1e30f; f32x16 o[4] = {}; f32x16 lacc = {}; i32x8 qf[2];
  { const unsigned char* qrow = Q8b + (size_t)(wid * QBLK + r32) * HD + hi * 32;
#pragma unroll
    for (int dh = 0; dh < 2; ++dh) qf[dh] = cat8(*(const i32x4*)(qrow + dh * 64), *(const i32x4*)(qrow + dh * 64 + 16)); }
  int ka[2][2]; { const int sw = (r32 >> 1) & 7;
#pragma unroll
    for (int dh = 0; dh < 2; ++dh)
#pragma unroll
      for (int e = 0; e < 2; ++e) ka[dh][e] = r32 * 128 + (((dh * 4 + hi * 2 + e) ^ sw) << 4); }
  int va[2]; { const int sw = (r32 >> 2) & 3;
#pragma unroll
    for (int e = 0; e < 2; ++e) va[e] = r32 * 64 + (((hi * 2 + e) ^ sw) << 4); }
  const int kp_row = wid * 8 + (lane >> 3), kp_c = (lane & 7) ^ ((kp_row >> 1) & 7); const unsigned kgo = (unsigned)(kp_row * 128 + kp_c * 16);
  const int vp_d = wid * 16 + (lane >> 2), vp_c = (lane & 3) ^ ((vp_d >> 2) & 3); const unsigned vgo = (unsigned)(vp_d * 64 + vp_c * 16);
#define DMA8(slot, t) do { \
    __builtin_amdgcn_global_load_lds((const unsigned*)(K8h + (size_t)(t) * 8192 + kgo), (LAS unsigned*)(ldsl + (slot) * F8_KT + wid * 1024), 16, 0, 0); \
    __builtin_amdgcn_global_load_lds((const unsigned*)(Vt8h + (size_t)(t) * 8192 + vgo), (LAS unsigned*)(ldsl + (3 + (slot)) * F8_KT + wid * 1024), 16, 0, 0); } while (0)
#define TBAR() do { if (cvx.on()) asm volatile("s_waitcnt vmcnt(1) lgkmcnt(0)" ::: "memory"); else asm volatile("s_waitcnt vmcnt(0) lgkmcnt(0)" ::: "memory"); \
    __builtin_amdgcn_s_barrier(); asm volatile("" ::: "memory"); } while (0)
#define RESC8(a) do { if (__any((a) < 1.f)) { const int ln_ = lane_now(), r32_ = ln_ & 31, hi_ = ln_ >> 5; float* al2_ = (float*)(lds + F8_SCR) + wid * 64; \
    if (hi_ == 0) al2_[r32_] = (a); asm volatile("s_waitcnt lgkmcnt(0)" ::: "memory"); \
    for (int r = 0; r < 16; ++r) { const float f_ = al2_[crow(r, hi_)]; for (int d = 0; d < 4; ++d) o[d][r] *= f_; lacc[r] *= f_; } } } while (0)
  f32x16 pA0, pA1, pB0, pB1; float alA, alB; i32x8 pa; const int NT = seq / KVBLK;
  i32x8 ones = {(int)0x08208208, (int)0x82082082, (int)0x20820820, (int)0x08208208, (int)0x82082082, (int)0x20820820, 0, 0};
  asm volatile("" : "+v"(ones));
  DMA8(0, 0); DMA8(1, 1);
  cvx.step(0, 0);
  asm volatile("s_waitcnt vmcnt(0)" ::: "memory"); __builtin_amdgcn_s_barrier(); asm volatile("" ::: "memory");
  f32x16 negm = {};
  qkt8<false>(pA0, pA1, K_lds, qf, ka, negm); partial8(pA0, pA1, m_reg, alA);
  { const float nm = 4.0f - m_reg; for (int r = 0; r < 16; ++r) negm[r] = nm; }
  int ks = 1, vs = 0, wsl = 2;
#define RING_NEXT() do { ks = (ks == 2) ? 0 : ks + 1; vs = (vs == 2) ? 0 : vs + 1; wsl = (wsl == 2) ? 0 : wsl + 1; } while (0)
  for (int j = 1; j + 1 < NT; j += 2) {
    TBAR(); DMA8(wsl, j + 1);
    cvx.step(j, 2);
    SBAR(); qkt8<true>(pB0, pB1, K_lds + ks * F8_KT, qf, ka, negm);
    finish8(pA0, pA1, pa); SBAR();
    pv8(o, lacc, V_lds + vs * F8_KT, pa, va, ones); partial8r(pB0, pB1, m_reg, alB, negm);
    RESC8(alB); RING_NEXT();
    TBAR(); const bool more = j + 2 < NT; if (more) DMA8(wsl, j + 2);
    cvx.step(j + 1, more ? 2 : 0);
    SBAR(); qkt8<true>(pA0, pA1, K_lds + ks * F8_KT, qf, ka, negm);
    finish8(pB0, pB1, pa); SBAR();
    pv8(o, lacc, V_lds + vs * F8_KT, pa, va, ones); partial8r(pA0, pA1, m_reg, alA, negm);
    RESC8(alA); RING_NEXT();
  }
  TBAR();
  cvx.step(NT - 1, 0);
  SBAR(); qkt8<true>(pB0, pB1, K_lds + ks * F8_KT, qf, ka, negm);
  finish8(pA0, pA1, pa); SBAR();
  pv8(o, lacc, V_lds + vs * F8_KT, pa, va, ones); partial8r(pB0, pB1, m_reg, alB, negm);
  RESC8(alB); RING_NEXT();
  finish8(pB0, pB1, pa); SBAR();
  pv8(o, lacc, V_lds + vs * F8_KT, pa, va, ones);
#undef RING_NEXT
  cvx.end();
  const int le_ = lane_now();
  unsigned char* Ow = Ob + (long)(wid * QBLK) * LDO; const unsigned lane_off = (unsigned)(4 * (le_ >> 5) * LDO + (le_ & 31));
#pragma unroll
  for (int r = 0; r < 16; ++r) { unsigned char* rowb = Ow + ((r & 3) + 8 * (r >> 2)) * LDO; const float rl = __builtin_amdgcn_rcpf(lacc[r]) * F8_YMUL;
#pragma unroll
    for (int d0 = 0; d0 < 4; ++d0) { const float v = o[d0][r] * rl; rowb[lane_off + d0 * 32] = (unsigned char)(__builtin_amdgcn_cvt_pk_fp8_f32(v, v, 0, false) & 0xff); } }
#undef DMA8
#undef TBAR
#undef RESC8
}
}

#define XB_TMO      128
#define XB_XCNT(j)  (256  + 64 * (j))
#define XB_XSUB(j)  (1280 + 64 * (j))
#define XB_XGEN(j)  (2304 + 64 * (j))
#define XB_TOP      3328
#define XB_TOPGEN   3392
#define XCD_BAR_WORDS 3456
#define XB_SPIN_CAP (1u << 18)
__device__ __forceinline__ unsigned xb_ld(unsigned* p)              { return __hip_atomic_load(p, __ATOMIC_RELAXED, __HIP_MEMORY_SCOPE_AGENT); }
__device__ __forceinline__ unsigned xb_add(unsigned* p, unsigned v) { return __hip_atomic_fetch_add(p, v, __ATOMIC_RELAXED, __HIP_MEMORY_SCOPE_AGENT); }
__device__ __forceinline__ unsigned xb_xcc_id() { return (unsigned)__builtin_amdgcn_s_getreg((3 << 11) | 20) & 0xFu; }
#define XB_SPIN(cond, bar) do { unsigned _sp = 0; while (cond) { __builtin_amdgcn_s_sleep(1); \
    if ((++_sp & 255u) == 0u) { if (xb_ld(&(bar)[XB_TMO])) break; if (_sp > XB_SPIN_CAP) { atomicAdd(&(bar)[XB_TMO], 1u); break; } } } } while (0)
struct XcdBarrier { unsigned* bar; unsigned x; volatile LAS unsigned* st; };
__device__ __forceinline__ XcdBarrier xcd_barrier_post(unsigned* bar, volatile LAS unsigned* st, const bool t0) {
    XcdBarrier b; b.bar = bar; b.x = xb_xcc_id(); b.st = st;
    if (t0) (void)xb_add(&bar[XB_XCNT(b.x)], 1u);
    return b;
}
__device__ __forceinline__ void xcd_barrier_complete(unsigned* bar, unsigned x, unsigned& nloc, unsigned& nx) {
    const unsigned G = gridDim.x * gridDim.y * gridDim.z;
    unsigned sum, cnt, mine, sp = 0u;
    for (;;) {
        sum = 0u; cnt = 0u; mine = 0u;
#pragma unroll
        for (unsigned j = 0; j < 16; ++j) { const unsigned c = xb_ld(&bar[XB_XCNT(j)]); sum += c; cnt += (c > 0u) ? 1u : 0u; mine = (j == x) ? c : mine; }
        if (sum == G) break;
        __builtin_amdgcn_s_sleep(1);
        if ((++sp & 255u) == 0u) { if (xb_ld(&bar[XB_TMO])) break; if (sp > XB_SPIN_CAP) { atomicAdd(&bar[XB_TMO], 1u); break; } }
    }
    nloc = mine > 0u ? mine : 1u; nx = cnt > 0u ? cnt : 1u;
}
__device__ __forceinline__ void xcd_barrier(const XcdBarrier& b, const bool t0) {
    asm volatile("s_waitcnt vmcnt(0)" ::: "memory");
    __syncthreads();
    if (t0) {
        unsigned* bar = b.bar;
        __builtin_amdgcn_s_waitcnt(0);
        unsigned nloc = b.st[0], nx = b.st[1];
        if (nloc == 0u) { xcd_barrier_complete(bar, b.x, nloc, nx); b.st[0] = nloc; b.st[1] = nx; }
        const unsigned old = xb_add(&bar[XB_XSUB(b.x)], 1u);
        const unsigned gen = old / nloc;
        if (old + 1u == (gen + 1u) * nloc) {
            __builtin_amdgcn_fence(__ATOMIC_RELEASE, "agent");
            asm volatile("s_waitcnt vmcnt(0)" ::: "memory");
            const unsigned og = xb_add(&bar[XB_TOP], 1u);
            const unsigned tg = og / nx;
            if (og + 1u == (tg + 1u) * nx) xb_add(&bar[XB_TOPGEN], 1u);
            else XB_SPIN(xb_ld(&bar[XB_TOPGEN]) == tg, bar);
            __builtin_amdgcn_fence(__ATOMIC_ACQUIRE, "agent");
            xb_add(&bar[XB_XGEN(b.x)], 1u);
            asm volatile("s_waitcnt vmcnt(0)" ::: "memory");
        } else {
            XB_SPIN(xb_ld(&bar[XB_XGEN(b.x)]) == gen, bar);
            __builtin_amdgcn_fence(__ATOMIC_ACQUIRE, "agent");
            asm volatile("s_waitcnt vmcnt(0)" ::: "memory");
        }
    }
    __syncthreads();
}

struct Frame {
    LAS unsigned char* lds;
    volatile LAS unsigned* MISC;
    gu32* ctl;
    int tid, lane, wave, G, bx;
    float* out; unsigned char* ws;
};
__device__ __forceinline__ const float* inp(int k) {
    const __attribute__((address_space(4))) char* kp = (const __attribute__((address_space(4))) char*)__builtin_amdgcn_kernarg_segment_ptr();
    asm volatile("" : "+s"(kp));
    return *(const float* const __attribute__((address_space(4)))*)(kp + 8 * k);
}
__device__ __forceinline__ float wave_sum(float v) {
#pragma unroll
    for (int o = 1; o < 64; o <<= 1) v += __shfl_xor(v, o);
    return v;
}
__device__ __forceinline__ unsigned f2bf(float f) { unsigned u = __builtin_bit_cast(unsigned, f); return (u + 0x7fffu + ((u >> 16) & 1u)) >> 16; }
__device__ __forceinline__ unsigned pk2(float lo, float hi) { return f2bf(lo) | (f2bf(hi) << 16); }

__device__ __forceinline__ void tr_item(const float* W, int N, bf16_t* WT, int K, int k0, int n0, size_t dst_row0, LAS float* scr, int lane) {
#pragma unroll
    for (int i = 0; i < 32; ++i) { const int kk = 2 * i + (lane >> 5); scr[kk * 33 + (lane & 31)] = W[(size_t)(k0 + kk) * N + n0 + (lane & 31)]; }
    LDS_WAIT(); asm volatile("" ::: "memory");
    const int c = lane & 7;
#pragma unroll
    for (int j = 0; j < 4; ++j) { const int n = (lane >> 3) + 8 * j; const LAS float* s = scr + (8 * c) * 33 + n;
        u32x4 o; o.x = pk2(s[0 * 33], s[1 * 33]); o.y = pk2(s[2 * 33], s[3 * 33]); o.z = pk2(s[4 * 33], s[5 * 33]); o.w = pk2(s[6 * 33], s[7 * 33]);
        *(GAS u32x4*)(WT + (dst_row0 + n) * K + k0 + 8 * c) = o; }
    LDS_WAIT(); asm volatile("" ::: "memory");
}
template <bool KG> __device__ __forceinline__ void tr_item_f8(const float* W, int N, unsigned char* WT, int K, int k0, int n0, size_t dst_row0, LAS float* scr, int lane, const float* kg = nullptr) {
#pragma unroll
    for (int i = 0; i < 32; ++i) { const int kk = 2 * i + (lane >> 5); scr[kk * 33 + (lane & 31)] = W[(size_t)(k0 + kk) * N + n0 + (lane & 31)]; }
    LDS_WAIT(); asm volatile("" ::: "memory");
    const int c = lane & 7;
    f32x4 m0 = {F8_WMUL, F8_WMUL, F8_WMUL, F8_WMUL}, m1 = m0;
    if (KG) { m0 = *(const f32x4*)(kg + k0 + 8 * c) * F8_WMUL; m1 = *(const f32x4*)(kg + k0 + 8 * c + 4) * F8_WMUL; }
#pragma unroll
    for (int j = 0; j < 4; ++j) { const int n = (lane >> 3) + 8 * j; const LAS float* s = scr + (8 * c) * 33 + n;
        u32x2 o; o.x = pk4_fp8(s[0 * 33] * m0.x, s[1 * 33] * m0.y, s[2 * 33] * m0.z, s[3 * 33] * m0.w); o.y = pk4_fp8(s[4 * 33] * m1.x, s[5 * 33] * m1.y, s[6 * 33] * m1.z, s[7 * 33] * m1.w);
        *(GAS u32x2*)(WT + (dst_row0 + n) * K + k0 + 8 * c) = o; }
    LDS_WAIT(); asm volatile("" ::: "memory");
}
__device__ __forceinline__ void rms_row_to_fp8(int lane, const float* xrow, const float* g, unsigned char* orow) {
    const GAS f32x4* xr = (const GAS f32x4*)xrow + lane; const GAS f32x4* gr = (const GAS f32x4*)g + lane;
    f32x4 v[8]; float s = 0.f;
#pragma unroll
    for (int j = 0; j < 8; ++j) { v[j] = xr[64 * j]; s += (v[j].x * v[j].x + v[j].y * v[j].y) + (v[j].z * v[j].z + v[j].w * v[j].w); }
    const float rstd = 1.0f / sqrtf(wave_sum(s) * (1.f / D) + EPS);
    GAS unsigned* o8 = (GAS unsigned*)orow + lane;
#pragma unroll
    for (int j = 0; j < 8; ++j) { const f32x4 gg = gr[64 * j]; o8[64 * j] = pk4_fp8(v[j].x * rstd * gg.x, v[j].y * rstd * gg.y, v[j].z * rstd * gg.z, v[j].w * rstd * gg.w); }
}
__device__ __forceinline__ void sincos_d(double a, float& c, float& s) {
    const double TWO_OVER_PI = 0.63661977236758134308, PIO2_HI = 1.57079632679489655800e+00, PIO2_LO = 6.12323399573676603587e-17;
    const double q = __builtin_rint(a * TWO_OVER_PI); const double r = (a - q * PIO2_HI) - q * PIO2_LO; const int n = (int)q & 3;
    const double r2 = r * r;
    double sp = -1.0 / 1307674368000.0; sp = sp * r2 + 1.0 / 6227020800.0; sp = sp * r2 - 1.0 / 39916800.0; sp = sp * r2 + 1.0 / 362880.0; sp = sp * r2 - 1.0 / 5040.0; sp = sp * r2 + 1.0 / 120.0; sp = sp * r2 - 1.0 / 6.0; sp = sp * r2 + 1.0;
    const double sn = sp * r;
    double cp = 1.0 / 20922789888000.0; cp = cp * r2 - 1.0 / 87178291200.0; cp = cp * r2 + 1.0 / 479001600.0; cp = cp * r2 - 1.0 / 3628800.0; cp = cp * r2 + 1.0 / 40320.0; cp = cp * r2 - 1.0 / 720.0; cp = cp * r2 + 1.0 / 24.0; cp = cp * r2 - 0.5; cp = cp * r2 + 1.0;
    const double cs = cp;
    double so, co;
    if (n == 0) { so = sn; co = cs; } else if (n == 1) { so = cs; co = -sn; } else if (n == 2) { so = -sn; co = -cs; } else { so = -cs; co = sn; }
    c = (float)co; s = (float)so;
}
__device__ __forceinline__ double inv_freq_d(int f) {
    const double t[32] = {1.0, 0.7498942093324559, 0.5623413251903491, 0.4216965034285822, 0.31622776601683794, 0.23713737056616552, 0.1778279410038923, 0.1333521432163324, 0.09999999999999999, 0.07498942093324558, 0.056234132519034905, 0.042169650342858224, 0.03162277660168379, 0.023713737056616554, 0.01778279410038923, 0.013335214321633239, 0.01, 0.007498942093324559, 0.005623413251903491, 0.004216965034285822, 0.0031622776601683794, 0.002371373705661655, 0.0017782794100389228, 0.0013335214321633238, 0.001, 0.0007498942093324559, 0.000562341325190349, 0.00042169650342858224, 0.00031622776601683794, 0.00023713737056616554, 0.0001778279410038923, 0.0001333521432163324};
    double r = t[0];
#pragma unroll
    for (int i = 1; i < 32; ++i) r = (f == i) ? t[i] : r;
    return r;
}

struct P0Item { const float* src; unsigned char* dst; const float* kg; int N, K, k0, n0; size_t drow0; };
__device__ __forceinline__ void p0_decode(int it, unsigned char* ws, P0Item& d) {
    constexpr int I_IN = 32 * 272, I_PA = 16 * 64, I_OUT = 32 * 64, I_EX = NE * 32 * 64;
    int r = it; d.kg = nullptr;
    if (r < I_IN) { const int kb = r / 272, nb = r % 272; d.src = inp(2); d.N = NCOLS; d.dst = ws + WS_WIN; d.K = D; d.k0 = 64 * kb; d.n0 = 32 * nb; d.drow0 = (size_t)32 * nb; return; } r -= I_IN;
    if (r < I_PA) { const int kb = r / 64, nb = r % 64; d.src = inp(8); d.N = D; d.dst = ws + WS_WPA; d.K = 1024; d.k0 = 64 * kb; d.n0 = 32 * nb; d.drow0 = (size_t)32 * nb; return; } r -= I_PA;
    if (r < I_PA) { const int kb = r / 64, nb = r % 64; d.src = inp(9); d.N = D; d.dst = ws + WS_WPB; d.K = 1024; d.k0 = 64 * kb; d.n0 = 32 * nb; d.drow0 = (size_t)32 * nb; return; } r -= I_PA;
    if (r < I_OUT) { const int kb = r / 64, nb = r % 64; d.src = inp(10); d.N = D; d.dst = ws + WS_WOUT; d.K = D; d.k0 = 64 * kb; d.n0 = 32 * nb; d.drow0 = (size_t)32 * nb; return; } r -= I_OUT;
    const int which = r / I_EX; r -= which * I_EX; const int e = r / 2048, rr = r % 2048, kb = rr / 64, nb = rr % 64, n0 = 32 * nb;
    d.k0 = 64 * kb; d.n0 = n0;
    if (which == 0) { d.src = inp(14) + (size_t)e * D * DE; d.N = DE; d.dst = ws + WS_WGU + (size_t)e * 4096 * D; d.K = D; d.drow0 = (size_t)((n0 >> 7) * 256 + (n0 & 127)); d.kg = inp(11); }
    else if (which == 1) { d.src = inp(16) + (size_t)e * D * DE; d.N = DE; d.dst = ws + WS_WGU + (size_t)e * 4096 * D; d.K = D; d.drow0 = (size_t)((n0 >> 7) * 256 + 128 + (n0 & 127)); d.kg = inp(11); }
    else { d.src = inp(18) + (size_t)e * DE * D; d.N = D; d.dst = ws + WS_WD + (size_t)e * 2048 * DE; d.K = DE; d.drow0 = (size_t)n0; }
}
__device__ __forceinline__ void p0_load(const P0Item& d, float (&v)[32], int lane) {
    const float* p = d.src + (size_t)(d.k0 + (lane >> 5)) * d.N + d.n0 + (lane & 31);
#pragma unroll
    for (int i = 0; i < 32; ++i) v[i] = p[(size_t)(2 * i) * d.N];
}
__device__ __forceinline__ void p0_finish(const P0Item& d, const float (&v)[32], LAS float* scr, int lane) {
#pragma unroll
    for (int i = 0; i < 32; ++i) scr[(2 * i + (lane >> 5)) * 33 + (lane & 31)] = v[i];
    LDS_WAIT(); asm volatile("" ::: "memory");
    const int c = lane & 7;
    f32x4 m0 = {F8_WMUL, F8_WMUL, F8_WMUL, F8_WMUL}, m1 = m0;
    if (d.kg) { m0 = *(const f32x4*)(d.kg + d.k0 + 8 * c) * F8_WMUL; m1 = *(const f32x4*)(d.kg + d.k0 + 8 * c + 4) * F8_WMUL; }
#pragma unroll
    for (int j = 0; j < 4; ++j) { const int n = (lane >> 3) + 8 * j; const LAS float* s = scr + (8 * c) * 33 + n;
        u32x2 o; o.x = pk4_fp8(s[0 * 33] * m0.x, s[1 * 33] * m0.y, s[2 * 33] * m0.z, s[3 * 33] * m0.w); o.y = pk4_fp8(s[4 * 33] * m1.x, s[5 * 33] * m1.y, s[6 * 33] * m1.z, s[7 * 33] * m1.w);
        *(GAS u32x2*)(d.dst + (d.drow0 + n) * d.K + d.k0 + 8 * c) = o; }
    LDS_WAIT(); asm volatile("" ::: "memory");
}
constexpr int P0_I_FIRST = 32 * 272 + 2 * 16 * 64 + 32 * 64, P0_I_ALL = P0_I_FIRST + 3 * NE * 32 * 64;
struct ConvW {
    static constexpr bool ON = true;
    const float* src0; unsigned char* dst0; size_t sstride, dstride; int N, K, k0; size_t drow0; bool kgf, act;
    LAS float* scr; const LAS float* gl;
    __device__ __forceinline__ void init(unsigned char* ws, int unit, int slot) {
        P0Item d; p0_decode(P0_I_FIRST + (unit * 32) * 2048 + slot, ws, d);
        src0 = d.src + (size_t)d.k0 * d.N + d.n0; dst0 = d.dst; N = d.N; K = d.K; k0 = d.k0; drow0 = d.drow0; kgf = d.kg != nullptr;
        sstride = (size_t)D * DE; dstride = (unit < 2) ? (size_t)4096 * D : (size_t)2048 * DE;
    }
    __device__ __forceinline__ bool on() const { return act; }
    __device__ __forceinline__ void finish(int q) {
        const int lane = lane_now(), c = lane & 7;
        f32x4 m0 = {F8_WMUL, F8_WMUL, F8_WMUL, F8_WMUL}, m1 = m0;
        if (kgf) { m0 = *(const LAS f32x4*)(gl + k0 + 8 * c) * F8_WMUL; m1 = *(const LAS f32x4*)(gl + k0 + 8 * c + 4) * F8_WMUL; }
        unsigned char* dq = dst0 + (size_t)q * dstride;
#pragma unroll
        for (int j = 0; j < 4; ++j) { const int n = (lane >> 3) + 8 * j; const LAS float* s = scr + c * 256 + ((((n >> 2) + c) & 7) << 2) + (n & 3);
            u32x2 o; o.x = pk4_fp8(s[0 * 32] * m0.x, s[1 * 32] * m0.y, s[2 * 32] * m0.z, s[3 * 32] * m0.w); o.y = pk4_fp8(s[4 * 32] * m1.x, s[5 * 32] * m1.y, s[6 * 32] * m1.z, s[7 * 32] * m1.w);
            __builtin_nontemporal_store(o, (GAS u32x2*)(dq + (drow0 + n) * K + k0 + 8 * c)); }
    }
    __device__ __forceinline__ void step(int c, int newer) {
        if (!act) return;
        if ((c & 7) == 0 && c > 0) { if (newer == 2) asm volatile("s_waitcnt vmcnt(2)" ::: "memory"); else asm volatile("s_waitcnt vmcnt(0)" ::: "memory");
            finish((c >> 3) - 1); }
        const int lane = lane_now(), sblk = c & 7;
        const float* src = src0 + (size_t)(c >> 3) * sstride + (size_t)(8 * sblk + (lane >> 3)) * N + 4 * (((lane & 7) - sblk) & 7);
        __builtin_amdgcn_global_load_lds((const unsigned*)src, (LAS unsigned*)(scr + sblk * 256), 16, 0, 2);
    }
    __device__ __forceinline__ void end() { if (!act) return; asm volatile("s_waitcnt vmcnt(0)" ::: "memory"); finish(31); }
};
__device__ __forceinline__ void p0_prologue(Frame& F) {
    LAS float* scr = (LAS float*)(F.lds + RING_OFF + F.wave * 16384);
    const int gw = F.bx * NWAVES + F.wave, NGW = F.G * NWAVES;
    unsigned char* ws = F.ws;
    const int NITEMS = (F.G == 256) ? P0_I_FIRST : P0_I_ALL;
    { P0Item A, B; float va[32], vb[32]; int it = gw;
      if (it < NITEMS) { p0_decode(it, ws, A); p0_load(A, va, F.lane);
        for (;;) {
            const bool hb = it + NGW < NITEMS; if (hb) { p0_decode(it + NGW, ws, B); p0_load(B, vb, F.lane); }
            p0_finish(A, va, scr, F.lane); if (!hb) break;
            it += 2 * NGW; const bool ha = it < NITEMS; if (ha) { p0_decode(it, ws, A); p0_load(A, va, F.lane); }
            p0_finish(B, vb, scr, F.lane); if (!ha) break;
        } } }
    for (int m = gw; m < NTOK; m += NGW) rms_row_to_fp8(F.lane, inp(0) + (size_t)m * D, inp(1), (unsigned char*)(ws + WS_H) + (size_t)m * D);
    { float* tab = (float*)(ws + WS_TAB); const int gid = F.bx * 512 + F.tid;
      if (gid < 320 * 32) { const int pos = gid >> 5, f = gid & 31; const int p = pos < 256 ? pos : pos - 256; float c, s; sincos_d((double)p * inv_freq_d(f), c, s);
        if (pos < 256) { tab[pos * 32 + f] = c; tab[8192 + pos * 32 + f] = s; } else { tab[16384 + p * 32 + f] = c; tab[16384 + 2048 + p * 32 + f] = s; } } }
}

__device__ __forceinline__ void p2_qknorm(Frame& F) {
    const float* tab = (const float*)(F.ws + WS_TAB);
    const int l16 = F.lane & 15, g4 = F.lane >> 4, gw = F.bx * NWAVES + F.wave, NGW = F.G * NWAVES;
    constexpr int R_QA = 2 * 8 * SEQ, R_KA = 2 * 2 * SEQ, NCH = (R_QA + R_KA) / 16;
    const int axis = l16 >> 3, half = (l16 >> 2) & 1;
    const int cch = gw, cstep = NGW, cend = NCH;
    u32x4 w[4];
#define P2_LOAD(dst, chx) do { int r_ = (chx) * 16; const bf16_t* b_ = (const bf16_t*)(F.ws + WS_QA); if (r_ >= R_QA) { r_ -= R_QA; b_ = (const bf16_t*)(F.ws + WS_KA); } \
        _Pragma("unroll") for (int k = 0; k < 4; ++k) dst[k] = *(const u32x4*)(b_ + (size_t)(r_ + 4 * k + g4) * HD + 8 * l16); } while (0)
    if (cch < cend) P2_LOAD(w, cch);
    for (int ch = cch; ch < cend; ch += cstep) {
        int r0 = ch * 16; const float* g; unsigned char* o8; float omul = 1.0f;
        if (r0 < R_QA) { g = inp(3); o8 = F.ws + WS_Q8; omul = att::QMUL; }
        else { r0 -= R_QA; g = inp(4); o8 = F.ws + WS_K8; omul = att::KMUL; }
        u32x4 wn[4];
#pragma unroll
        for (int k = 0; k < 4; ++k) wn[k] = w[k];
        if (ch + cstep < cend) P2_LOAD(wn, ch + cstep);
        const f32x4 g0 = *(const f32x4*)(g + 8 * l16), g1 = *(const f32x4*)(g + 8 * l16 + 4);
#pragma unroll
        for (int k = 0; k < 4; ++k) {
            const int row = r0 + 4 * k + g4;
            float x[8] = {bf_lo(w[k].x), bf_hi(w[k].x), bf_lo(w[k].y), bf_hi(w[k].y), bf_lo(w[k].z), bf_hi(w[k].z), bf_lo(w[k].w), bf_hi(w[k].w)};
            float ss = 0.f;
#pragma unroll
            for (int i = 0; i < 8; ++i) ss += x[i] * x[i];
            ss += __shfl_xor(ss, 1); ss += __shfl_xor(ss, 2); ss += __shfl_xor(ss, 4); ss += __shfl_xor(ss, 8);
            const float rstd = 1.0f / sqrtf(ss * (1.f / 128.f) + EPS);
#pragma unroll
            for (int i = 0; i < 4; ++i) { x[i] = x[i] * rstd * g0[i]; x[4 + i] = x[4 + i] * rstd * g1[i]; }
            const int sq = row & (SEQ - 1), pos = axis ? (sq & 63) : (sq >> 6);
            const float* ct = tab + (axis ? 16384 : 0) + pos * 32 + 8 * (l16 & 3); const float* st = ct + (axis ? 2048 : 8192);
            const f32x4 c0 = *(const f32x4*)ct, c1 = *(const f32x4*)(ct + 4), s0 = *(const f32x4*)st, s1 = *(const f32x4*)(st + 4);
            float y[8];
#pragma unroll
            for (int i = 0; i < 8; ++i) { const float pr = __shfl_xor(x[i], 4); const float cc = i < 4 ? c0[i & 3] : c1[i & 3], sn = i < 4 ? s0[i & 3] : s1[i & 3];
                y[i] = half ? (x[i] * cc + pr * sn) : (x[i] * cc - pr * sn); }
            const unsigned a24 = f6pack24(f6x4_bytes(y[0], y[1], y[2], y[3], omul)), b24 = f6pack24(f6x4_bytes(y[4], y[5], y[6], y[7], omul));
            const unsigned lo = a24 | (b24 << 24), hi16 = b24 >> 8;
            const unsigned plo = (unsigned)__builtin_amdgcn_update_dpp(0, (int)lo, 0xB1, 0xf, 0xf, false), phi = (unsigned)__builtin_amdgcn_update_dpp(0, (int)hi16, 0xB1, 0xf, 0xf, false);
            if (!(l16 & 1)) { unsigned* dst = (unsigned*)(o8 + (size_t)row * HD + (l16 >> 2) * 32 + ((l16 & 3) >> 1) * 12);
                dst[0] = lo; dst[1] = hi16 | (plo << 16); dst[2] = (plo >> 16) | (phi << 16); }
        }
#pragma unroll
        for (int k = 0; k < 4; ++k) w[k] = wn[k];
    }
#undef P2_LOAD
    LAS unsigned char* vt = F.lds + RING_OFF + F.wave * 16384;
    for (int T = gw; T < 2 * 2 * (SEQ / 64); T += NGW) {
        const bf16_t* vsrc = (const bf16_t*)(F.ws + WS_VA) + ((size_t)T * 64 + F.lane) * HD;
#pragma unroll
        for (int c = 0; c < 16; ++c) { const u32x4 w = *(const u32x4*)(vsrc + 8 * c);
            u32x2 q;
            q.x = f6x4_bytes(bf_lo(w.x), bf_hi(w.x), bf_lo(w.y), bf_hi(w.y), att::VMUL); q.y = f6x4_bytes(bf_lo(w.z), bf_hi(w.z), bf_lo(w.w), bf_hi(w.w), att::VMUL);
            *(LAS u32x2*)(vt + F.lane * 144 + 8 * c) = q; }
        LDS_WAIT(); asm volatile("" ::: "memory");
#pragma unroll
        for (int dd = 0; dd < 2; ++dd) { const int d = F.lane + 64 * dd;
            unsigned char* dst = F.ws + WS_VT8 + (size_t)T * 8192 + (size_t)d * 64;
#pragma unroll
            for (int hh = 0; hh < 2; ++hh) { unsigned wv[6] = {0u, 0u, 0u, 0u, 0u, 0u};
#pragma unroll
                for (int j = 0; j < 32; ++j) { const int key = (j < 16) ? att::crow(j, hh) : 32 + att::crow(j - 16, hh); const unsigned code = vt[key * 144 + d];
                    const int fld = (j < 16) ? 2 * j : 2 * (j - 16) + 1;
                    const int bit = 6 * fld, wi = bit >> 5, sh = bit & 31; wv[wi] |= code << sh; if (sh > 26) wv[wi + 1] |= code >> (32 - sh); }
                *(u32x4*)(dst + 32 * hh) = (u32x4){wv[0], wv[1], wv[2], wv[3]}; *(u32x2*)(dst + 32 * hh + 16) = (u32x2){wv[4], wv[5]}; } }
        LDS_WAIT(); asm volatile("" ::: "memory");
    }
}

__device__ __forceinline__ void p3_attention(Frame& F, char* lds) {
    unsigned char* ya = (unsigned char*)(F.ws + WS_YA); unsigned char* yb = (unsigned char*)(F.ws + WS_YB);
    { const int tl = F.wave * 64 + lane_now(); *(LAS f32x4*)(F.lds + RING_OFF + 116736 + tl * 16) = *(const f32x4*)(inp(11) + tl * 4); }
    for (int i = 0; ; ++i) {
        int b, h, qb;
        if (F.G == 256) { if (i >= 4) break; const int x = F.bx & 7, combo = x & 3, cu = (x >> 2) * 32 + (F.bx >> 3); b = combo >> 1; h = (combo & 1) * 4 + i; qb = cu; }
        else { const int u = F.bx + i * F.G; if (u >= 1024) break; b = u >> 9; h = (u >> 6) & 7; qb = u & 63; }
        const size_t t0 = (size_t)b * SEQ;
        __syncthreads();
        ConvW cvx; cvx.scr = (LAS float*)(F.lds + RING_OFF + 51200 + F.wave * 8192); cvx.gl = (const LAS float*)(F.lds + RING_OFF + 116736);
        cvx.act = (F.G == 256) && (i < 3); cvx.init(F.ws, i < 3 ? i : 0, F.bx * NWAVES + F.wave);
        att::attn_body_f8<1024, ConvW>(F.ws + WS_Q8 + ((size_t)(b * 8 + h) * SEQ + (size_t)qb * 256) * HD, F.ws + WS_K8 + (size_t)(b * 2 + (h >> 2)) * SEQ * HD,
                                F.ws + WS_VT8 + (size_t)(b * 2 + (h >> 2)) * (SEQ / 64) * 8192, ya + (t0 + (size_t)qb * 256) * 1024 + 128 * h, SEQ, lds, F.lds + RING_OFF, F.wave, cvx);
    }
    float* bias_l = (float*)(lds + att::BIAS_OFF);
    for (int i = 0; ; ++i) {
        const int u = F.bx + i * F.G; if (u >= 1024) break;
        const int b = u >> 9, h = (u >> 6) & 7, rb = u & 63, R0 = rb * 4;
        int kr0 = R0 - 4; kr0 = kr0 < 0 ? 0 : (kr0 > ROWS - 12 ? ROWS - 12 : kr0);
        __syncthreads();
        const int lane = lane_now(), wid = F.wave, tl = wid * 64 + lane;
        if (tl < 15 * 32) { const int ro = tl >> 5, co = tl & 31; bias_l[tl] = co < 31 ? inp(7)[(h * 15 + ro) * 31 + co] * (1.0f / att::SCALE) : 0.f; }
        const size_t t0 = (size_t)b * SEQ;
        const int c = 32 * (wid & 1) + (lane & 31); int cs = c - 8; cs = cs < 0 ? 0 : (cs > GW - 16 ? GW - 16 : cs);
        att::NaMask mk{bias_l, kr0, R0 + (wid >> 1), c, cs, lane >> 5};
        att::attn_body_simple<HD, HD, 1024, att::NaMask>((const bf16_t*)(F.ws + WS_QB) + ((size_t)(b * 8 + h) * SEQ + (size_t)R0 * 64) * HD, (const bf16_t*)(F.ws + WS_KB) + ((size_t)(b * 8 + h) * SEQ + (size_t)kr0 * 64) * HD,
                                                            (const bf16_t*)(F.ws + WS_VB) + ((size_t)(b * 8 + h) * SEQ + (size_t)kr0 * 64) * HD, yb + (t0 + (size_t)R0 * 64) * 1024 + 128 * h, 12, lds, mk, F.wave, inp(5), inp(6));
    }
}

__device__ __forceinline__ void p6_router(Frame& F) {
    const bf16_t* x1 = (const bf16_t*)(F.ws + WS_X1B); const float* g2 = inp(11); const float* wr = inp(12); const float* br = inp(13);
    unsigned char* h2 = (unsigned char*)(F.ws + WS_H8);
    LAS unsigned char* tile = F.lds + RING_OFF;
    LAS float* part = (LAS float*)(F.lds + PART_OFF);
    LAS unsigned* asg = (LAS unsigned*)(F.lds + ASG_OFF);
    LAS unsigned* hist = (LAS unsigned*)(F.lds + HIST_OFF);
    const int lane = F.lane, w = F.wave, row = lane & 15, kq = lane >> 4;
    if (F.tid < 64) hist[F.tid] = 0u;
    float Breg[16][4][2];
#pragma unroll
    for (int s = 0; s < 16; ++s)
#pragma unroll
        for (int i = 0; i < 4; ++i)
#pragma unroll
            for (int hf = 0; hf < 2; ++hf) { const int k = 256 * w + 16 * s + 4 * kq + i; Breg[s][i][hf] = wr[(size_t)k * NE + row + 16 * hf] * g2[k]; }
    int nasg = 0;
    u32x2 va[8], vb[8];
    const unsigned lofs = (unsigned)lane * 16u;
    { const int ch = F.bx; if (ch < NTOK / 16) { const char* xa = (const char*)(x1 + ((size_t)ch * 16 + 2 * w) * D);
#pragma unroll
        for (int j = 0; j < 8; ++j) { va[j] = *(const u32x2*)(xa + (lofs >> 1) + 512 * j); vb[j] = *(const u32x2*)(xa + 4096 + (lofs >> 1) + 512 * j); } } }
    for (int ch = F.bx; ch < NTOK / 16; ch += F.G) {
        __syncthreads();
#define P6_ROW(vr, tt) do { const int tl = 2 * w + (tt); const size_t tok = (size_t)ch * 16 + tl; float ss = 0.f; f32x4 v[8]; \
            _Pragma("unroll") for (int j = 0; j < 8; ++j) { v[j] = (f32x4){bf_lo(vr[j].x), bf_hi(vr[j].x), bf_lo(vr[j].y), bf_hi(vr[j].y)}; ss += (v[j].x * v[j].x + v[j].y * v[j].y) + (v[j].z * v[j].z + v[j].w * v[j].w); } \
            const float rstd = 1.0f / sqrtf(wave_sum(ss) * (1.f / D) + EPS); unsigned char* o8 = h2 + tok * D; \
            _Pragma("unroll") for (int j = 0; j < 8; ++j) { const f32x4 y = v[j] * rstd;     \
                *(unsigned*)(o8 + (lofs >> 2) + 256 * j) = pk4_fp8(y.x, y.y, y.z, y.w); *(LAS f32x4*)(tile + tl * 8192 + (((lofs >> 4) ^ tl) << 4) + 1024 * j) = y; } } while (0)
        P6_ROW(va, 0); P6_ROW(vb, 1);
#undef P6_ROW
        __syncthreads();
        { const int chn = ch + F.G; if (chn < NTOK / 16) { const char* xa = (const char*)(x1 + ((size_t)chn * 16 + 2 * w) * D);
            const unsigned lo2 = (unsigned)lane_now() * 16u;
#pragma unroll
            for (int j = 0; j < 8; ++j) { va[j] = *(const u32x2*)(xa + (lo2 >> 1) + 512 * j); vb[j] = *(const u32x2*)(xa + 4096 + (lo2 >> 1) + 512 * j); } } }
        f32x4 a0 = {0.f, 0.f, 0.f, 0.f}, a1 = {0.f, 0.f, 0.f, 0.f};
        f32x4 ab[2][2];
        unsigned abase[4];
        { const int ln = lane_now(), rw = ln & 15, kk = ln >> 4;
#pragma unroll
          for (int q = 0; q < 4; ++q) abase[q] = (unsigned)(rw * 8192 + ((64 * w + ((4 * q + kk) ^ rw)) << 4)); }
#define P6_LDA(g) do { _Pragma("unroll") for (int q = 0; q < 2; ++q) { const int s_ = 2 * (g) + q; ab[(g) & 1][q] = *(const LAS f32x4*)(tile + abase[s_ & 3] + (s_ >> 2) * 256); } } while (0)
        P6_LDA(0);
#pragma unroll
        for (int g = 0; g < 8; ++g) {
            if (g < 7) P6_LDA(g + 1);
#pragma unroll
            for (int q = 0; q < 2; ++q)
#pragma unroll
                for (int i = 0; i < 4; ++i) { a0 = __builtin_amdgcn_mfma_f32_16x16x4f32(ab[g & 1][q][i], Breg[2 * g + q][i][0], a0, 0, 0, 0); a1 = __builtin_amdgcn_mfma_f32_16x16x4f32(ab[g & 1][q][i], Breg[2 * g + q][i][1], a1, 0, 0, 0); }
            __builtin_amdgcn_sched_barrier(0);
        }
#undef P6_LDA
#pragma unroll
        for (int j = 0; j < 4; ++j) { part[(w * 16 + 4 * kq + j) * 32 + row] = a0[j]; part[(w * 16 + 4 * kq + j) * 32 + 16 + row] = a1[j]; }
        __syncthreads();
        { const int tl = F.tid >> 5, e = F.tid & 31; float lg = br[e];
#pragma unroll
          for (int ww = 0; ww < 8; ++ww) lg += part[(ww * 16 + tl) * 32 + e];
          float tv[4]; int ti[4]; bool taken = false;
#pragma unroll
          for (int r = 0; r < 4; ++r) { float bv = taken ? -__builtin_inff() : lg; int bi = e;
#define P6_STEP(EXPR_F, EXPR_I) do { const float ov = __int_as_float(EXPR_F); const int oi = (EXPR_I); if (ov > bv || (ov == bv && oi < bi)) { bv = ov; bi = oi; } } while (0)
#define P6_DPP(v, c) __builtin_amdgcn_update_dpp((v), (v), (c), 0xf, 0xf, false)
              P6_STEP(P6_DPP(__float_as_int(bv), 0xB1), P6_DPP(bi, 0xB1));
              P6_STEP(P6_DPP(__float_as_int(bv), 0x4E), P6_DPP(bi, 0x4E));
              P6_STEP(P6_DPP(__float_as_int(bv), 0x141), P6_DPP(bi, 0x141));
              P6_STEP(P6_DPP(__float_as_int(bv), 0x140), P6_DPP(bi, 0x140));
              P6_STEP(__builtin_amdgcn_ds_swizzle(__float_as_int(bv), 0x401F), __builtin_amdgcn_ds_swizzle(bi, 0x401F));
#undef P6_STEP
#undef P6_DPP
              tv[r] = bv; ti[r] = bi; if (bi == e) taken = true; }
          const float e1 = __expf(tv[1] - tv[0]), e2 = __expf(tv[2] - tv[0]), e3 = __expf(tv[3] - tv[0]); const float inv = 1.0f / (1.0f + e1 + e2 + e3);
          if (e < 4) { const float wt = (e == 0 ? 1.0f : e == 1 ? e1 : e == 2 ? e2 : e3) * inv; const int ex = e == 0 ? ti[0] : e == 1 ? ti[1] : e == 2 ? ti[2] : ti[3];
              const int n = nasg * 64 + tl * 4 + e; asg[n * 4 + 0] = (unsigned)(ch * 16 + tl) * 4u + (unsigned)e; asg[n * 4 + 1] = (unsigned)ex; asg[n * 4 + 2] = __float_as_uint(wt); } }
        ++nasg;
        if (nasg == 8) {
            __syncthreads();
            const int tf = F.wave * 64 + lane_now();
            { const unsigned ex = asg[tf * 4 + 1]; asg[tf * 4 + 3] = __hip_atomic_fetch_add((LAS unsigned*)&hist[ex], 1u, __ATOMIC_RELAXED, __HIP_MEMORY_SCOPE_WORKGROUP); }
            __syncthreads();
            if (tf < 32) { const unsigned n = hist[tf]; hist[32 + tf] = n ? __hip_atomic_fetch_add((unsigned*)(F.ctl + CW_CNT + 64 * tf), n, RLX_AGENT) : 0u; }
            __syncthreads();
            { const unsigned tk = asg[tf * 4 + 0], ex = asg[tf * 4 + 1], wb = asg[tf * 4 + 2], pos = hist[32 + ex] + asg[tf * 4 + 3];
              ((int*)(F.ws + WS_LTOK))[(size_t)ex * LCAP + pos] = (int)(tk >> 2); ((unsigned*)(F.ws + WS_LW))[(size_t)ex * LCAP + pos] = wb;
              ((unsigned*)(F.ws + WS_TOKEP))[tk] = (ex << 16) | pos; }
            __syncthreads();
            if (tf < 64) hist[tf] = 0u;
            nasg = 0;
        }
    }
    if (nasg) {
        __syncthreads();
        const int tf = F.wave * 64 + lane_now();
        const bool act = tf < nasg * 64;
        if (act) { const unsigned ex = asg[tf * 4 + 1]; asg[tf * 4 + 3] = __hip_atomic_fetch_add((LAS unsigned*)&hist[ex], 1u, __ATOMIC_RELAXED, __HIP_MEMORY_SCOPE_WORKGROUP); }
        __syncthreads();
        if (tf < 32) { const unsigned n = hist[tf]; hist[32 + tf] = n ? __hip_atomic_fetch_add((unsigned*)(F.ctl + CW_CNT + 64 * tf), n, RLX_AGENT) : 0u; }
        __syncthreads();
        if (act) { const unsigned tk = asg[tf * 4 + 0], ex = asg[tf * 4 + 1], wb = asg[tf * 4 + 2], pos = hist[32 + ex] + asg[tf * 4 + 3];
          ((int*)(F.ws + WS_LTOK))[(size_t)ex * LCAP + pos] = (int)(tk >> 2); ((unsigned*)(F.ws + WS_LW))[(size_t)ex * LCAP + pos] = wb;
          ((unsigned*)(F.ws + WS_TOKEP))[tk] = (ex << 16) | pos; }
        __syncthreads();
    }
}

__device__ __forceinline__ int moe_tables(Frame& F) {
    LAS int* cnt = (LAS int*)(F.lds + TAB_OFF); LAS int* tstart = cnt + 32; LAS unsigned char* tile_e = (LAS unsigned char*)(F.lds + TAB_OFF + 384);
    __syncthreads();
    if (F.tid < 32) cnt[F.tid] = (int)__hip_atomic_load((unsigned*)(F.ctl + CW_CNT + 64 * F.tid), RLX_AGENT);
    __syncthreads();
    if (F.tid == 0) { int s = 0; for (int e = 0; e < NE; ++e) { tstart[e] = s; s += (cnt[e] + 255) >> 8; } tstart[NE] = s; }
    __syncthreads();
    const int TT = tstart[NE];
    for (int t = F.tid; t < TT; t += 512) { int e = 0;
#pragma unroll
        for (int k = 1; k < NE; ++k) e += (tstart[k] <= t) ? 1 : 0;
        tile_e[t] = (unsigned char)e; }
    __syncthreads();
    return TT;
}

#define f8lo(w, b) __builtin_amdgcn_cvt_f32_fp8((int)(w), b)
__device__ __forceinline__ void p9_combine(Frame& F) {
    const LAS int* tstart = (const LAS int*)(F.lds + TAB_OFF) + 32;
    const unsigned char* Y = (const unsigned char*)(F.ws + WS_Y); const unsigned* tokep = (const unsigned*)(F.ws + WS_TOKEP);
    const int gw = F.bx * NWAVES + F.wave, NGW = F.G * NWAVES, lane = F.lane;
    for (int t0 = gw; t0 < NTOK; t0 += 16 * NGW) {
        const int tk = t0 + (lane & 15) * NGW; u32x4 ep = {0u, 0u, 0u, 0u};
        if (tk < NTOK) ep = *(const u32x4*)(tokep + (size_t)tk * 4);
        unsigned so0 = (unsigned)tstart[ep.x >> 16] * 256u + (ep.x & 0xffffu), so1 = (unsigned)tstart[ep.y >> 16] * 256u + (ep.y & 0xffffu);
        unsigned so2 = (unsigned)tstart[ep.z >> 16] * 256u + (ep.z & 0xffffu), so3 = (unsigned)tstart[ep.w >> 16] * 256u + (ep.w & 0xffffu);
#pragma unroll 2
        for (int k = 0; k < 16; ++k) {
            const int t = t0 + k * NGW; if (t >= NTOK) break;
            const size_t s0 = (size_t)__builtin_amdgcn_readlane((int)so0, k), s1 = (size_t)__builtin_amdgcn_readlane((int)so1, k), s2 = (size_t)__builtin_amdgcn_readlane((int)so2, k), s3 = (size_t)__builtin_amdgcn_readlane((int)so3, k);
            float* xo = F.out + (size_t)t * D; const bf16_t* xi = (const bf16_t*)(F.ws + WS_X1B) + (size_t)t * D;
            u32x2 y0[4], y1[4], y2[4], y3[4]; f32x4 a[4], b[4];
#pragma unroll
            for (int j = 0; j < 4; ++j) { const int c = (lane + 64 * j) * 8;
                y0[j] = *(const u32x2*)(Y + s0 * D + c); y1[j] = *(const u32x2*)(Y + s1 * D + c); y2[j] = *(const u32x2*)(Y + s2 * D + c); y3[j] = *(const u32x2*)(Y + s3 * D + c);
                const u32x4 xw = *(const u32x4*)(xi + c); a[j] = (f32x4){bf_lo(xw.x), bf_hi(xw.x), bf_lo(xw.y), bf_hi(xw.y)}; b[j] = (f32x4){bf_lo(xw.z), bf_hi(xw.z), bf_lo(xw.w), bf_hi(xw.w)}; }
#pragma unroll
            for (int j = 0; j < 4; ++j) { const int c = (lane + 64 * j) * 8;
#define Y4(w, i) ((f8lo(y0[j].w, i) + f8lo(y1[j].w, i)) + (f8lo(y2[j].w, i) + f8lo(y3[j].w, i))) * 0.0625f
                a[j].x += Y4(x, 0); a[j].y += Y4(x, 1); a[j].z += Y4(x, 2); a[j].w += Y4(x, 3);
                b[j].x += Y4(y, 0); b[j].y += Y4(y, 1); b[j].z += Y4(y, 2); b[j].w += Y4(y, 3);
#undef Y4
                *(f32x4*)(xo + c) = a[j]; *(f32x4*)(xo + c + 4) = b[j]; }
        }
    }
}

struct Args { const float* in[20]; float* out; unsigned char* ws; int ph_lo, ph_hi, li, pad; };
__global__ void __launch_bounds__(NWAVES * 64, 2) mk_fwd(Args args) {
    extern __shared__ __attribute__((aligned(16))) unsigned char lds[];
    Frame F;
    F.lds = (LAS unsigned char*)lds;
    F.MISC = (volatile LAS unsigned*)(F.lds + MISC_OFF);
    F.tid = threadIdx.x; F.lane = F.tid & 63; F.wave = __builtin_amdgcn_readfirstlane(F.tid >> 6);
    F.G = gridDim.x; F.bx = blockIdx.x;
    F.out = args.out; F.ws = args.ws; F.ctl = (gu32*)(args.ws + WS_CTL);
    for (int u = F.tid; u < (LDS_BYTES - LDSCTL_OFF) / 4; u += NWAVES * 64) ((LAS unsigned*)(F.lds + LDSCTL_OFF))[u] = 0u;
    __syncthreads();
    XcdBarrier bar; bar.bar = (unsigned*)(F.ctl + CW_BAR); bar.x = 0; bar.st = nullptr;
    if (N_LAUNCHES != PER_PHASE) bar = xcd_barrier_post((unsigned*)(F.ctl + CW_BAR), F.MISC + 8, F.tid == 0);
#define GRID_BAR(seam) do { if (N_LAUNCHES == PER_PHASE) { if (F.tid == 0) __hip_atomic_store(F.ctl + CW_TMO, 0xBADBA0u | (unsigned)(seam), RLX_AGENT); } else { xcd_barrier(bar, F.wave == 0 && lane_now() == 0); } } while (0)
    const int lo = args.ph_lo, hi = args.ph_hi;
#ifndef PH_MASK
#define PH_MASK 0x3ff
#endif
#define IN(k) (((PH_MASK >> (k)) & 1) && lo <= (k) && (k) < hi)
#define BOTH(k) (IN(k) && IN((k) + 1))
#define REFRESH() do { F.lane = lane_now(); F.tid = F.wave * 64 + F.lane; } while (0)
    unsigned char* ws = args.ws;

    if (IN(0)) { REFRESH(); p0_prologue(F); if (BOTH(0)) GRID_BAR(0); }

    if (IN(1)) { REFRESH();
        pg8::Gemm g{ws + WS_H, ws + WS_WIN, D, F8_ONE, F8_W}; pg8::StaticOrder S; S.init(NTOK, NCOLS, F.G, F.bx);
        pg8::EpiProj E{ws};
        pg8::gemm_phase<pg8::EpiProj, pg8::StaticOrder, true, true>(F.lds + RING_OFF, g, S, E, F.wave);
        if (BOTH(1)) GRID_BAR(1);
    }
    if (IN(2)) { REFRESH(); p2_qknorm(F); if (BOTH(2)) GRID_BAR(2); }
    if (IN(3)) { REFRESH(); p3_attention(F, (char*)lds + RING_OFF); if (BOTH(3)) GRID_BAR(3); }
    if (IN(4)) { REFRESH();
        { pg8::Gemm g{ws + WS_YA, ws + WS_WPA, 1024, F8_Y, F8_W, (long long)(WS_YB - WS_YA), (long long)(WS_WPB - WS_WPA)}; pg8::StaticOrder S; S.init(NTOK, D, F.G, F.bx);
          pg8::EpiGateDual E{(unsigned char*)(ws + WS_MERGED8), (const unsigned char*)(ws + WS_G)};
          pg8::gemm_phase<pg8::EpiGateDual, pg8::StaticOrder, true, true, true>(F.lds + RING_OFF, g, S, E, F.wave); }
        if (BOTH(4)) GRID_BAR(4);
    }
    if (IN(5)) { REFRESH();
        pg8::Gemm g{ws + WS_MERGED8, ws + WS_WOUT, D, F8_M, F8_W}; pg8::StaticOrder S; S.init(NTOK, D, F.G, F.bx);
        pg8::EpiResidB E{inp(0), (bf16_t*)(ws + WS_X1B), D};
        pg8::gemm_phase<pg8::EpiResidB, pg8::StaticOrder, true, true>(F.lds + RING_OFF, g, S, E, F.wave);
        if (BOTH(5)) GRID_BAR(5);
    }
    if (IN(6)) { REFRESH(); p6_router(F); if (BOTH(6)) GRID_BAR(6); }
    if (IN(7)) { REFRESH();
        const int TT = moe_tables(F);
        const LAS int* cnt = (const LAS int*)(F.lds + TAB_OFF);
        pg8::Gemm g{ws + WS_H8, ws + WS_WGU, D, F8_ONE, F8_W};
        pg8::MoeOrder S{cnt, cnt + 32, (const LAS unsigned char*)(F.lds + TAB_OFF + 384), TT, 16, F.G, F.bx, (const int*)(ws + WS_LTOK), true, (size_t)4096};
        pg8::EpiSwiglu E{(unsigned char*)(ws + WS_ACT), inp(15), inp(17)};
        pg8::gemm_phase<pg8::EpiSwiglu, pg8::MoeOrder, true, true>(F.lds + RING_OFF, g, S, E, F.wave);
        if (BOTH(7)) GRID_BAR(7);
    }
    if (IN(8)) { REFRESH();
        const int TT = moe_tables(F);
        const LAS int* cnt = (const LAS int*)(F.lds + TAB_OFF);
        pg8::Gemm g{ws + WS_ACT, ws + WS_WD, DE, F8_ONE, F8_W};
        pg8::MoeOrder S{cnt, cnt + 32, (const LAS unsigned char*)(F.lds + TAB_OFF + 384), TT, 8, F.G, F.bx, (const int*)(ws + WS_LTOK), false, (size_t)2048};
        pg8::EpiDown E{(unsigned char*)(ws + WS_Y), inp(19), (const float*)(ws + WS_LW), cnt + 32};
        pg8::gemm_phase<pg8::EpiDown, pg8::MoeOrder, true, true>(F.lds + RING_OFF, g, S, E, F.wave);
        if (BOTH(8)) GRID_BAR(8);
    }
    if (IN(9)) { REFRESH(); (void)moe_tables(F); p9_combine(F); }
#undef IN
#undef BOTH
}

extern "C" void kernel_launch(void* const* d_in, const int* in_sizes, int n_in, void* d_out, int out_size, void* d_ws, size_t ws_size, hipStream_t stream) {
    static int grid = 0;
    if (grid == 0) {
        if (n_in != 20 || out_size != NTOK * D || ws_size < WS_END) { fprintf(stderr, "kernel_launch: shape mismatch n_in %d out %d ws %zu (need %zu)\n", n_in, out_size, ws_size, (size_t)WS_END); grid = -1; return; }
        int dev = 0, cus = 0, per_cu = 0;
        if (hipGetDevice(&dev) != hipSuccess || hipDeviceGetAttribute(&cus, hipDeviceAttributeMultiprocessorCount, dev) != hipSuccess) { grid = -1; return; }
        if (hipFuncSetAttribute((const void*)mk_fwd, hipFuncAttributeMaxDynamicSharedMemorySize, LDS_BYTES) != hipSuccess) { fprintf(stderr, "kernel_launch: hipFuncSetAttribute failed\n"); grid = -1; return; }
        if (hipOccupancyMaxActiveBlocksPerMultiprocessor(&per_cu, (const void*)mk_fwd, NWAVES * 64, LDS_BYTES) != hipSuccess || per_cu < 1) fprintf(stderr, "kernel_launch: occupancy query reports %d\n", per_cu);
        (void)hipGetLastError();
        grid = cus < 256 ? cus : 256;
    }
    if (grid < 0) return;
    if (hipMemsetAsync((char*)d_ws + WS_CTL, 0, CTL_ZERO_BYTES, stream) != hipSuccess) return;
    Args a{};
    for (int i = 0; i < 20; ++i) a.in[i] = (const float*)d_in[i];
    a.out = (float*)d_out; a.ws = (unsigned char*)d_ws;
    for (int li = 0; li < N_LAUNCHES; ++li) {
        a.ph_lo = (N_LAUNCHES == PER_PHASE) ? li : 0; a.ph_hi = (N_LAUNCHES == PER_PHASE) ? li + 1 : PER_PHASE; a.li = li; a.pad = 0;
        for (int rep = 0; rep < ((N_LAUNCHES == PER_PHASE && li == DUP_PHASE) ? DUP_TIMES : 1) - 1; ++rep) hipLaunchKernelGGL(mk_fwd, dim3(grid), dim3(NWAVES * 64), LDS_BYTES, stream, a);
        hipLaunchKernelGGL(mk_fwd, dim3(grid), dim3(NWAVES * 64), LDS_BYTES, stream, a);
        const hipError_t le = hipPeekAtLastError();
        if (le != hipSuccess) { fprintf(stderr, "kernel_launch: launch %d failed: %s\n", li, hipGetErrorName(le)); break; }
    }
}
```

```cpp
#include <hip/hip_runtime.h>
#include <cstdio>
#include <cstdint>

#ifndef MK_N_LAUNCHES
#define MK_N_LAUNCHES 1
#endif
#ifndef DUP_PHASE
#define DUP_PHASE -1
#endif
#ifndef DUP_TIMES
#define DUP_TIMES 2
#endif
constexpr int PER_PHASE = 10;
constexpr int N_LAUNCHES = MK_N_LAUNCHES;

#define GAS __attribute__((address_space(1)))
#define LAS __attribute__((address_space(3)))
typedef unsigned short bf16_t;
typedef short bf16x8 __attribute__((ext_vector_type(8)));
typedef short s16x4 __attribute__((ext_vector_type(4)));
typedef float f32x2 __attribute__((ext_vector_type(2)));
typedef float f32x4 __attribute__((ext_vector_type(4)));
typedef float f32x8 __attribute__((ext_vector_type(8)));
typedef float f32x16 __attribute__((ext_vector_type(16)));
typedef unsigned u32x2 __attribute__((ext_vector_type(2)));
typedef unsigned u32x4 __attribute__((ext_vector_type(4)));
typedef int i32x2 __attribute__((ext_vector_type(2)));
typedef int i32x4 __attribute__((ext_vector_type(4)));
typedef int i32x8 __attribute__((ext_vector_type(8)));
typedef GAS unsigned gu32;
constexpr int F8_ONE = 127, F8_W = 121, F8_Y = 121, F8_M = 123;
constexpr float F8_WMUL = 64.0f, F8_YMUL = 64.0f, F8_MMUL = 16.0f;

constexpr int D = 2048, NTOK = 32768, SEQ = 16384, GW = 64, ROWS = 256, HD = 128;
constexpr int NCOLS = 8704;
constexpr int C_QA = 0, C_KA = 1024, C_VA = 1280, C_QB = 1536, C_KB = 2560, C_VB = 3584, C_GA = 4608, C_GB = 6656;
constexpr int NE = 32, DE = 2048, LCAP = 32768;
constexpr int MAXT = 544;
constexpr float EPS = 1e-6f;
constexpr int NWAVES = 8;

constexpr size_t MiB = 1u << 20;
constexpr size_t WS_CTL = 0, CTL_ZERO_BYTES = 1 * MiB;
constexpr size_t WS_TAB = 1 * MiB;
constexpr size_t WS_TOKEP = 1 * MiB + 128 * 1024;
constexpr size_t WS_LTOK = 2 * MiB;
constexpr size_t WS_LW = 6 * MiB;
constexpr size_t WS_WIN = 10 * MiB;
constexpr size_t WS_WPA = 44 * MiB, WS_WPB = 48 * MiB, WS_WOUT = 52 * MiB;
constexpr size_t WS_WD = 64 * MiB;
constexpr size_t WS_WGU = 320 * MiB;
constexpr size_t WS_MERGED = 832 * MiB;
constexpr size_t WS_X1B = 832 * MiB;
constexpr size_t WS_MERGED8 = 1760 * MiB;
constexpr size_t WS_Y = 320 * MiB;
constexpr size_t WS_H = 960 * MiB;
constexpr size_t WS_H8 = 1024 * MiB;
constexpr size_t WS_PROJ = 1088 * MiB;
constexpr size_t WS_QA = WS_PROJ, WS_KA = WS_PROJ + 64 * MiB, WS_VA = WS_PROJ + 80 * MiB, WS_QB = WS_PROJ + 96 * MiB, WS_KB = WS_PROJ + 160 * MiB, WS_VB = WS_PROJ + 224 * MiB, WS_G = WS_PROJ + 288 * MiB;
constexpr size_t WS_ACT = 1088 * MiB;
constexpr size_t WS_YA = 1632 * MiB, WS_YB = 1696 * MiB;
constexpr size_t WS_Q8 = 1824 * MiB;
constexpr size_t WS_K8 = 1856 * MiB;
constexpr size_t WS_VT8 = 1864 * MiB;
constexpr size_t WS_END = 1872 * MiB;
static_assert(WS_Y + (size_t)MAXT * 256 * 2048 * 2 <= WS_H && WS_ACT + (size_t)MAXT * 256 * 2048 * 2 <= WS_YA, "ws map");
static_assert(WS_Y + (size_t)MAXT * 256 * 2048 <= WS_X1B && WS_X1B + (size_t)NTOK * D * 2 <= WS_H, "ws map: fp8 Y below the bf16 residual stream");
constexpr int CW_TMO = 0, CW_CODE = 1;
constexpr int CW_BAR = 4096;
constexpr int CW_CNT = 16384;

constexpr int RING_OFF = 0, RING_BYTES = 131072;
constexpr int PART_OFF = 131072;
constexpr int ASG_OFF = 147456;
constexpr int TAB_OFF = 155648;
constexpr int HIST_OFF = 156672;
constexpr int MISC_OFF = 156928;
constexpr int LDS_BYTES = 157696;
constexpr int LDSCTL_OFF = HIST_OFF;

#define RLX_AGENT __ATOMIC_RELAXED, __HIP_MEMORY_SCOPE_AGENT
#define LDS_WAIT() asm volatile("s_waitcnt lgkmcnt(0)" ::: "memory")
#define VM_WAIT() asm volatile("s_waitcnt vmcnt(0)" ::: "memory")
__device__ __forceinline__ unsigned cvt_pk_bf16(float lo, float hi) { unsigned r; asm volatile("v_cvt_pk_bf16_f32 %0, %1, %2" : "=v"(r) : "v"(lo), "v"(hi)); return r; }
__device__ __forceinline__ unsigned f6_e2m3(float v) {
    const float y = fminf(__builtin_fabsf(v), 7.5f);
    const unsigned eb = __float_as_uint(fmaxf(y, 1.0f)) >> 23;
    const float q = __builtin_rintf(y * __uint_as_float((257u - eb) << 23));
    return ((unsigned)(int)q + 8u * eb - 1016u) | ((__float_as_uint(v) >> 26) & 32u);
}
__device__ __forceinline__ unsigned pk4_fp8(float a, float b, float c, float d) { int w = __builtin_amdgcn_cvt_pk_fp8_f32(a, b, 0, false); w = __builtin_amdgcn_cvt_pk_fp8_f32(c, d, w, true); return (unsigned)w; }
__device__ __forceinline__ int lane_now() { int l; asm volatile("v_mbcnt_lo_u32_b32 %0, -1, 0\n\tv_mbcnt_hi_u32_b32 %0, -1, %0" : "=v"(l)); return l; }
__device__ __forceinline__ float bf_lo(unsigned w) { return __uint_as_float(w << 16); }
__device__ __forceinline__ float bf_hi(unsigned w) { return __uint_as_float(w & 0xffff0000u); }
__device__ __forceinline__ float sigmoidf_(float x) { return __builtin_amdgcn_rcpf(1.0f + __builtin_amdgcn_exp2f(-1.4426950408889634f * x)); }

namespace pg8 {
constexpr int BM = 256, BK = 64, HALF = 128, HTB = HALF * BK * 2, STAGE_BYTES = 8 * HTB, NXCD = 8, WGM = 8;
__host__ __device__ __forceinline__ int lds_byte(int r, int c) { const int st = (r >> 4) * 2 + (c >> 5), rr = r & 15, cc = c & 31, ob = rr * 64 + cc * 2; return st * 1024 + (ob ^ (((ob >> 9) & 1) << 5)); }
__host__ __device__ __forceinline__ void stage_rc(int b, int& R, int& C) { const int st = b / 1024, sb = b % 1024, swz = sb ^ (((sb >> 9) & 1) << 5); R = (st >> 1) * 16 + swz / 64; C = (st & 1) * 32 + (swz % 64) / 2; }
__host__ __device__ __forceinline__ int perm32(int rho) { const int n = rho >> 4, i = rho & 15; return 8 * (i >> 2) + 4 * n + (i & 3); }

struct Unit { int pm, pn, e, cnt; };
struct Gemm { const void* A; const void* Bt; int rb; int sa, sb; long long dA = 0, dB = 0; };

__device__ __forceinline__ bool tile_order(int i, int G, int c, int nM, int nN, int& pm, int& pn) {
    const int nwg = nM * nN; const long L = (long)i * G + c; if (L >= nwg) return false;
    int wgid = (int)L; { const int q = nwg / NXCD, r = nwg % NXCD, xcd = wgid % NXCD, off = wgid / NXCD; wgid = (xcd < r ? xcd * (q + 1) : r * (q + 1) + (xcd - r) * q) + off; }
    const int nig = WGM * nN, gid = wgid / nig, fm = gid * WGM, gsz = (nM - fm) < WGM ? (nM - fm) : WGM;
    pm = fm + ((wgid % nig) % gsz); pn = (wgid % nig) / gsz; return true;
}
struct StaticOrder {
    int nM, nN, G, c;
    __device__ void init(int M, int N, int G_, int c_) { nM = M / BM; nN = N / BM; G = G_; c = c_; }
    __device__ __forceinline__ bool next(int i, Unit& u) const { u.e = 0; u.cnt = 256; return tile_order(i, G, c, nM, nN, u.pm, u.pn); }
    __device__ __forceinline__ void a_offs(const Gemm& g, const Unit& u, const int (&R)[2], const int (&C)[2], unsigned (&ao)[2][2]) const {
#pragma unroll
        for (int h = 0; h < 2; ++h)
#pragma unroll
            for (int i = 0; i < 2; ++i) ao[h][i] = (unsigned)((u.pm * BM + h * HALF + R[i]) * g.rb + C[i] * 2);
    }
    __device__ __forceinline__ const char* b_ptr(const Gemm& g, const Unit& u) const { return (const char*)g.Bt + (size_t)u.pn * BM * g.rb; }
};

template <class Epi, class Sched, bool ALIGN_EPI, bool FP8 = false, bool DUAL = false>
__device__ __forceinline__ void gemm_phase(LAS unsigned char* lds, const Gemm g, const Sched& S, const Epi& E, const int wid) {
    const int lane = lane_now(), tid = wid * 64 + lane, wr = wid >> 2, wc = wid & 3, fr = lane & 15, fq = lane >> 4;
    const int rb = g.rb, nt1 = rb / (BK * 2), nt = DUAL ? 2 * nt1 : nt1;
    unsigned voffB[2]; int RR[2], CC[2];
#pragma unroll
    for (int i = 0; i < 2; ++i) { int R, C; stage_rc(tid * 16 + i * 8192, R, C); RR[i] = R; CC[i] = C; int Rs;
        if constexpr ((int)Epi::PERM == 2) Rs = 64 * (R >> 5) + 16 * ((R & 15) >> 2) + 4 * ((R >> 4) & 1) + (R & 3);
        else Rs = (int)Epi::PERM ? ((R & ~31) + perm32(R & 31)) : R;
        voffB[i] = (unsigned)(Rs * rb + C * 2); }
    const size_t hstep = (size_t)(((int)Epi::PERM == 2) ? 8 : HALF) * rb;
    const size_t kstep = (size_t)(BK * 2);
    const unsigned ldsw = (unsigned)wid * 1024u;
    const int aoff = lds_byte(wr * 64 + fr, fq * 8), boff = lds_byte(wc * 32 + fr, fq * 8);
#define PG8_SA(b, h) (((b) * 2 + (h)) * HTB)
#define PG8_SB(b, h) ((4 + (b) * 2 + (h)) * HTB)
#define PG8_STAGE(bufoff, gbase, voff) do { _Pragma("unroll") for (int _i = 0; _i < 2; ++_i) \
        __builtin_amdgcn_global_load_lds((const unsigned*)((const char*)(gbase) + (voff)[_i]), (LAS unsigned*)(lds + (bufoff) + ldsw + _i * 8192), 16, 0, 0); } while (0)
#define PG8_STAGE_A(bufoff, kb, ao, h) PG8_STAGE(bufoff, (const char*)g.A + (kb), (ao)[h])
#define PG8_LDA(dst, b, h) do { _Pragma("unroll") for (int m = 0; m < 4; ++m) { if constexpr (FP8) { const i32x4 lo_ = *(const LAS i32x4*)(lds + PG8_SA(b, h) + aoff + m * 2048), hi_ = *(const LAS i32x4*)(lds + PG8_SA(b, h) + aoff + m * 2048 + 1024); \
            dst##8[m] = __builtin_shufflevector(lo_, hi_, 0, 1, 2, 3, 4, 5, 6, 7); } else { _Pragma("unroll") for (int k = 0; k < 2; ++k) dst[m][k] = *(const LAS bf16x8*)(lds + PG8_SA(b, h) + aoff + m * 2048 + k * 1024); } } } while (0)
#define PG8_LDB(dst, b, h) do { _Pragma("unroll") for (int n = 0; n < 2; ++n) { if constexpr (FP8) { const i32x4 lo_ = *(const LAS i32x4*)(lds + PG8_SB(b, h) + boff + n * 2048), hi_ = *(const LAS i32x4*)(lds + PG8_SB(b, h) + boff + n * 2048 + 1024); \
            dst##8[n] = __builtin_shufflevector(lo_, hi_, 0, 1, 2, 3, 4, 5, 6, 7); } else { _Pragma("unroll") for (int k = 0; k < 2; ++k) dst[n][k] = *(const LAS bf16x8*)(lds + PG8_SB(b, h) + boff + n * 2048 + k * 1024); } } } while (0)
#define PG8_MMA(ai, bj, At, Bt) do { __builtin_amdgcn_s_setprio(1); if constexpr (FP8) { asm volatile("s_nop 1" ::: "memory"); }     \
          \
        _Pragma("unroll") for (int m_ = 0; m_ < 4; ++m_) _Pragma("unroll") for (int n_ = 0; n_ < 2; ++n_) { const int m = (bj) ? 3 - m_ : m_, n = (m_ & 1) ? 1 - n_ : n_; \
        if constexpr (FP8) { asm volatile("v_mfma_scale_f32_16x16x128_f8f6f4 %0, %1, %2, %0, %3, %4 op_sel_hi:[0,0,0]" : "+v"(acc[ai][bj][m][n]) : "v"(Bt##8[n]), "v"(At##8[m]), "v"(sclB), "v"(sclA)); } \
        else { _Pragma("unroll") for (int k = 0; k < 2; ++k) acc[ai][bj][m][n] = __builtin_amdgcn_mfma_f32_16x16x32_bf16(Bt[n][k], At[m][k], acc[ai][bj][m][n], 0, 0, 0); } } \
        __builtin_amdgcn_s_setprio(0); } while (0)
#define PG8_WAIT_V(n) asm volatile("s_waitcnt vmcnt(" #n ")" ::: "memory")
#define PG8_WAIT_L(n) asm volatile("s_waitcnt lgkmcnt(" #n ")" ::: "memory")
#define PG8_BAR __builtin_amdgcn_s_barrier()
#define PG8_SCHED __builtin_amdgcn_sched_barrier(0)
    Unit cur, nxt; int ui = 0;
    if (!S.next(0, cur)) return;
    f32x4 acc[2][2][4][2];
#pragma unroll
    for (int a = 0; a < 2; ++a)
#pragma unroll
        for (int b = 0; b < 2; ++b)
#pragma unroll
            for (int m = 0; m < 4; ++m)
#pragma unroll
                for (int n = 0; n < 2; ++n) acc[a][b][m][n] = (f32x4){0.f, 0.f, 0.f, 0.f};
    bf16x8 At[4][2], B0[2][2], B1[2][2]; i32x8 At8[4], B08[2], B18[2];
    int sclA = g.sa, sclB = g.sb; if constexpr (FP8) { asm volatile("" : "+v"(sclA), "+v"(sclB)); }
    unsigned aoC[2][2], aoN[2][2];
    S.a_offs(g, cur, RR, CC, aoC);
    const char* cB = S.b_ptr(g, cur);
    PG8_STAGE(PG8_SB(0, 0), cB, voffB); PG8_STAGE(PG8_SB(0, 1), cB + hstep, voffB); PG8_STAGE_A(PG8_SA(0, 0), 0, aoC, 0); PG8_STAGE_A(PG8_SA(0, 1), 0, aoC, 1);
    if (wr == 1) PG8_BAR;
    PG8_WAIT_V(2); PG8_BAR;
    PG8_STAGE(PG8_SB(1, 0), cB + kstep, voffB); PG8_STAGE_A(PG8_SA(1, 0), kstep, aoC, 0); PG8_STAGE(PG8_SB(1, 1), cB + hstep + kstep, voffB);
    PG8_WAIT_V(6); PG8_BAR;
    for (;;) {
        const bool has_next = S.next(ui + 1, nxt);
        const char* nB = cB;
#pragma unroll
        for (int h = 0; h < 2; ++h)
#pragma unroll
            for (int i = 0; i < 2; ++i) aoN[h][i] = aoC[h][i];
        if (has_next) { S.a_offs(g, nxt, RR, CC, aoN); nB = S.b_ptr(g, nxt); }
        for (int t = 0; t < nt; t += 2) {
            const bool last = (t == nt - 2);
            if constexpr (DUAL) { if (t == nt1) { asm volatile("s_nop 15\n\ts_nop 15" ::: "memory"); if (wr == 0) PG8_BAR; E.mid(acc, cur, wr, wc, fr, fq); asm volatile("s_nop 7" ::: "memory"); if (wr == 1) PG8_BAR; } }
            size_t k1 = (size_t)(t + 1) * kstep, kk2 = (size_t)(t + 2) * kstep, kb2 = kk2;
            if constexpr (DUAL) { if (t >= nt1) k1 = (size_t)g.dA + (size_t)(t + 1 - nt1) * kstep;
                                  if (t + 2 >= nt1) { kk2 = (size_t)g.dA + (size_t)(t + 2 - nt1) * kstep; kb2 = (size_t)g.dB + (size_t)(t + 2 - nt1) * kstep; } }
            const size_t k2 = last ? 0 : kk2, k3 = k2 + kstep;
            const char* b2 = last ? nB : cB + kb2; const char* b3 = b2 + kstep;
            unsigned ao2[2][2];
#pragma unroll
            for (int h = 0; h < 2; ++h)
#pragma unroll
                for (int i = 0; i < 2; ++i) ao2[h][i] = last ? aoN[h][i] : aoC[h][i];
            PG8_LDB(B0, 0, 0); PG8_LDB(B1, 0, 1); PG8_SCHED; PG8_LDA(At, 0, 0); PG8_STAGE_A(PG8_SA(1, 1), k1, aoC, 1);
            PG8_WAIT_V(8); PG8_WAIT_L(0); PG8_BAR; PG8_MMA(0, 0, At, B0); PG8_MMA(0, 1, At, B1); PG8_BAR; PG8_SCHED;
            PG8_LDA(At, 0, 1); PG8_STAGE(PG8_SB(0, 0), b2, voffB); PG8_STAGE(PG8_SB(0, 1), b2 + hstep, voffB); PG8_STAGE_A(PG8_SA(0, 0), k2, ao2, 0);
            PG8_WAIT_V(8); PG8_WAIT_L(0); PG8_BAR; PG8_MMA(1, 0, At, B0); PG8_MMA(1, 1, At, B1); PG8_BAR; PG8_SCHED;
            PG8_LDB(B0, 1, 0); PG8_LDB(B1, 1, 1); PG8_SCHED; PG8_LDA(At, 1, 0); PG8_STAGE_A(PG8_SA(0, 1), k2, ao2, 1);
            PG8_WAIT_V(8); PG8_WAIT_L(0); PG8_BAR; PG8_MMA(0, 0, At, B0); PG8_MMA(0, 1, At, B1); PG8_BAR; PG8_SCHED;
            PG8_LDA(At, 1, 1); PG8_STAGE(PG8_SB(1, 0), b3, voffB); PG8_STAGE(PG8_SB(1, 1), b3 + hstep, voffB); PG8_STAGE_A(PG8_SA(1, 0), k3, ao2, 0);
            PG8_WAIT_V(8); PG8_WAIT_L(0); PG8_BAR; PG8_MMA(1, 0, At, B0); PG8_MMA(1, 1, At, B1); PG8_BAR; PG8_SCHED;
        }
        if constexpr (FP8) { asm volatile("s_nop 15\n\ts_nop 15" ::: "memory"); }
        if constexpr (ALIGN_EPI) { if (wr == 0) PG8_BAR; }
        E(acc, cur, wr, wc, fr, fq);
        if (!has_next) break;
#pragma unroll
        for (int a = 0; a < 2; ++a)
#pragma unroll
            for (int b = 0; b < 2; ++b)
#pragma unroll
                for (int m = 0; m < 4; ++m)
#pragma unroll
                    for (int n = 0; n < 2; ++n) acc[a][b][m][n] = (f32x4){0.f, 0.f, 0.f, 0.f};
        cur = nxt; cB = nB; ++ui;
#pragma unroll
        for (int h = 0; h < 2; ++h)
#pragma unroll
            for (int i = 0; i < 2; ++i) aoC[h][i] = aoN[h][i];
        if constexpr (ALIGN_EPI) { if (wr == 1) PG8_BAR; }
    }
    PG8_WAIT_V(0);
    if constexpr (!ALIGN_EPI) { if (wr == 0) PG8_BAR; }
    PG8_BAR;
#undef PG8_SA
#undef PG8_SB
#undef PG8_STAGE
#undef PG8_STAGE_A
#undef PG8_LDA
#undef PG8_LDB
#undef PG8_MMA
#undef PG8_WAIT_V
#undef PG8_WAIT_L
#undef PG8_BAR
#undef PG8_SCHED
}

struct EpiBf16 {
    static constexpr bool PERM = true;
    bf16_t* O; int ldc;
    __device__ __forceinline__ void operator()(const f32x4 (&acc)[2][2][4][2], const Unit& u, int wr, int wc, int fr, int fq) const {
        const int row0 = u.pm * BM + wr * 64 + fr, col0 = u.pn * BM + wc * 32 + 8 * fq;
#pragma unroll
        for (int ai = 0; ai < 2; ++ai)
#pragma unroll
            for (int m = 0; m < 4; ++m) { bf16_t* rowp = O + (size_t)(row0 + ai * HALF + m * 16) * ldc + col0;
#pragma unroll
                for (int bj = 0; bj < 2; ++bj) { const f32x4 v0 = acc[ai][bj][m][0], v1 = acc[ai][bj][m][1];
                    u32x4 w; w.x = cvt_pk_bf16(v0[0], v0[1]); w.y = cvt_pk_bf16(v0[2], v0[3]); w.z = cvt_pk_bf16(v1[0], v1[1]); w.w = cvt_pk_bf16(v1[2], v1[3]);
                    *(u32x4*)(rowp + bj * HALF) = w; } }
    }
};
struct EpiProj {
    static constexpr int PERM = 2;
    unsigned char* ws;
    __device__ __forceinline__ void operator()(const f32x4 (&acc)[2][2][4][2], const Unit& u, int wr, int wc, int fr, int fq) const {
        const int pn = u.pn; size_t base; int H, h0; bool gate = false;
        if (pn < 4) { base = WS_QA; H = 8; h0 = 2 * pn; } else if (pn == 4) { base = WS_KA; H = 2; h0 = 0; } else if (pn == 5) { base = WS_VA; H = 2; h0 = 0; }
        else if (pn < 10) { base = WS_QB; H = 8; h0 = 2 * (pn - 6); } else if (pn < 14) { base = WS_KB; H = 8; h0 = 2 * (pn - 10); } else if (pn < 18) { base = WS_VB; H = 8; h0 = 2 * (pn - 14); }
        else { base = WS_G; H = 0; h0 = 0; gate = true; }
        const int row0 = u.pm * BM + wr * 64 + fr, ct = wc * 64 + 16 * fq;
        bf16_t* O = (bf16_t*)(ws + base) + (size_t)(h0 + (wc >> 1)) * SEQ * HD + (ct & 127);
        unsigned char* G8 = ws + WS_G + (size_t)(pn - 18) * BM + ct;
#pragma unroll
        for (int ai = 0; ai < 2; ++ai)
#pragma unroll
            for (int m = 0; m < 4; ++m) { const int r = row0 + ai * HALF + m * 16;
                if (gate) { u32x4 w8; w8.x = pk4_fp8(acc[ai][0][m][0][0], acc[ai][0][m][0][1], acc[ai][0][m][0][2], acc[ai][0][m][0][3]); w8.y = pk4_fp8(acc[ai][0][m][1][0], acc[ai][0][m][1][1], acc[ai][0][m][1][2], acc[ai][0][m][1][3]);
                    w8.z = pk4_fp8(acc[ai][1][m][0][0], acc[ai][1][m][0][1], acc[ai][1][m][0][2], acc[ai][1][m][0][3]); w8.w = pk4_fp8(acc[ai][1][m][1][0], acc[ai][1][m][1][1], acc[ai][1][m][1][2], acc[ai][1][m][1][3]);
                    *(u32x4*)(G8 + (size_t)r * 4096) = w8; }
                else { bf16_t* rowp = O + ((size_t)(r >> 14) * H * SEQ + (size_t)(r & (SEQ - 1))) * HD;
#pragma unroll
                    for (int bj = 0; bj < 2; ++bj) { const f32x4 v0 = acc[ai][bj][m][0], v1 = acc[ai][bj][m][1];
                        u32x4 w; w.x = cvt_pk_bf16(v0[0], v0[1]); w.y = cvt_pk_bf16(v0[2], v0[3]); w.z = cvt_pk_bf16(v1[0], v1[1]); w.w = cvt_pk_bf16(v1[2], v1[3]);
                        *(u32x4*)(rowp + 8 * bj) = w; } } }
    }
};
template <bool ADD> struct EpiGate {
    static constexpr bool PERM = true;
    bf16_t* O; unsigned char* O8; int ldc; const bf16_t* Gt; int ldg;
    __device__ __forceinline__ void operator()(const f32x4 (&acc)[2][2][4][2], const Unit& u, int wr, int wc, int fr, int fq) const {
        const int row0 = u.pm * BM + wr * 64 + fr, col0 = u.pn * BM + wc * 32 + 8 * fq;
#pragma unroll
        for (int ai = 0; ai < 2; ++ai)
#pragma unroll
            for (int m = 0; m < 4; ++m) { const size_t r = (size_t)(row0 + ai * HALF + m * 16);
#pragma unroll
                for (int bj = 0; bj < 2; ++bj) { const f32x4 v0 = acc[ai][bj][m][0], v1 = acc[ai][bj][m][1];
                    const u32x4 gw = *(const u32x4*)(Gt + r * ldg + col0 + bj * HALF);
                    bf16_t* op = O + r * ldc + col0 + bj * HALF;
                    float o[8] = {0.f, 0.f, 0.f, 0.f, 0.f, 0.f, 0.f, 0.f};
                    if (ADD) { const u32x4 ow = *(const u32x4*)op; o[0] = bf_lo(ow.x); o[1] = bf_hi(ow.x); o[2] = bf_lo(ow.y); o[3] = bf_hi(ow.y); o[4] = bf_lo(ow.z); o[5] = bf_hi(ow.z); o[6] = bf_lo(ow.w); o[7] = bf_hi(ow.w); }
                    o[0] += sigmoidf_(bf_lo(gw.x)) * v0[0]; o[1] += sigmoidf_(bf_hi(gw.x)) * v0[1]; o[2] += sigmoidf_(bf_lo(gw.y)) * v0[2]; o[3] += sigmoidf_(bf_hi(gw.y)) * v0[3];
                    o[4] += sigmoidf_(bf_lo(gw.z)) * v1[0]; o[5] += sigmoidf_(bf_hi(gw.z)) * v1[1]; o[6] += sigmoidf_(bf_lo(gw.w)) * v1[2]; o[7] += sigmoidf_(bf_hi(gw.w)) * v1[3];
                    if (ADD) { u32x2 w; w.x = pk4_fp8(o[0] * F8_MMUL, o[1] * F8_MMUL, o[2] * F8_MMUL, o[3] * F8_MMUL); w.y = pk4_fp8(o[4] * F8_MMUL, o[5] * F8_MMUL, o[6] * F8_MMUL, o[7] * F8_MMUL);
                        *(u32x2*)(O8 + r * ldc + col0 + bj * HALF) = w; }
                    else { u32x4 w; w.x = cvt_pk_bf16(o[0], o[1]); w.y = cvt_pk_bf16(o[2], o[3]); w.z = cvt_pk_bf16(o[4], o[5]); w.w = cvt_pk_bf16(o[6], o[7]);
                        *(u32x4*)op = w; } } }
    }
};
struct EpiGateDual {
    static constexpr int PERM = 2;
    static constexpr int LDC = 2048, LDG = 4096;
    unsigned char* O8; const unsigned char* Gt;
    static __device__ __forceinline__ float eneg(float g) { return __builtin_amdgcn_exp2f(-1.4426950408889634f * g); }
    static __device__ __forceinline__ float clampb(float g) { return fmaxf(g, -30.0f); }
#define GD8(w, b) __builtin_amdgcn_cvt_f32_fp8((int)(w), b)
    __device__ __forceinline__ void mid(f32x4 (&acc)[2][2][4][2], const Unit& u, int wr, int wc, int fr, int fq) const {
        unsigned gb0 = (unsigned)((u.pm * BM + wr * 64 + fr) * LDG + u.pn * BM + wc * 64 + 16 * fq);
        asm volatile("" : "+v"(gb0));
        const unsigned char* gt = Gt;
#pragma unroll
        for (int ai = 0; ai < 2; ++ai)
#pragma unroll
            for (int m = 0; m < 4; ++m) { const unsigned off = gb0 + (unsigned)((ai * HALF + m * 16) * LDG);
                const u32x4 ga = *(const u32x4*)(gt + off), gb = *(const u32x4*)(gt + off + 2048u);
#define GDR(wa, wb, b) ((1.0f + eneg(clampb(GD8(wb, b)))) * __builtin_amdgcn_rcpf(1.0f + eneg(GD8(wa, b))))
#define GDQ(bj, n, wa, wb) do { acc[ai][bj][m][n][0] *= GDR(wa, wb, 0); acc[ai][bj][m][n][1] *= GDR(wa, wb, 1); acc[ai][bj][m][n][2] *= GDR(wa, wb, 2); acc[ai][bj][m][n][3] *= GDR(wa, wb, 3); } while (0)
                GDQ(0, 0, ga.x, gb.x); GDQ(0, 1, ga.y, gb.y); GDQ(1, 0, ga.z, gb.z); GDQ(1, 1, ga.w, gb.w);
#undef GDQ
#undef GDR
            }
    }
    __device__ __forceinline__ void operator()(const f32x4 (&acc)[2][2][4][2], const Unit& u, int wr, int wc, int fr, int fq) const {
        unsigned rc0 = (unsigned)((u.pm * BM + wr * 64 + fr) * LDC + u.pn * BM + wc * 64 + 16 * fq);
        asm volatile("" : "+v"(rc0));
        const unsigned row0 = rc0 / LDC, col0 = rc0 % LDC;
        const unsigned char* gt = Gt;
#pragma unroll
        for (int ai = 0; ai < 2; ++ai)
#pragma unroll
            for (int m = 0; m < 4; ++m) { const unsigned r = row0 + ai * HALF + m * 16;
                const u32x4 gw = *(const u32x4*)(gt + (r * LDG + 2048u + col0));
#define GSO(bj, n, w) pk4_fp8(sigmoidf_(clampb(GD8(w, 0))) * acc[ai][bj][m][n][0] * F8_MMUL, sigmoidf_(clampb(GD8(w, 1))) * acc[ai][bj][m][n][1] * F8_MMUL, sigmoidf_(clampb(GD8(w, 2))) * acc[ai][bj][m][n][2] * F8_MMUL, sigmoidf_(clampb(GD8(w, 3))) * acc[ai][bj][m][n][3] * F8_MMUL)
                u32x4 w; w.x = GSO(0, 0, gw.x); w.y = GSO(0, 1, gw.y); w.z = GSO(1, 0, gw.z); w.w = GSO(1, 1, gw.w);
#undef GSO
                *(u32x4*)(O8 + (r * LDC + col0)) = w; }
    }
#undef GD8
};
struct EpiResid {
    static constexpr bool PERM = false;
    const float* base; float* out; int ldc;
    __device__ __forceinline__ void operator()(const f32x4 (&acc)[2][2][4][2], const Unit& u, int wr, int wc, int fr, int fq) const {
        const int row0 = u.pm * BM + wr * 64 + fr, col0 = u.pn * BM + wc * 32 + 4 * fq;
#pragma unroll
        for (int ai = 0; ai < 2; ++ai)
#pragma unroll
            for (int m = 0; m < 4; ++m) { const size_t off = (size_t)(row0 + ai * HALF + m * 16) * ldc + col0;
#pragma unroll
                for (int bj = 0; bj < 2; ++bj)
#pragma unroll
                    for (int n = 0; n < 2; ++n) { const f32x4 b = *(const f32x4*)(base + off + bj * HALF + n * 16); *(f32x4*)(out + off + bj * HALF + n * 16) = b + acc[ai][bj][m][n]; } }
    }
};
struct EpiResidB {
    static constexpr bool PERM = true;
    const float* base; bf16_t* out; int ldc;
    __device__ __forceinline__ void operator()(const f32x4 (&acc)[2][2][4][2], const Unit& u, int wr, int wc, int fr, int fq) const {
        const int row0 = u.pm * BM + wr * 64 + fr, col0 = u.pn * BM + wc * 32 + 8 * fq;
#pragma unroll
        for (int ai = 0; ai < 2; ++ai)
#pragma unroll
            for (int m = 0; m < 4; ++m) { const size_t off = (size_t)(row0 + ai * HALF + m * 16) * ldc + col0;
#pragma unroll
                for (int bj = 0; bj < 2; ++bj) { const f32x4 v0 = *(const f32x4*)(base + off + bj * HALF) + acc[ai][bj][m][0], v1 = *(const f32x4*)(base + off + bj * HALF + 4) + acc[ai][bj][m][1];
                    u32x4 w; w.x = cvt_pk_bf16(v0[0], v0[1]); w.y = cvt_pk_bf16(v0[2], v0[3]); w.z = cvt_pk_bf16(v1[0], v1[1]); w.w = cvt_pk_bf16(v1[2], v1[3]);
                    *(u32x4*)(out + off + bj * HALF) = w; } }
    }
};
struct EpiSwiglu {
    static constexpr bool PERM = true;
    unsigned char* act; const float* bg; const float* bu;
    __device__ __forceinline__ void operator()(const f32x4 (&acc)[2][2][4][2], const Unit& u, int wr, int wc, int fr, int fq) const {
        const int row0 = u.pm * BM + wr * 64 + fr, j0 = u.pn * HALF + wc * 32 + 8 * fq;
        const f32x4 g0 = *(const f32x4*)(bg + (size_t)u.e * DE + j0), g1 = *(const f32x4*)(bg + (size_t)u.e * DE + j0 + 4);
        const f32x4 u0 = *(const f32x4*)(bu + (size_t)u.e * DE + j0), u1 = *(const f32x4*)(bu + (size_t)u.e * DE + j0 + 4);
#pragma unroll
        for (int ai = 0; ai < 2; ++ai)
#pragma unroll
            for (int m = 0; m < 4; ++m) {
                float o[8];
#pragma unroll
                for (int n = 0; n < 2; ++n)
#pragma unroll
                    for (int i = 0; i < 4; ++i) {
                        float gt = acc[ai][0][m][n][i] + (n ? g1[i] : g0[i]), up = acc[ai][1][m][n][i] + (n ? u1[i] : u0[i]);
                        gt = fminf(gt, 7.0f); up = fminf(fmaxf(up, -7.0f), 7.0f);
                        o[n * 4 + i] = gt * sigmoidf_(1.702f * gt) * (up + 1.0f); }
                u32x2 w; w.x = pk4_fp8(o[0], o[1], o[2], o[3]); w.y = pk4_fp8(o[4], o[5], o[6], o[7]);
                *(u32x2*)(act + (size_t)(row0 + ai * HALF + m * 16) * DE + j0) = w; }
    }
};
struct EpiDown {
    static constexpr int PERM = 2;
    unsigned char* Y; const float* bd; const float* lw; const LAS int* tstart;
    __device__ __forceinline__ void operator()(const f32x4 (&acc)[2][2][4][2], const Unit& u, int wr, int wc, int fr, int fq) const {
        const int rl0 = wr * 64 + fr, col0 = u.pn * BM + wc * 64 + 16 * fq;
        const int lt = u.pm - tstart[u.e];
        f32x4 bv[2][2];
#pragma unroll
        for (int bj = 0; bj < 2; ++bj)
#pragma unroll
            for (int n = 0; n < 2; ++n) bv[bj][n] = *(const f32x4*)(bd + (size_t)u.e * D + col0 + 8 * bj + 4 * n);
#pragma unroll
        for (int ai = 0; ai < 2; ++ai)
#pragma unroll
            for (int m = 0; m < 4; ++m) { const int rl = rl0 + ai * HALF + m * 16;
                const float wl = lw[(size_t)u.e * LCAP + lt * 256 + (rl < u.cnt ? rl : u.cnt - 1)]; const float w = rl < u.cnt ? wl : 0.f;
                unsigned char* rowp = Y + (size_t)(u.pm * BM + rl) * D + col0; const float w16 = w * 16.0f;
                u32x4 q;
                { const f32x4 v = (acc[ai][0][m][0] + bv[0][0]) * w16; q.x = pk4_fp8(v[0], v[1], v[2], v[3]); }
                { const f32x4 v = (acc[ai][0][m][1] + bv[0][1]) * w16; q.y = pk4_fp8(v[0], v[1], v[2], v[3]); }
                { const f32x4 v = (acc[ai][1][m][0] + bv[1][0]) * w16; q.z = pk4_fp8(v[0], v[1], v[2], v[3]); }
                { const f32x4 v = (acc[ai][1][m][1] + bv[1][1]) * w16; q.w = pk4_fp8(v[0], v[1], v[2], v[3]); }
                *(u32x4*)rowp = q; }
    }
};
struct MoeOrder {
    const LAS int* cnt; const LAS int* tstart; const LAS unsigned char* tile_e; int TT, NC, G, c;
    const int* ltok; bool gather; size_t brows;
    __device__ __forceinline__ bool next(int i, Unit& u) const {
        if (!tile_order(i, G, c, TT, NC, u.pm, u.pn)) return false;
        u.e = tile_e[u.pm]; const int lt = u.pm - tstart[u.e]; const int rem = cnt[u.e] - lt * 256; u.cnt = rem < 256 ? rem : 256; return true;
    }
    __device__ __forceinline__ void a_offs(const Gemm& g, const Unit& u, const int (&R)[2], const int (&C)[2], unsigned (&ao)[2][2]) const {
        const int lt = u.pm - tstart[u.e];
#pragma unroll
        for (int h = 0; h < 2; ++h)
#pragma unroll
            for (int i = 0; i < 2; ++i) {
                int row;
                if (gather) { int rl = h * HALF + R[i]; rl = rl < u.cnt ? rl : u.cnt - 1;
                    row = ltok[(size_t)u.e * LCAP + lt * 256 + rl]; }
                else row = u.pm * BM + h * HALF + R[i];
                ao[h][i] = (unsigned)(row * g.rb + C[i] * 2); }
    }
    __device__ __forceinline__ const char* b_ptr(const Gemm& g, const Unit& u) const { return (const char*)g.Bt + ((size_t)u.e * brows + (size_t)u.pn * BM) * g.rb; }
};
}

namespace att {
constexpr int NW = 8, QBLK = 32, KVBLK = 64;
constexpr float SCALE = 0.088388347648318440f;
constexpr float THR = 8.f;
constexpr float QMUL = 0.088388347648318440f * 1.4426950408889634f * 16.0f;
constexpr float PTHR = 0.75f, PHEAD0 = 2.0f, PHEAD = 1.0f;
constexpr float KMUL = 2.0f, VMUL = 2.0f;
constexpr size_t SHM_V = KVBLK * HD * 2, SHM_K = KVBLK * HD * 2, SHM_ATTN = 2 * SHM_V + 2 * SHM_K + NW * 64 * 4;
constexpr int BIAS_OFF = 67584;
#define KSWZ(row, colB) ((row) * 256 + ((colB) ^ (((row) & 15) << 4)))
#define SBAR() __builtin_amdgcn_sched_barrier(0)
__device__ __forceinline__ int crow(int r, int hi) { return (r & 3) + 8 * (r >> 2) + 4 * hi; }
__device__ __forceinline__ unsigned cvtpk(float lo, float hi) { unsigned r; asm volatile("v_cvt_pk_bf16_f32 %0, %1, %2" : "=v"(r) : "v"(lo), "v"(hi)); return r; }
__device__ __forceinline__ bf16x8 ld8(const bf16_t* p) { return *reinterpret_cast<const bf16x8*>(p); }

__device__ __forceinline__ void partialSM(f32x16& p0, f32x16& p1, float& m_reg, float& mn, float& alpha) {
  constexpr float C = SCALE * 1.4426950408889634f;
  float pmax = p0[0]; for (int r = 1; r < 16; ++r) pmax = fmaxf(pmax, p0[r]); for (int r = 0; r < 16; ++r) pmax = fmaxf(pmax, p1[r]);
  { auto rr = __builtin_amdgcn_permlane32_swap(__float_as_uint(pmax), __float_as_uint(pmax), false, false);
    pmax = fmaxf(__uint_as_float(rr[0]), __uint_as_float(rr[1])); }
  if (__builtin_expect(__all(pmax - m_reg <= THR / SCALE), 1)) { mn = m_reg; alpha = 1.f; }
  else { mn = fmaxf(m_reg, pmax); alpha = __builtin_amdgcn_exp2f((m_reg - mn) * C); m_reg = mn; }
  float mnC = -mn * C;
  for (int r = 0; r < 16; ++r) p0[r] = fmaf(p0[r], C, mnC); for (int r = 0; r < 16; ++r) p1[r] = fmaf(p1[r], C, mnC);
  for (int r = 0; r < 16; ++r) p0[r] = __builtin_amdgcn_exp2f(p0[r]);
}
__device__ __forceinline__ void finishSM(f32x16& p0, f32x16& p1, float alpha, float& l_reg, bf16x8& pa0, bf16x8& pa1, bf16x8& pa2, bf16x8& pa3) {
  for (int r = 0; r < 16; ++r) p1[r] = __builtin_amdgcn_exp2f(p1[r]);
  float ps = 0; for (int r = 0; r < 16; ++r) ps += p0[r]; for (int r = 0; r < 16; ++r) ps += p1[r];
  { auto rr = __builtin_amdgcn_permlane32_swap(__float_as_uint(ps), __float_as_uint(ps), false, false);
    ps = __uint_as_float(rr[0]) + __uint_as_float(rr[1]); }
  l_reg = l_reg * alpha + ps;
#define PK4(P, BASE, OUT) do { unsigned a0 = cvtpk(P[BASE + 0], P[BASE + 1]), a1 = cvtpk(P[BASE + 2], P[BASE + 3]);   \
    unsigned b0 = cvtpk(P[BASE + 4], P[BASE + 5]), b1 = cvtpk(P[BASE + 6], P[BASE + 7]);                              \
    auto r0 = __builtin_amdgcn_permlane32_swap(a0, b0, false, false); auto r1 = __builtin_amdgcn_permlane32_swap(a1, b1, false, false); \
    u32x4 w = {r0[0], r1[0], r0[1], r1[1]}; OUT = *reinterpret_cast<bf16x8*>(&w); } while (0)
  PK4(p0, 0, pa0); PK4(p0, 8, pa1); PK4(p1, 0, pa2); PK4(p1, 8, pa3);
#undef PK4
}
__device__ __forceinline__ void qkt(f32x16& p0, f32x16& p1, const bf16_t* Ks, const bf16x8* qr, int r32, int hi) {
  p0 = f32x16{}; p1 = f32x16{};
  for (int d0 = 0; d0 < 8; ++d0) { int cb = (d0 * 16 + hi * 8) * 2;
    bf16x8 b0 = *reinterpret_cast<const bf16x8*>((const char*)Ks + KSWZ(r32, cb));
    bf16x8 b1 = *reinterpret_cast<const bf16x8*>((const char*)Ks + KSWZ(32 + r32, cb));
    p0 = __builtin_amdgcn_mfma_f32_32x32x16_bf16(b0, qr[d0], p0, 0, 0, 0);
    p1 = __builtin_amdgcn_mfma_f32_32x32x16_bf16(b1, qr[d0], p1, 0, 0, 0); }
}
__device__ __forceinline__ int v_st(int k, int c) { const int kk = (k & ~0xC) | ((k & 4) << 1) | ((k & 8) >> 1); return ((kk >> 3) * 4 + (c >> 5)) * 512 + ((kk & 7) * 32 + (c & 31)) * 2; }
__device__ __forceinline__ int v_rd_base(int lane) { return ((lane & 3) << 3) | (((lane >> 2) & 3) << 6) | (((lane >> 4) & 1) << 5) | (((lane >> 5) & 1) << 8); }
constexpr int v_rd_off(int d0, int ks, int half) { return d0 * 512 + ks * 4096 + half * 2048; }
template <int OFF> __device__ __forceinline__ s16x4 tr_read(int vb) {
  s16x4 r; asm volatile("ds_read_b64_tr_b16 %0, %1 offset:%2" : "=&v"(r) : "v"(vb), "i"(OFF) : "memory"); return r;
}
template <int D0> __device__ __forceinline__ void pv_one(f32x16& od, int vb, bf16x8 pa0, bf16x8 pa1, bf16x8 pa2, bf16x8 pa3) {
  const s16x4 l0 = tr_read<v_rd_off(D0, 0, 0)>(vb), h0 = tr_read<v_rd_off(D0, 0, 1)>(vb), l1 = tr_read<v_rd_off(D0, 1, 0)>(vb), h1 = tr_read<v_rd_off(D0, 1, 1)>(vb);
  const s16x4 l2 = tr_read<v_rd_off(D0, 2, 0)>(vb), h2 = tr_read<v_rd_off(D0, 2, 1)>(vb), l3 = tr_read<v_rd_off(D0, 3, 0)>(vb), h3 = tr_read<v_rd_off(D0, 3, 1)>(vb);
  asm volatile("s_waitcnt lgkmcnt(0)" ::: "memory"); SBAR();
#define PK(L, H) (bf16x8){L[0], L[1], L[2], L[3], H[0], H[1], H[2], H[3]}
  od = __builtin_amdgcn_mfma_f32_32x32x16_bf16(pa0, PK(l0, h0), od, 0, 0, 0);
  od = __builtin_amdgcn_mfma_f32_32x32x16_bf16(pa1, PK(l1, h1), od, 0, 0, 0);
  od = __builtin_amdgcn_mfma_f32_32x32x16_bf16(pa2, PK(l2, h2), od, 0, 0, 0);
  od = __builtin_amdgcn_mfma_f32_32x32x16_bf16(pa3, PK(l3, h3), od, 0, 0, 0);
#undef PK
}
__device__ __forceinline__ void pv_d0(f32x16* o, int vb, bf16x8 pa0, bf16x8 pa1, bf16x8 pa2, bf16x8 pa3) {
  pv_one<0>(o[0], vb, pa0, pa1, pa2, pa3); pv_one<1>(o[1], vb, pa0, pa1, pa2, pa3); pv_one<2>(o[2], vb, pa0, pa1, pa2, pa3); pv_one<3>(o[3], vb, pa0, pa1, pa2, pa3);
}
struct NoMask { __device__ __forceinline__ void operator()(f32x16&, f32x16&, int) const {} };
struct NaMask {
  const float* bias; int kr0, rq, c, cs, hi;
  __device__ __forceinline__ void operator()(f32x16& p0, f32x16& p1, int j) const {
    const int kr = kr0 + j; int rs = rq - 4; rs = rs < 0 ? 0 : (rs > ROWS - 8 ? ROWS - 8 : rs);
    const bool vrow = (kr >= rs) && (kr < rs + 8);
    int ro = kr - rq + 7; ro = ro < 0 ? 0 : (ro > 14 ? 14 : ro);
    const float* br = bias + ro * 32; const float ninf = -__builtin_inff();
#pragma unroll
    for (int r = 0; r < 16; ++r) { const int kc = crow(r, hi);
      { const bool v = vrow && ((unsigned)(kc - cs) < 16u); const int co = v ? (kc - c + 15) : 0; const float b = br[co]; p0[r] = v ? p0[r] + b : ninf; }
      { const int kc1 = kc + 32; const bool v = vrow && ((unsigned)(kc1 - cs) < 16u); const int co = v ? (kc1 - c + 15) : 0; const float b = br[co]; p1[r] = v ? p1[r] + b : ninf; } }
  }
};

template <int LDQ, int LDK, int LDO, class Mask>
__device__ __forceinline__ void attn_body(const bf16_t* __restrict__ Qb, const bf16_t* __restrict__ Kh, const bf16_t* __restrict__ Vh,
                                          unsigned char* __restrict__ Ob, int seq, char* lds, const Mask& MK, const int wid) {
  const int lane = lane_now(), tid = wid * 64 + lane, r32 = lane & 31, hi = lane >> 5;
  bf16_t* V_lds = (bf16_t*)lds; bf16_t* K_lds = (bf16_t*)(lds + 2 * SHM_V);
  float* ws = (float*)(lds + 2 * SHM_V + 2 * SHM_K) + wid * 64; float* li_l = ws; float* al_l = ws + 32;
  float m_reg = -1e30f, l_reg = 0; f32x16 o[4] = {}; bf16x8 qr[8];
  const bf16_t* Qw = Qb + (long)(wid * QBLK + r32) * LDQ + hi * 8;
#pragma unroll
  for (int d0 = 0; d0 < 8; ++d0) qr[d0] = ld8(Qw + d0 * 16);
  const int sr = tid >> 4, sc = (tid & 15) * 8, vst0 = v_st(sr, sc), vst1 = v_st(32 + sr, sc);
  const unsigned lo0 = (unsigned)(sr * LDK + sc) * 2u, lo1 = lo0 + 32u * LDK * 2u;
  const int vb0 = (int)(uintptr_t)V_lds + v_rd_base(lane);
  constexpr int SDEPTH = 2;
  struct { bf16x8 vs0, vs1, ks0, ks1; } sr_[SDEPTH];
#define SLOAD(i, k0) do { const char* kb_ = (const char*)Kh + (size_t)(k0) * (LDK * 2); const char* vb_ = (const char*)Vh + (size_t)(k0) * (LDK * 2); \
    sr_[i].vs0 = *(const bf16x8*)(vb_ + lo0); sr_[i].vs1 = *(const bf16x8*)(vb_ + 32 * LDK * 2 + lo0); \
    sr_[i].ks0 = *(const bf16x8*)(kb_ + lo0); sr_[i].ks1 = *(const bf16x8*)(kb_ + 32 * LDK * 2 + lo0); } while (0)
#define SWRITE(b, i) do { *(bf16x8*)((char*)V_lds + (b) * SHM_V + vst0) = sr_[i].vs0;          \
    *(bf16x8*)((char*)V_lds + (b) * SHM_V + vst1) = sr_[i].vs1; int kc = sc * 2;               \
    *(bf16x8*)((char*)K_lds + (b) * SHM_K + KSWZ(sr, kc)) = sr_[i].ks0;                       \
    *(bf16x8*)((char*)K_lds + (b) * SHM_K + KSWZ(32 + sr, kc)) = sr_[i].ks1; } while (0)
#define SWAIT() do { if constexpr (SDEPTH == 2) asm volatile("s_waitcnt vmcnt(4)" ::: "memory"); else asm volatile("s_waitcnt vmcnt(0)" ::: "memory"); } while (0)
#define RESC(a) do { if (__any((a) < 1.f)) { const int ln_ = lane_now(), r32_ = ln_ & 31, hi_ = ln_ >> 5; float* al2_ = (float*)(lds + 2 * SHM_V + 2 * SHM_K) + wid * 64 + 32; \
    if (hi_ == 0) al2_[r32_] = (a); asm volatile("s_waitcnt lgkmcnt(0)" ::: "memory"); \
    for (int d = 0; d < 4; ++d) for (int r = 0; r < 16; ++r) o[d][r] *= al2_[crow(r, hi_)]; } } while (0)
  f32x16 pA0, pA1, pB0, pB1; float mnA, mnB, alA, alB; bf16x8 pa0, pa1, pa2, pa3; const int NT = seq / KVBLK;
  constexpr int SE = 0, SO = SDEPTH - 1;
  SLOAD(SE, 0); asm volatile("s_waitcnt vmcnt(0)" ::: "memory"); SWRITE(0, SE); __syncthreads();
  qkt(pA0, pA1, K_lds, qr, r32, hi); MK(pA0, pA1, 0); partialSM(pA0, pA1, m_reg, mnA, alA);
  SLOAD(SO, KVBLK); if constexpr (SDEPTH == 2) { if (2 < NT) SLOAD(SE, 2 * KVBLK); }
  SWAIT(); SWRITE(1, SO); __syncthreads();
  for (int j = 1; j + 1 < NT; j += 2) {
    SBAR(); qkt(pB0, pB1, (bf16_t*)((char*)K_lds + SHM_K), qr, r32, hi); MK(pB0, pB1, j);
    finishSM(pA0, pA1, alA, l_reg, pa0, pa1, pa2, pa3); SBAR();
    SLOAD(SO, (j + SDEPTH) * KVBLK); SBAR();
    pv_d0(o, vb0, pa0, pa1, pa2, pa3); partialSM(pB0, pB1, m_reg, mnB, alB);
    __syncthreads(); SWAIT(); SWRITE(0, SE);
    RESC(alB); __syncthreads();
    SBAR(); qkt(pA0, pA1, K_lds, qr, r32, hi); MK(pA0, pA1, j + 1);
    finishSM(pB0, pB1, alB, l_reg, pa0, pa1, pa2, pa3); SBAR();
    if (SDEPTH == 1 || j + 3 < NT) SLOAD(SE, (j + 1 + SDEPTH) * KVBLK); SBAR();
    pv_d0(o, vb0 + (int)SHM_V, pa0, pa1, pa2, pa3); partialSM(pA0, pA1, m_reg, mnA, alA);
    __syncthreads(); SWAIT(); SWRITE(1, SO);
    RESC(alA); __syncthreads();
  }
  SBAR(); qkt(pB0, pB1, (bf16_t*)((char*)K_lds + SHM_K), qr, r32, hi); MK(pB0, pB1, NT - 1);
  finishSM(pA0, pA1, alA, l_reg, pa0, pa1, pa2, pa3); SBAR();
  pv_d0(o, vb0, pa0, pa1, pa2, pa3); partialSM(pB0, pB1, m_reg, mnB, alB);
  __syncthreads(); RESC(alB);
  finishSM(pB0, pB1, alB, l_reg, pa0, pa1, pa2, pa3); SBAR();
  pv_d0(o, vb0 + (int)SHM_V, pa0, pa1, pa2, pa3);
  if (hi == 0) li_l[r32] = l_reg; asm volatile("s_waitcnt lgkmcnt(0)" ::: "memory");
  float rli[16];
#pragma unroll
  for (int r = 0; r < 16; ++r) rli[r] = __builtin_amdgcn_rcpf(li_l[crow(r, hi)]) * F8_YMUL;
  unsigned char* Ow = Ob + (long)(wid * QBLK) * LDO; const unsigned lane_off = (unsigned)(4 * hi * LDO + r32);
#pragma unroll
  for (int r = 0; r < 16; ++r) { unsigned char* rowb = Ow + ((r & 3) + 8 * (r >> 2)) * LDO;
#pragma unroll
    for (int d0 = 0; d0 < 4; ++d0) { const float v = o[d0][r] * rli[r]; rowb[lane_off + d0 * 32] = (unsigned char)(__builtin_amdgcn_cvt_pk_fp8_f32(v, v, 0, false) & 0xff); } }
#undef SLOAD
#undef SWRITE
#undef SWAIT
#undef RESC
}

template <int LDQ, int LDK, int LDO, class Mask>
__device__ __forceinline__ void attn_body_simple(const bf16_t* __restrict__ Qb, const bf16_t* __restrict__ Kh, const bf16_t* __restrict__ Vh,
                                                 unsigned char* __restrict__ Ob, int NT, char* lds, const Mask& MK, const int wid, const float* __restrict__ gq, const float* __restrict__ gk) {
  const int lane = lane_now(), tid = wid * 64 + lane, r32 = lane & 31, hi = lane >> 5;
  bf16_t* V_lds = (bf16_t*)lds; bf16_t* K_lds = (bf16_t*)(lds + 2 * SHM_V);
  float* ws = (float*)(lds + 2 * SHM_V + 2 * SHM_K) + wid * 64; float* li_l = ws; float* al_l = ws + 32;
  float m_reg = -1e30f, l_reg = 0; f32x16 o[4] = {}; bf16x8 qr[8];
  const bf16_t* Qw = Qb + (long)(wid * QBLK + r32) * LDQ + hi * 8;
#pragma unroll
  for (int d0 = 0; d0 < 8; ++d0) qr[d0] = ld8(Qw + d0 * 16);
  { float ss = 0.f;
#pragma unroll
    for (int d0 = 0; d0 < 8; ++d0) { const u32x4 w = __builtin_bit_cast(u32x4, qr[d0]); const float a0 = bf_lo(w.x), a1 = bf_hi(w.x), a2 = bf_lo(w.y), a3 = bf_hi(w.y), a4 = bf_lo(w.z), a5 = bf_hi(w.z), a6 = bf_lo(w.w), a7 = bf_hi(w.w);
        ss += (a0 * a0 + a1 * a1) + (a2 * a2 + a3 * a3) + (a4 * a4 + a5 * a5) + (a6 * a6 + a7 * a7); }
    { auto rr = __builtin_amdgcn_permlane32_swap(__float_as_uint(ss), __float_as_uint(ss), false, false); ss = __uint_as_float(rr[0]) + __uint_as_float(rr[1]); }
    const float rstd = 1.0f / sqrtf(ss * (1.f / 128.f) + EPS);
#pragma unroll
    for (int d0 = 0; d0 < 8; ++d0) { const u32x4 w = __builtin_bit_cast(u32x4, qr[d0]); const f32x4 g0 = *(const f32x4*)(gq + d0 * 16 + hi * 8), g1 = *(const f32x4*)(gq + d0 * 16 + hi * 8 + 4);
        u32x4 o; o.x = cvtpk(bf_lo(w.x) * rstd * g0.x, bf_hi(w.x) * rstd * g0.y); o.y = cvtpk(bf_lo(w.y) * rstd * g0.z, bf_hi(w.y) * rstd * g0.w);
        o.z = cvtpk(bf_lo(w.z) * rstd * g1.x, bf_hi(w.z) * rstd * g1.y); o.w = cvtpk(bf_lo(w.w) * rstd * g1.z, bf_hi(w.w) * rstd * g1.w); qr[d0] = __builtin_bit_cast(bf16x8, o); } }
  const int sr = tid >> 4, sc = (tid & 15) * 8, vst0 = v_st(sr, sc), vst1 = v_st(32 + sr, sc);
  const unsigned lo0 = (unsigned)(sr * LDK + sc) * 2u, lo1 = lo0 + 32u * LDK * 2u;
  const int vb0 = (int)(uintptr_t)V_lds + v_rd_base(lane);
  const f32x4 gk0 = *(const f32x4*)(gk + sc), gk1 = *(const f32x4*)(gk + sc + 4);
  bf16x8 vs0, vs1, ks0, ks1;
#define KNORM(kv) do { const u32x4 w_ = __builtin_bit_cast(u32x4, kv); const float a0 = bf_lo(w_.x), a1 = bf_hi(w_.x), a2 = bf_lo(w_.y), a3 = bf_hi(w_.y), a4 = bf_lo(w_.z), a5 = bf_hi(w_.z), a6 = bf_lo(w_.w), a7 = bf_hi(w_.w); \
    float ss_ = (a0 * a0 + a1 * a1) + (a2 * a2 + a3 * a3) + (a4 * a4 + a5 * a5) + (a6 * a6 + a7 * a7); ss_ += __shfl_xor(ss_, 1); ss_ += __shfl_xor(ss_, 2); ss_ += __shfl_xor(ss_, 4); ss_ += __shfl_xor(ss_, 8); \
    const float r_ = 1.0f / sqrtf(ss_ * (1.f / 128.f) + EPS); u32x4 o_; o_.x = cvtpk(a0 * r_ * gk0.x, a1 * r_ * gk0.y); o_.y = cvtpk(a2 * r_ * gk0.z, a3 * r_ * gk0.w); o_.z = cvtpk(a4 * r_ * gk1.x, a5 * r_ * gk1.y); o_.w = cvtpk(a6 * r_ * gk1.z, a7 * r_ * gk1.w); \
    kv = __builtin_bit_cast(bf16x8, o_); } while (0)
#define NLOAD(k0) do { const char* kb_ = (const char*)Kh + (size_t)(k0) * (LDK * 2); const char* vb_ = (const char*)Vh + (size_t)(k0) * (LDK * 2); \
    vs0 = *(const bf16x8*)(vb_ + lo0); vs1 = *(const bf16x8*)(vb_ + lo1); ks0 = *(const bf16x8*)(kb_ + lo0); ks1 = *(const bf16x8*)(kb_ + lo1); } while (0)
#define NWRITE(b) do { KNORM(ks0); KNORM(ks1); *(bf16x8*)((char*)V_lds + (b) * SHM_V + vst0) = vs0; *(bf16x8*)((char*)V_lds + (b) * SHM_V + vst1) = vs1; const int kc = sc * 2; \
    *(bf16x8*)((char*)K_lds + (b) * SHM_K + KSWZ(sr, kc)) = ks0; *(bf16x8*)((char*)K_lds + (b) * SHM_K + KSWZ(32 + sr, kc)) = ks1; } while (0)
  NLOAD(0); asm volatile("s_waitcnt vmcnt(0)" ::: "memory"); NWRITE(0); __syncthreads();
  for (int j = 0; j < NT; ++j) {
    const int bsel = j & 1;
    if (j + 1 < NT) NLOAD((j + 1) * KVBLK);
    f32x16 p0, p1; float mn, al; bf16x8 pa0, pa1, pa2, pa3;
    qkt(p0, p1, (const bf16_t*)((const char*)K_lds + bsel * SHM_K), qr, r32, hi); MK(p0, p1, j);
    partialSM(p0, p1, m_reg, mn, al);
    if (__any(al < 1.f)) { if (hi == 0) al_l[r32] = al; asm volatile("s_waitcnt lgkmcnt(0)" ::: "memory");
      for (int d = 0; d < 4; ++d) for (int r = 0; r < 16; ++r) o[d][r] *= al_l[crow(r, hi)]; }
    finishSM(p0, p1, al, l_reg, pa0, pa1, pa2, pa3); SBAR();
    pv_d0(o, vb0 + bsel * (int)SHM_V, pa0, pa1, pa2, pa3);
    if (j + 1 < NT) { asm volatile("s_waitcnt vmcnt(0)" ::: "memory"); NWRITE(bsel ^ 1); }
    __syncthreads();
  }
  if (hi == 0) li_l[r32] = l_reg; asm volatile("s_waitcnt lgkmcnt(0)" ::: "memory");
  float rli[16];
#pragma unroll
  for (int r = 0; r < 16; ++r) rli[r] = __builtin_amdgcn_rcpf(li_l[crow(r, hi)]) * F8_YMUL;
  unsigned char* Ow = Ob + (long)(wid * QBLK) * LDO; const unsigned lane_off = (unsigned)(4 * hi * LDO + r32);
#pragma unroll
  for (int r = 0; r < 16; ++r) { unsigned char* rowb = Ow + ((r & 3) + 8 * (r >> 2)) * LDO;
#pragma unroll
    for (int d0 = 0; d0 < 4; ++d0) { const float v = o[d0][r] * rli[r]; rowb[lane_off + d0 * 32] = (unsigned char)(__builtin_amdgcn_cvt_pk_fp8_f32(v, v, 0, false) & 0xff); } }
#undef NLOAD
#undef NWRITE
#undef KNORM
}
constexpr int F8_KT = 8192, F8_SCR = 49152;
#define MF8(a, b, c, sa, sb) __builtin_amdgcn_mfma_scale_f32_32x32x64_f8f6f4(a, b, c, 0, 0, 0, sa, 0, sb)
#define MFPV(a, b, c, sa, sb) __builtin_amdgcn_mfma_scale_f32_32x32x64_f8f6f4(a, b, c, 3, 2, 0, sa, 0, sb)
#define MF6(a, b, c, sa, sb) __builtin_amdgcn_mfma_scale_f32_32x32x64_f8f6f4(a, b, c, 2, 2, 0, sa, 0, sb)
__device__ __forceinline__ i32x8 cat8(const i32x4 lo, const i32x4 hi) { return __builtin_shufflevector(lo, hi, 0, 1, 2, 3, 4, 5, 6, 7); }
__device__ __forceinline__ i32x8 cat6(const i32x4 lo, const i32x2 hi) { i32x8 r; r[0] = lo[0]; r[1] = lo[1]; r[2] = lo[2]; r[3] = lo[3]; r[4] = hi[0]; r[5] = hi[1]; int u0, u1; asm volatile("" : "=v"(u0), "=v"(u1)); r[6] = u0; r[7] = u1; return r; }
template <bool REL>
__device__ __forceinline__ void qkt8(f32x16& p0, f32x16& p1, const char* Kt, const i32x8 (&qf)[2], const int (&ka)[2][2], const f32x16& negm) {
  const i32x8 k00 = cat6(*(const i32x4*)(Kt + ka[0][0]), *(const i32x2*)(Kt + ka[0][1])), k10 = cat6(*(const i32x4*)(Kt + 4096 + ka[0][0]), *(const i32x2*)(Kt + 4096 + ka[0][1]));
  const i32x8 k01 = cat6(*(const i32x4*)(Kt + ka[1][0]), *(const i32x2*)(Kt + ka[1][1])), k11 = cat6(*(const i32x4*)(Kt + 4096 + ka[1][0]), *(const i32x2*)(Kt + 4096 + ka[1][1]));
  asm volatile("" ::: "memory");
  const f32x16 zero = {};
  p0 = MF6(k00, qf[0], REL ? negm : zero, 126, 123); p1 = MF6(k10, qf[0], REL ? negm : zero, 126, 123); p0 = MF6(k01, qf[1], p0, 126, 123); p1 = MF6(k11, qf[1], p1, 126, 123);
}
__device__ __forceinline__ void partial8(f32x16& p0, f32x16& p1, float& m_reg, float& alpha) {
  float pmax = p0[0]; for (int r = 1; r < 16; ++r) pmax = fmaxf(pmax, p0[r]); for (int r = 0; r < 16; ++r) pmax = fmaxf(pmax, p1[r]);
  { auto rr = __builtin_amdgcn_permlane32_swap(__float_as_uint(pmax), __float_as_uint(pmax), false, false);
    pmax = fmaxf(__uint_as_float(rr[0]), __uint_as_float(rr[1])); }
  float mn;
  if (__builtin_expect(__all(pmax - m_reg <= PTHR), 1)) { mn = m_reg; alpha = 1.f; }
  else { mn = fmaxf(m_reg, pmax) + PHEAD0; alpha = __builtin_amdgcn_exp2f(m_reg - mn); m_reg = mn; }
  const float mb = mn - 4.0f;
  for (int r = 0; r < 16; ++r) p0[r] = p0[r] - mb; for (int r = 0; r < 16; ++r) p1[r] = p1[r] - mb;
  for (int r = 0; r < 16; ++r) p0[r] = __builtin_amdgcn_exp2f(p0[r]);
}
__device__ __forceinline__ void partial8r(f32x16& p0, f32x16& p1, float& m_reg, float& alpha, f32x16& negm) {
  float pmax = p0[0]; for (int r = 1; r < 16; ++r) pmax = fmaxf(pmax, p0[r]); for (int r = 0; r < 16; ++r) pmax = fmaxf(pmax, p1[r]);
  { auto rr = __builtin_amdgcn_permlane32_swap(__float_as_uint(pmax), __float_as_uint(pmax), false, false);
    pmax = fmaxf(__uint_as_float(rr[0]), __uint_as_float(rr[1])); }
  if (__builtin_expect(__all(pmax <= 4.0f + PTHR), 1)) { alpha = 1.f; }
  else { const float d = fmaxf(pmax - 4.0f + PHEAD, 0.f); alpha = __builtin_amdgcn_exp2f(-d); m_reg += d;
    for (int r = 0; r < 16; ++r) { p0[r] -= d; p1[r] -= d; negm[r] -= d; } }
  for (int r = 0; r < 16; ++r) p0[r] = __builtin_amdgcn_exp2f(p0[r]);
}
__device__ __forceinline__ int pk4_fp8_nz(float a, float b, float c, float d, int old) { int w = __builtin_amdgcn_cvt_pk_fp8_f32(a, b, old, false); return __builtin_amdgcn_cvt_pk_fp8_f32(c, d, w, true); }
__device__ __forceinline__ void finish8(const f32x16& p0, f32x16& p1, i32x8& pa) {
  for (int r = 0; r < 16; ++r) p1[r] = __builtin_amdgcn_exp2f(p1[r]);
  typedef unsigned u32x6_ __attribute__((ext_vector_type(6)));
  const u32x6_ pk = __builtin_amdgcn_cvt_scalef32_2xpk16_bf6_f32(p0, p1, 1.0f);
#pragma unroll
  for (int i = 0; i < 6; ++i) pa[i] = (int)pk[i];
  { int u0, u1; asm volatile("" : "=v"(u0), "=v"(u1)); pa[6] = u0; pa[7] = u1; }
}
__device__ __forceinline__ void pv8(f32x16 (&o)[4], f32x16& lacc, const char* Vt, const i32x8& pa, const int (&va)[2], const i32x8& ones) {
  lacc = MFPV(pa, ones, lacc, 127, 127);
#pragma unroll
  for (int d0 = 0; d0 < 4; ++d0) { const i32x8 vf = cat6(*(const i32x4*)(Vt + d0 * 2048 + va[0]), *(const i32x2*)(Vt + d0 * 2048 + va[1]));
    o[d0] = MFPV(pa, vf, o[d0], 127, 126); }
}
struct NoConv { static constexpr bool ON = false; __device__ __forceinline__ bool on() const { return false; } __device__ __forceinline__ void step(int, int) {} __device__ __forceinline__ void end() {} };
template <int LDO, class CV>
__device__ __forceinline__ void attn_body_f8(const unsigned char* __restrict__ Q8b, const unsigned char* __restrict__ K8h, const unsigned char* __restrict__ Vt8h,
                                             unsigned char* __restrict__ Ob, int seq, char* lds, LAS unsigned char* ldsl, const int wid, CV& cvx) {
  const int lane = lane_now(), tid = wid * 64 + lane, r32 = lane & 31, hi = lane >> 5;
  char* K_lds = lds; char* V_lds = lds + 3 * F8_KT;
  float m_reg = -1e30f; f32x16 o[4] = {}; f32x16 lacc = {}; i32x8 qf[2];
  { const unsigned char* qrow = Q8b + (size_t)(wid * QBLK + r32) * HD + hi * 32;
#pragma unroll
    for (int dh = 0; dh < 2; ++dh) qf[dh] = cat8(*(const i32x4*)(qrow + dh * 64), *(const i32x4*)(qrow + dh * 64 + 16)); }
  int ka[2][2]; { const int sw = (r32 >> 1) & 7;
#pragma unroll
    for (int dh = 0; dh < 2; ++dh)
#pragma unroll
      for (int e = 0; e < 2; ++e) ka[dh][e] = r32 * 128 + (((dh * 4 + hi * 2 + e) ^ sw) << 4); }
  int va[2]; { const int sw = (r32 >> 2) & 3;
#pragma unroll
    for (int e = 0; e < 2; ++e) va[e] = r32 * 64 + (((hi * 2 + e) ^ sw) << 4); }
  const int kp_row = wid * 8 + (lane >> 3), kp_c = (lane & 7) ^ ((kp_row >> 1) & 7); const unsigned kgo = (unsigned)(kp_row * 128 + kp_c * 16);
  const int vp_d = wid * 16 + (lane >> 2), vp_c = (lane & 3) ^ ((vp_d >> 2) & 3); const unsigned vgo = (unsigned)(vp_d * 64 + vp_c * 16);
#define DMA8(slot, t) do { \
    __builtin_amdgcn_global_load_lds((const unsigned*)(K8h + (size_t)(t) * 8192 + kgo), (LAS unsigned*)(ldsl + (slot) * F8_KT + wid * 1024), 16, 0, 0); \
    __builtin_amdgcn_global_load_lds((const unsigned*)(Vt8h + (size_t)(t) * 8192 + vgo), (LAS unsigned*)(ldsl + (3 + (slot)) * F8_KT + wid * 1024), 16, 0, 0); } while (0)
#define TBAR() do { if (cvx.on()) asm volatile("s_waitcnt vmcnt(1) lgkmcnt(0)" ::: "memory"); else asm volatile("s_waitcnt vmcnt(0) lgkmcnt(0)" ::: "memory"); \
    __builtin_amdgcn_s_barrier(); asm volatile("" ::: "memory"); } while (0)
#define RESC8(a) do { if (__any((a) < 1.f)) { const int ln_ = lane_now(), r32_ = ln_ & 31, hi_ = ln_ >> 5; float* al2_ = (float*)(lds + F8_SCR) + wid * 64; \
    if (hi_ == 0) al2_[r32_] = (a); asm volatile("s_waitcnt lgkmcnt(0)" ::: "memory"); \
    for (int r = 0; r < 16; ++r) { const float f_ = al2_[crow(r, hi_)]; for (int d = 0; d < 4; ++d) o[d][r] *= f_; lacc[r] *= f_; } } } while (0)
  f32x16 pA0, pA1, pB0, pB1; float alA, alB; i32x8 pa; const int NT = seq / KVBLK;
  i32x8 ones = {(int)0x08208208, (int)0x82082082, (int)0x20820820, (int)0x08208208, (int)0x82082082, (int)0x20820820, 0, 0};
  asm volatile("" : "+v"(ones));
  DMA8(0, 0); DMA8(1, 1);
  cvx.step(0, 0);
  asm volatile("s_waitcnt vmcnt(0)" ::: "memory"); __builtin_amdgcn_s_barrier(); asm volatile("" ::: "memory");
  f32x16 negm = {};
  qkt8<false>(pA0, pA1, K_lds, qf, ka, negm); partial8(pA0, pA1, m_reg, alA);
  { const float nm = 4.0f - m_reg; for (int r = 0; r < 16; ++r) negm[r] = nm; }
  int ks = 1, vs = 0, wsl = 2;
#define RING_NEXT() do { ks = (ks == 2) ? 0 : ks + 1; vs = (vs == 2) ? 0 : vs + 1; wsl = (wsl == 2) ? 0 : wsl + 1; } while (0)
  for (int j = 1; j + 1 < NT; j += 2) {
    TBAR(); DMA8(wsl, j + 1);
    cvx.step(j, 2);
    SBAR(); qkt8<true>(pB0, pB1, K_lds + ks * F8_KT, qf, ka, negm);
    finish8(pA0, pA1, pa); SBAR();
    pv8(o, lacc, V_lds + vs * F8_KT, pa, va, ones); partial8r(pB0, pB1, m_reg, alB, negm);
    RESC8(alB); RING_NEXT();
    TBAR(); const bool more = j + 2 < NT; if (more) DMA8(wsl, j + 2);
    cvx.step(j + 1, more ? 2 : 0);
    SBAR(); qkt8<true>(pA0, pA1, K_lds + ks * F8_KT, qf, ka, negm);
    finish8(pB0, pB1, pa); SBAR();
    pv8(o, lacc, V_lds + vs * F8_KT, pa, va, ones); partial8r(pA0, pA1, m_reg, alA, negm);
    RESC8(alA); RING_NEXT();
  }
  TBAR();
  cvx.step(NT - 1, 0);
  SBAR(); qkt8<true>(pB0, pB1, K_lds + ks * F8_KT, qf, ka, negm);
  finish8(pA0, pA1, pa); SBAR();
  pv8(o, lacc, V_lds + vs * F8_KT, pa, va, ones); partial8r(pB0, pB1, m_reg, alB, negm);
  RESC8(alB); RING_NEXT();
  finish8(pB0, pB1, pa); SBAR();
  pv8(o, lacc, V_lds + vs * F8_KT, pa, va, ones);
#undef RING_NEXT
  cvx.end();
  const int le_ = lane_now();
  unsigned char* Ow = Ob + (long)(wid * QBLK) * LDO; const unsigned lane_off = (unsigned)(4 * (le_ >> 5) * LDO + (le_ & 31));
#pragma unroll
  for (int r = 0; r < 16; ++r) { unsigned char* rowb = Ow + ((r & 3) + 8 * (r >> 2)) * LDO; const float rl = __builtin_amdgcn_rcpf(lacc[r]) * F8_YMUL;
#pragma unroll
    for (int d0 = 0; d0 < 4; ++d0) { const float v = o[d0][r] * rl; rowb[lane_off + d0 * 32] = (unsigned char)(__builtin_amdgcn_cvt_pk_fp8_f32(v, v, 0, false) & 0xff); } }
#undef DMA8
#undef TBAR
#undef RESC8
}
}

#define XB_TMO      128
#define XB_XCNT(j)  (256  + 64 * (j))
#define XB_XSUB(j)  (1280 + 64 * (j))
#define XB_XGEN(j)  (2304 + 64 * (j))
#define XB_TOP      3328
#define XB_TOPGEN   3392
#define XCD_BAR_WORDS 3456
#define XB_SPIN_CAP (1u << 18)
__device__ __forceinline__ unsigned xb_ld(unsigned* p)              { return __hip_atomic_load(p, __ATOMIC_RELAXED, __HIP_MEMORY_SCOPE_AGENT); }
__device__ __forceinline__ unsigned xb_add(unsigned* p, unsigned v) { return __hip_atomic_fetch_add(p, v, __ATOMIC_RELAXED, __HIP_MEMORY_SCOPE_AGENT); }
__device__ __forceinline__ unsigned xb_xcc_id() { return (unsigned)__builtin_amdgcn_s_getreg((3 << 11) | 20) & 0xFu; }
#define XB_SPIN(cond, bar) do { unsigned _sp = 0; while (cond) { __builtin_amdgcn_s_sleep(1); \
    if ((++_sp & 255u) == 0u) { if (xb_ld(&(bar)[XB_TMO])) break; if (_sp > XB_SPIN_CAP) { atomicAdd(&(bar)[XB_TMO], 1u); break; } } } } while (0)
struct XcdBarrier { unsigned* bar; unsigned x; volatile LAS unsigned* st; };
__device__ __forceinline__ XcdBarrier xcd_barrier_post(unsigned* bar, volatile LAS unsigned* st, const bool t0) {
    XcdBarrier b; b.bar = bar; b.x = xb_xcc_id(); b.st = st;
    if (t0) (void)xb_add(&bar[XB_XCNT(b.x)], 1u);
    return b;
}
__device__ __forceinline__ void xcd_barrier_complete(unsigned* bar, unsigned x, unsigned& nloc, unsigned& nx) {
    const unsigned G = gridDim.x * gridDim.y * gridDim.z;
    unsigned sum, cnt, mine, sp = 0u;
    for (;;) {
        sum = 0u; cnt = 0u; mine = 0u;
#pragma unroll
        for (unsigned j = 0; j < 16; ++j) { const unsigned c = xb_ld(&bar[XB_XCNT(j)]); sum += c; cnt += (c > 0u) ? 1u : 0u; mine = (j == x) ? c : mine; }
        if (sum == G) break;
        __builtin_amdgcn_s_sleep(1);
        if ((++sp & 255u) == 0u) { if (xb_ld(&bar[XB_TMO])) break; if (sp > XB_SPIN_CAP) { atomicAdd(&bar[XB_TMO], 1u); break; } }
    }
    nloc = mine > 0u ? mine : 1u; nx = cnt > 0u ? cnt : 1u;
}
__device__ __forceinline__ void xcd_barrier(const XcdBarrier& b, const bool t0) {
    asm volatile("s_waitcnt vmcnt(0)" ::: "memory");
    __syncthreads();
    if (t0) {
        unsigned* bar = b.bar;
        __builtin_amdgcn_s_waitcnt(0);
        unsigned nloc = b.st[0], nx = b.st[1];
        if (nloc == 0u) { xcd_barrier_complete(bar, b.x, nloc, nx); b.st[0] = nloc; b.st[1] = nx; }
        const unsigned old = xb_add(&bar[XB_XSUB(b.x)], 1u);
        const unsigned gen = old / nloc;
        if (old + 1u == (gen + 1u) * nloc) {
            __builtin_amdgcn_fence(__ATOMIC_RELEASE, "agent");
            asm volatile("s_waitcnt vmcnt(0)" ::: "memory");
            const unsigned og = xb_add(&bar[XB_TOP], 1u);
            const unsigned tg = og / nx;
            if (og + 1u == (tg + 1u) * nx) xb_add(&bar[XB_TOPGEN], 1u);
            else XB_SPIN(xb_ld(&bar[XB_TOPGEN]) == tg, bar);
            __builtin_amdgcn_fence(__ATOMIC_ACQUIRE, "agent");
            xb_add(&bar[XB_XGEN(b.x)], 1u);
            asm volatile("s_waitcnt vmcnt(0)" ::: "memory");
        } else {
            XB_SPIN(xb_ld(&bar[XB_XGEN(b.x)]) == gen, bar);
            __builtin_amdgcn_fence(__ATOMIC_ACQUIRE, "agent");
            asm volatile("s_waitcnt vmcnt(0)" ::: "memory");
        }
    }
    __syncthreads();
}

struct Frame {
    LAS unsigned char* lds;
    volatile LAS unsigned* MISC;
    gu32* ctl;
    int tid, lane, wave, G, bx;
    float* out; unsigned char* ws;
};
__device__ __forceinline__ const float* inp(int k) {
    const __attribute__((address_space(4))) char* kp = (const __attribute__((address_space(4))) char*)__builtin_amdgcn_kernarg_segment_ptr();
    asm volatile("" : "+s"(kp));
    return *(const float* const __attribute__((address_space(4)))*)(kp + 8 * k);
}
__device__ __forceinline__ float wave_sum(float v) {
#pragma unroll
    for (int o = 1; o < 64; o <<= 1) v += __shfl_xor(v, o);
    return v;
}
__device__ __forceinline__ unsigned f2bf(float f) { unsigned u = __builtin_bit_cast(unsigned, f); return (u + 0x7fffu + ((u >> 16) & 1u)) >> 16; }
__device__ __forceinline__ unsigned pk2(float lo, float hi) { return f2bf(lo) | (f2bf(hi) << 16); }

__device__ __forceinline__ void tr_item(const float* W, int N, bf16_t* WT, int K, int k0, int n0, size_t dst_row0, LAS float* scr, int lane) {
#pragma unroll
    for (int i = 0; i < 32; ++i) { const int kk = 2 * i + (lane >> 5); scr[kk * 33 + (lane & 31)] = W[(size_t)(k0 + kk) * N + n0 + (lane & 31)]; }
    LDS_WAIT(); asm volatile("" ::: "memory");
    const int c = lane & 7;
#pragma unroll
    for (int j = 0; j < 4; ++j) { const int n = (lane >> 3) + 8 * j; const LAS float* s = scr + (8 * c) * 33 + n;
        u32x4 o; o.x = pk2(s[0 * 33], s[1 * 33]); o.y = pk2(s[2 * 33], s[3 * 33]); o.z = pk2(s[4 * 33], s[5 * 33]); o.w = pk2(s[6 * 33], s[7 * 33]);
        *(GAS u32x4*)(WT + (dst_row0 + n) * K + k0 + 8 * c) = o; }
    LDS_WAIT(); asm volatile("" ::: "memory");
}
template <bool KG> __device__ __forceinline__ void tr_item_f8(const float* W, int N, unsigned char* WT, int K, int k0, int n0, size_t dst_row0, LAS float* scr, int lane, const float* kg = nullptr) {
#pragma unroll
    for (int i = 0; i < 32; ++i) { const int kk = 2 * i + (lane >> 5); scr[kk * 33 + (lane & 31)] = W[(size_t)(k0 + kk) * N + n0 + (lane & 31)]; }
    LDS_WAIT(); asm volatile("" ::: "memory");
    const int c = lane & 7;
    f32x4 m0 = {F8_WMUL, F8_WMUL, F8_WMUL, F8_WMUL}, m1 = m0;
    if (KG) { m0 = *(const f32x4*)(kg + k0 + 8 * c) * F8_WMUL; m1 = *(const f32x4*)(kg + k0 + 8 * c + 4) * F8_WMUL; }
#pragma unroll
    for (int j = 0; j < 4; ++j) { const int n = (lane >> 3) + 8 * j; const LAS float* s = scr + (8 * c) * 33 + n;
        u32x2 o; o.x = pk4_fp8(s[0 * 33] * m0.x, s[1 * 33] * m0.y, s[2 * 33] * m0.z, s[3 * 33] * m0.w); o.y = pk4_fp8(s[4 * 33] * m1.x, s[5 * 33] * m1.y, s[6 * 33] * m1.z, s[7 * 33] * m1.w);
        *(GAS u32x2*)(WT + (dst_row0 + n) * K + k0 + 8 * c) = o; }
    LDS_WAIT(); asm volatile("" ::: "memory");
}
__device__ __forceinline__ void rms_row_to_fp8(int lane, const float* xrow, const float* g, unsigned char* orow) {
    const GAS f32x4* xr = (const GAS f32x4*)xrow + lane; const GAS f32x4* gr = (const GAS f32x4*)g + lane;
    f32x4 v[8]; float s = 0.f;
#pragma unroll
    for (int j = 0; j < 8; ++j) { v[j] = xr[64 * j]; s += (v[j].x * v[j].x + v[j].y * v[j].y) + (v[j].z * v[j].z + v[j].w * v[j].w); }
    const float rstd = 1.0f / sqrtf(wave_sum(s) * (1.f / D) + EPS);
    GAS unsigned* o8 = (GAS unsigned*)orow + lane;
#pragma unroll
    for (int j = 0; j < 8; ++j) { const f32x4 gg = gr[64 * j]; o8[64 * j] = pk4_fp8(v[j].x * rstd * gg.x, v[j].y * rstd * gg.y, v[j].z * rstd * gg.z, v[j].w * rstd * gg.w); }
}
__device__ __forceinline__ void sincos_d(double a, float& c, float& s) {
    const double TWO_OVER_PI = 0.63661977236758134308, PIO2_HI = 1.57079632679489655800e+00, PIO2_LO = 6.12323399573676603587e-17;
    const double q = __builtin_rint(a * TWO_OVER_PI); const double r = (a - q * PIO2_HI) - q * PIO2_LO; const int n = (int)q & 3;
    const double r2 = r * r;
    double sp = -1.0 / 1307674368000.0; sp = sp * r2 + 1.0 / 6227020800.0; sp = sp * r2 - 1.0 / 39916800.0; sp = sp * r2 + 1.0 / 362880.0; sp = sp * r2 - 1.0 / 5040.0; sp = sp * r2 + 1.0 / 120.0; sp = sp * r2 - 1.0 / 6.0; sp = sp * r2 + 1.0;
    const double sn = sp * r;
    double cp = 1.0 / 20922789888000.0; cp = cp * r2 - 1.0 / 87178291200.0; cp = cp * r2 + 1.0 / 479001600.0; cp = cp * r2 - 1.0 / 3628800.0; cp = cp * r2 + 1.0 / 40320.0; cp = cp * r2 - 1.0 / 720.0; cp = cp * r2 + 1.0 / 24.0; cp = cp * r2 - 0.5; cp = cp * r2 + 1.0;
    const double cs = cp;
    double so, co;
    if (n == 0) { so = sn; co = cs; } else if (n == 1) { so = cs; co = -sn; } else if (n == 2) { so = -sn; co = -cs; } else { so = -cs; co = sn; }
    c = (float)co; s = (float)so;
}
__device__ __forceinline__ double inv_freq_d(int f) {
    const double t[32] = {1.0, 0.7498942093324559, 0.5623413251903491, 0.4216965034285822, 0.31622776601683794, 0.23713737056616552, 0.1778279410038923, 0.1333521432163324, 0.09999999999999999, 0.07498942093324558, 0.056234132519034905, 0.042169650342858224, 0.03162277660168379, 0.023713737056616554, 0.01778279410038923, 0.013335214321633239, 0.01, 0.007498942093324559, 0.005623413251903491, 0.004216965034285822, 0.0031622776601683794, 0.002371373705661655, 0.0017782794100389228, 0.0013335214321633238, 0.001, 0.0007498942093324559, 0.000562341325190349, 0.00042169650342858224, 0.00031622776601683794, 0.00023713737056616554, 0.0001778279410038923, 0.0001333521432163324};
    double r = t[0];
#pragma unroll
    for (int i = 1; i < 32; ++i) r = (f == i) ? t[i] : r;
    return r;
}

struct P0Item { const float* src; unsigned char* dst; const float* kg; int N, K, k0, n0; size_t drow0; };
__device__ __forceinline__ void p0_decode(int it, unsigned char* ws, P0Item& d) {
    constexpr int I_IN = 32 * 272, I_PA = 16 * 64, I_OUT = 32 * 64, I_EX = NE * 32 * 64;
    int r = it; d.kg = nullptr;
    if (r < I_IN) { const int kb = r / 272, nb = r % 272; d.src = inp(2); d.N = NCOLS; d.dst = ws + WS_WIN; d.K = D; d.k0 = 64 * kb; d.n0 = 32 * nb; d.drow0 = (size_t)32 * nb; return; } r -= I_IN;
    if (r < I_PA) { const int kb = r / 64, nb = r % 64; d.src = inp(8); d.N = D; d.dst = ws + WS_WPA; d.K = 1024; d.k0 = 64 * kb; d.n0 = 32 * nb; d.drow0 = (size_t)32 * nb; return; } r -= I_PA;
    if (r < I_PA) { const int kb = r / 64, nb = r % 64; d.src = inp(9); d.N = D; d.dst = ws + WS_WPB; d.K = 1024; d.k0 = 64 * kb; d.n0 = 32 * nb; d.drow0 = (size_t)32 * nb; return; } r -= I_PA;
    if (r < I_OUT) { const int kb = r / 64, nb = r % 64; d.src = inp(10); d.N = D; d.dst = ws + WS_WOUT; d.K = D; d.k0 = 64 * kb; d.n0 = 32 * nb; d.drow0 = (size_t)32 * nb; return; } r -= I_OUT;
    const int which = r / I_EX; r -= which * I_EX; const int e = r / 2048, rr = r % 2048, kb = rr / 64, nb = rr % 64, n0 = 32 * nb;
    d.k0 = 64 * kb; d.n0 = n0;
    if (which == 0) { d.src = inp(14) + (size_t)e * D * DE; d.N = DE; d.dst = ws + WS_WGU + (size_t)e * 4096 * D; d.K = D; d.drow0 = (size_t)((n0 >> 7) * 256 + (n0 & 127)); d.kg = inp(11); }
    else if (which == 1) { d.src = inp(16) + (size_t)e * D * DE; d.N = DE; d.dst = ws + WS_WGU + (size_t)e * 4096 * D; d.K = D; d.drow0 = (size_t)((n0 >> 7) * 256 + 128 + (n0 & 127)); d.kg = inp(11); }
    else { d.src = inp(18) + (size_t)e * DE * D; d.N = D; d.dst = ws + WS_WD + (size_t)e * 2048 * DE; d.K = DE; d.drow0 = (size_t)n0; }
}
__device__ __forceinline__ void p0_load(const P0Item& d, float (&v)[32], int lane) {
    const float* p = d.src + (size_t)(d.k0 + (lane >> 5)) * d.N + d.n0 + (lane & 31);
#pragma unroll
    for (int i = 0; i < 32; ++i) v[i] = p[(size_t)(2 * i) * d.N];
}
__device__ __forceinline__ void p0_finish(const P0Item& d, const float (&v)[32], LAS float* scr, int lane) {
#pragma unroll
    for (int i = 0; i < 32; ++i) scr[(2 * i + (lane >> 5)) * 33 + (lane & 31)] = v[i];
    LDS_WAIT(); asm volatile("" ::: "memory");
    const int c = lane & 7;
    f32x4 m0 = {F8_WMUL, F8_WMUL, F8_WMUL, F8_WMUL}, m1 = m0;
    if (d.kg) { m0 = *(const f32x4*)(d.kg + d.k0 + 8 * c) * F8_WMUL; m1 = *(const f32x4*)(d.kg + d.k0 + 8 * c + 4) * F8_WMUL; }
#pragma unroll
    for (int j = 0; j < 4; ++j) { const int n = (lane >> 3) + 8 * j; const LAS float* s = scr + (8 * c) * 33 + n;
        u32x2 o; o.x = pk4_fp8(s[0 * 33] * m0.x, s[1 * 33] * m0.y, s[2 * 33] * m0.z, s[3 * 33] * m0.w); o.y = pk4_fp8(s[4 * 33] * m1.x, s[5 * 33] * m1.y, s[6 * 33] * m1.z, s[7 * 33] * m1.w);
        *(GAS u32x2*)(d.dst + (d.drow0 + n) * d.K + d.k0 + 8 * c) = o; }
    LDS_WAIT(); asm volatile("" ::: "memory");
}
constexpr int P0_I_FIRST = 32 * 272 + 2 * 16 * 64 + 32 * 64, P0_I_ALL = P0_I_FIRST + 3 * NE * 32 * 64;
struct ConvW {
    static constexpr bool ON = true;
    const float* src0; unsigned char* dst0; size_t sstride, dstride; int N, K, k0; size_t drow0; bool kgf, act;
    LAS float* scr; const LAS float* gl;
    __device__ __forceinline__ void init(unsigned char* ws, int unit, int slot) {
        P0Item d; p0_decode(P0_I_FIRST + (unit * 32) * 2048 + slot, ws, d);
        src0 = d.src + (size_t)d.k0 * d.N + d.n0; dst0 = d.dst; N = d.N; K = d.K; k0 = d.k0; drow0 = d.drow0; kgf = d.kg != nullptr;
        sstride = (size_t)D * DE; dstride = (unit < 2) ? (size_t)4096 * D : (size_t)2048 * DE;
    }
    __device__ __forceinline__ bool on() const { return act; }
    __device__ __forceinline__ void finish(int q) {
        const int lane = lane_now(), c = lane & 7;
        f32x4 m0 = {F8_WMUL, F8_WMUL, F8_WMUL, F8_WMUL}, m1 = m0;
        if (kgf) { m0 = *(const LAS f32x4*)(gl + k0 + 8 * c) * F8_WMUL; m1 = *(const LAS f32x4*)(gl + k0 + 8 * c + 4) * F8_WMUL; }
        unsigned char* dq = dst0 + (size_t)q * dstride;
#pragma unroll
        for (int j = 0; j < 4; ++j) { const int n = (lane >> 3) + 8 * j; const LAS float* s = scr + c * 256 + ((((n >> 2) + c) & 7) << 2) + (n & 3);
            u32x2 o; o.x = pk4_fp8(s[0 * 32] * m0.x, s[1 * 32] * m0.y, s[2 * 32] * m0.z, s[3 * 32] * m0.w); o.y = pk4_fp8(s[4 * 32] * m1.x, s[5 * 32] * m1.y, s[6 * 32] * m1.z, s[7 * 32] * m1.w);
            __builtin_nontemporal_store(o, (GAS u32x2*)(dq + (drow0 + n) * K + k0 + 8 * c)); }
    }
    __device__ __forceinline__ void step(int c, int newer) {
        if (!act) return;
        if ((c & 7) == 0 && c > 0) { if (newer == 2) asm volatile("s_waitcnt vmcnt(2)" ::: "memory"); else asm volatile("s_waitcnt vmcnt(0)" ::: "memory");
            finish((c >> 3) - 1); }
        const int lane = lane_now(), sblk = c & 7;
        const float* src = src0 + (size_t)(c >> 3) * sstride + (size_t)(8 * sblk + (lane >> 3)) * N + 4 * (((lane & 7) - sblk) & 7);
        __builtin_amdgcn_global_load_lds((const unsigned*)src, (LAS unsigned*)(scr + sblk * 256), 16, 0, 2);
    }
    __device__ __forceinline__ void end() { if (!act) return; asm volatile("s_waitcnt vmcnt(0)" ::: "memory"); finish(31); }
};
__device__ __forceinline__ void p0_prologue(Frame& F) {
    LAS float* scr = (LAS float*)(F.lds + RING_OFF + F.wave * 16384);
    const int gw = F.bx * NWAVES + F.wave, NGW = F.G * NWAVES;
    unsigned char* ws = F.ws;
    const int NITEMS = (F.G == 256) ? P0_I_FIRST : P0_I_ALL;
    { P0Item A, B; float va[32], vb[32]; int it = gw;
      if (it < NITEMS) { p0_decode(it, ws, A); p0_load(A, va, F.lane);
        for (;;) {
            const bool hb = it + NGW < NITEMS; if (hb) { p0_decode(it + NGW, ws, B); p0_load(B, vb, F.lane); }
            p0_finish(A, va, scr, F.lane); if (!hb) break;
            it += 2 * NGW; const bool ha = it < NITEMS; if (ha) { p0_decode(it, ws, A); p0_load(A, va, F.lane); }
            p0_finish(B, vb, scr, F.lane); if (!ha) break;
        } } }
    for (int m = gw; m < NTOK; m += NGW) rms_row_to_fp8(F.lane, inp(0) + (size_t)m * D, inp(1), (unsigned char*)(ws + WS_H) + (size_t)m * D);
    { float* tab = (float*)(ws + WS_TAB); const int gid = F.bx * 512 + F.tid;
      if (gid < 320 * 32) { const int pos = gid >> 5, f = gid & 31; const int p = pos < 256 ? pos : pos - 256; float c, s; sincos_d((double)p * inv_freq_d(f), c, s);
        if (pos < 256) { tab[pos * 32 + f] = c; tab[8192 + pos * 32 + f] = s; } else { tab[16384 + p * 32 + f] = c; tab[16384 + 2048 + p * 32 + f] = s; } } }
}

__device__ __forceinline__ void p2_qknorm(Frame& F) {
    const float* tab = (const float*)(F.ws + WS_TAB);
    const int l16 = F.lane & 15, g4 = F.lane >> 4, gw = F.bx * NWAVES + F.wave, NGW = F.G * NWAVES;
    constexpr int R_QA = 2 * 8 * SEQ, R_KA = 2 * 2 * SEQ, NCH = (R_QA + R_KA) / 16;
    const int axis = l16 >> 3, half = (l16 >> 2) & 1;
    const int cch = gw, cstep = NGW, cend = NCH;
    u32x4 w[4];
#define P2_LOAD(dst, chx) do { int r_ = (chx) * 16; const bf16_t* b_ = (const bf16_t*)(F.ws + WS_QA); if (r_ >= R_QA) { r_ -= R_QA; b_ = (const bf16_t*)(F.ws + WS_KA); } \
        _Pragma("unroll") for (int k = 0; k < 4; ++k) dst[k] = *(const u32x4*)(b_ + (size_t)(r_ + 4 * k + g4) * HD + 8 * l16); } while (0)
    if (cch < cend) P2_LOAD(w, cch);
    for (int ch = cch; ch < cend; ch += cstep) {
        int r0 = ch * 16; const float* g; unsigned char* o8; float omul = 1.0f;
        if (r0 < R_QA) { g = inp(3); o8 = F.ws + WS_Q8; omul = att::QMUL; }
        else { r0 -= R_QA; g = inp(4); o8 = F.ws + WS_K8; omul = att::KMUL; }
        u32x4 wn[4];
#pragma unroll
        for (int k = 0; k < 4; ++k) wn[k] = w[k];
        if (ch + cstep < cend) P2_LOAD(wn, ch + cstep);
        const f32x4 g0 = *(const f32x4*)(g + 8 * l16), g1 = *(const f32x4*)(g + 8 * l16 + 4);
#pragma unroll
        for (int k = 0; k < 4; ++k) {
            const int row = r0 + 4 * k + g4;
            float x[8] = {bf_lo(w[k].x), bf_hi(w[k].x), bf_lo(w[k].y), bf_hi(w[k].y), bf_lo(w[k].z), bf_hi(w[k].z), bf_lo(w[k].w), bf_hi(w[k].w)};
            float ss = 0.f;
#pragma unroll
            for (int i = 0; i < 8; ++i) ss += x[i] * x[i];
            ss += __shfl_xor(ss, 1); ss += __shfl_xor(ss, 2); ss += __shfl_xor(ss, 4); ss += __shfl_xor(ss, 8);
            const float rstd = 1.0f / sqrtf(ss * (1.f / 128.f) + EPS);
#pragma unroll
            for (int i = 0; i < 4; ++i) { x[i] = x[i] * rstd * g0[i]; x[4 + i] = x[4 + i] * rstd * g1[i]; }
            const int sq = row & (SEQ - 1), pos = axis ? (sq & 63) : (sq >> 6);
            const float* ct = tab + (axis ? 16384 : 0) + pos * 32 + 8 * (l16 & 3); const float* st = ct + (axis ? 2048 : 8192);
            const f32x4 c0 = *(const f32x4*)ct, c1 = *(const f32x4*)(ct + 4), s0 = *(const f32x4*)st, s1 = *(const f32x4*)(st + 4);
            float y[8];
#pragma unroll
            for (int i = 0; i < 8; ++i) { const float pr = __shfl_xor(x[i], 4); const float cc = i < 4 ? c0[i & 3] : c1[i & 3], sn = i < 4 ? s0[i & 3] : s1[i & 3];
                y[i] = half ? (x[i] * cc + pr * sn) : (x[i] * cc - pr * sn); }
            unsigned c6[8];
#pragma unroll
            for (int i = 0; i < 8; ++i) c6[i] = f6_e2m3(y[i] * omul);
            const unsigned lo = c6[0] | (c6[1] << 6) | (c6[2] << 12) | (c6[3] << 18) | (c6[4] << 24) | (c6[5] << 30), hi16 = (c6[5] >> 2) | (c6[6] << 4) | (c6[7] << 10);
            const unsigned plo = (unsigned)__builtin_amdgcn_update_dpp(0, (int)lo, 0xB1, 0xf, 0xf, false), phi = (unsigned)__builtin_amdgcn_update_dpp(0, (int)hi16, 0xB1, 0xf, 0xf, false);
            if (!(l16 & 1)) { unsigned* dst = (unsigned*)(o8 + (size_t)row * HD + (l16 >> 2) * 32 + ((l16 & 3) >> 1) * 12);
                dst[0] = lo; dst[1] = hi16 | (plo << 16); dst[2] = (plo >> 16) | (phi << 16); }
        }
#pragma unroll
        for (int k = 0; k < 4; ++k) w[k] = wn[k];
    }
#undef P2_LOAD
    LAS unsigned char* vt = F.lds + RING_OFF + F.wave * 16384;
    for (int T = gw; T < 2 * 2 * (SEQ / 64); T += NGW) {
        const bf16_t* vsrc = (const bf16_t*)(F.ws + WS_VA) + ((size_t)T * 64 + F.lane) * HD;
#pragma unroll
        for (int c = 0; c < 16; ++c) { const u32x4 w = *(const u32x4*)(vsrc + 8 * c);
            u32x2 q;
            q.x = f6_e2m3(bf_lo(w.x) * att::VMUL) | (f6_e2m3(bf_hi(w.x) * att::VMUL) << 8) | (f6_e2m3(bf_lo(w.y) * att::VMUL) << 16) | (f6_e2m3(bf_hi(w.y) * att::VMUL) << 24);
            q.y = f6_e2m3(bf_lo(w.z) * att::VMUL) | (f6_e2m3(bf_hi(w.z) * att::VMUL) << 8) | (f6_e2m3(bf_lo(w.w) * att::VMUL) << 16) | (f6_e2m3(bf_hi(w.w) * att::VMUL) << 24);
            *(LAS u32x2*)(vt + F.lane * 144 + 8 * c) = q; }
        LDS_WAIT(); asm volatile("" ::: "memory");
#pragma unroll
        for (int dd = 0; dd < 2; ++dd) { const int d = F.lane + 64 * dd;
            unsigned char* dst = F.ws + WS_VT8 + (size_t)T * 8192 + (size_t)d * 64;
#pragma unroll
            for (int hh = 0; hh < 2; ++hh) { unsigned wv[6] = {0u, 0u, 0u, 0u, 0u, 0u};
#pragma unroll
                for (int j = 0; j < 32; ++j) { const int key = (j < 16) ? att::crow(j, hh) : 32 + att::crow(j - 16, hh); const unsigned code = vt[key * 144 + d];
                    const int fld = (j < 16) ? 2 * j : 2 * (j - 16) + 1;
                    const int bit = 6 * fld, wi = bit >> 5, sh = bit & 31; wv[wi] |= code << sh; if (sh > 26) wv[wi + 1] |= code >> (32 - sh); }
                *(u32x4*)(dst + 32 * hh) = (u32x4){wv[0], wv[1], wv[2], wv[3]}; *(u32x2*)(dst + 32 * hh + 16) = (u32x2){wv[4], wv[5]}; } }
        LDS_WAIT(); asm volatile("" ::: "memory");
    }
}

__device__ __forceinline__ void p3_attention(Frame& F, char* lds) {
    unsigned char* ya = (unsigned char*)(F.ws + WS_YA); unsigned char* yb = (unsigned char*)(F.ws + WS_YB);
    { const int tl = F.wave * 64 + lane_now(); *(LAS f32x4*)(F.lds + RING_OFF + 116736 + tl * 16) = *(const f32x4*)(inp(11) + tl * 4); }
    for (int i = 0; ; ++i) {
        int b, h, qb;
        if (F.G == 256) { if (i >= 4) break; const int x = F.bx & 7, combo = x & 3, cu = (x >> 2) * 32 + (F.bx >> 3); b = combo >> 1; h = (combo & 1) * 4 + i; qb = cu; }
        else { const int u = F.bx + i * F.G; if (u >= 1024) break; b = u >> 9; h = (u >> 6) & 7; qb = u & 63; }
        const size_t t0 = (size_t)b * SEQ;
        __syncthreads();
        ConvW cvx; cvx.scr = (LAS float*)(F.lds + RING_OFF + 51200 + F.wave * 8192); cvx.gl = (const LAS float*)(F.lds + RING_OFF + 116736);
        cvx.act = (F.G == 256) && (i < 3); cvx.init(F.ws, i < 3 ? i : 0, F.bx * NWAVES + F.wave);
        att::attn_body_f8<1024, ConvW>(F.ws + WS_Q8 + ((size_t)(b * 8 + h) * SEQ + (size_t)qb * 256) * HD, F.ws + WS_K8 + (size_t)(b * 2 + (h >> 2)) * SEQ * HD,
                                F.ws + WS_VT8 + (size_t)(b * 2 + (h >> 2)) * (SEQ / 64) * 8192, ya + (t0 + (size_t)qb * 256) * 1024 + 128 * h, SEQ, lds, F.lds + RING_OFF, F.wave, cvx);
    }
    float* bias_l = (float*)(lds + att::BIAS_OFF);
    for (int i = 0; ; ++i) {
        const int u = F.bx + i * F.G; if (u >= 1024) break;
        const int b = u >> 9, h = (u >> 6) & 7, rb = u & 63, R0 = rb * 4;
        int kr0 = R0 - 4; kr0 = kr0 < 0 ? 0 : (kr0 > ROWS - 12 ? ROWS - 12 : kr0);
        __syncthreads();
        const int lane = lane_now(), wid = F.wave, tl = wid * 64 + lane;
        if (tl < 15 * 32) { const int ro = tl >> 5, co = tl & 31; bias_l[tl] = co < 31 ? inp(7)[(h * 15 + ro) * 31 + co] * (1.0f / att::SCALE) : 0.f; }
        const size_t t0 = (size_t)b * SEQ;
        const int c = 32 * (wid & 1) + (lane & 31); int cs = c - 8; cs = cs < 0 ? 0 : (cs > GW - 16 ? GW - 16 : cs);
        att::NaMask mk{bias_l, kr0, R0 + (wid >> 1), c, cs, lane >> 5};
        att::attn_body_simple<HD, HD, 1024, att::NaMask>((const bf16_t*)(F.ws + WS_QB) + ((size_t)(b * 8 + h) * SEQ + (size_t)R0 * 64) * HD, (const bf16_t*)(F.ws + WS_KB) + ((size_t)(b * 8 + h) * SEQ + (size_t)kr0 * 64) * HD,
                                                            (const bf16_t*)(F.ws + WS_VB) + ((size_t)(b * 8 + h) * SEQ + (size_t)kr0 * 64) * HD, yb + (t0 + (size_t)R0 * 64) * 1024 + 128 * h, 12, lds, mk, F.wave, inp(5), inp(6));
    }
}

__device__ __forceinline__ void p6_router(Frame& F) {
    const bf16_t* x1 = (const bf16_t*)(F.ws + WS_X1B); const float* g2 = inp(11); const float* wr = inp(12); const float* br = inp(13);
    unsigned char* h2 = (unsigned char*)(F.ws + WS_H8);
    LAS unsigned char* tile = F.lds + RING_OFF;
    LAS float* part = (LAS float*)(F.lds + PART_OFF);
    LAS unsigned* asg = (LAS unsigned*)(F.lds + ASG_OFF);
    LAS unsigned* hist = (LAS unsigned*)(F.lds + HIST_OFF);
    const int lane = F.lane, w = F.wave, row = lane & 15, kq = lane >> 4;
    if (F.tid < 64) hist[F.tid] = 0u;
    float Breg[16][4][2];
#pragma unroll
    for (int s = 0; s < 16; ++s)
#pragma unroll
        for (int i = 0; i < 4; ++i)
#pragma unroll
            for (int hf = 0; hf < 2; ++hf) { const int k = 256 * w + 16 * s + 4 * kq + i; Breg[s][i][hf] = wr[(size_t)k * NE + row + 16 * hf] * g2[k]; }
    int nasg = 0;
    u32x2 va[8], vb[8];
    const unsigned lofs = (unsigned)lane * 16u;
    { const int ch = F.bx; if (ch < NTOK / 16) { const char* xa = (const char*)(x1 + ((size_t)ch * 16 + 2 * w) * D);
#pragma unroll
        for (int j = 0; j < 8; ++j) { va[j] = *(const u32x2*)(xa + (lofs >> 1) + 512 * j); vb[j] = *(const u32x2*)(xa + 4096 + (lofs >> 1) + 512 * j); } } }
    for (int ch = F.bx; ch < NTOK / 16; ch += F.G) {
        __syncthreads();
#define P6_ROW(vr, tt) do { const int tl = 2 * w + (tt); const size_t tok = (size_t)ch * 16 + tl; float ss = 0.f; f32x4 v[8]; \
            _Pragma("unroll") for (int j = 0; j < 8; ++j) { v[j] = (f32x4){bf_lo(vr[j].x), bf_hi(vr[j].x), bf_lo(vr[j].y), bf_hi(vr[j].y)}; ss += (v[j].x * v[j].x + v[j].y * v[j].y) + (v[j].z * v[j].z + v[j].w * v[j].w); } \
            const float rstd = 1.0f / sqrtf(wave_sum(ss) * (1.f / D) + EPS); unsigned char* o8 = h2 + tok * D; \
            _Pragma("unroll") for (int j = 0; j < 8; ++j) { const f32x4 y = v[j] * rstd;     \
                *(unsigned*)(o8 + (lofs >> 2) + 256 * j) = pk4_fp8(y.x, y.y, y.z, y.w); *(LAS f32x4*)(tile + tl * 8192 + (((lofs >> 4) ^ tl) << 4) + 1024 * j) = y; } } while (0)
        P6_ROW(va, 0); P6_ROW(vb, 1);
#undef P6_ROW
        __syncthreads();
        { const int chn = ch + F.G; if (chn < NTOK / 16) { const char* xa = (const char*)(x1 + ((size_t)chn * 16 + 2 * w) * D);
            const unsigned lo2 = (unsigned)lane_now() * 16u;
#pragma unroll
            for (int j = 0; j < 8; ++j) { va[j] = *(const u32x2*)(xa + (lo2 >> 1) + 512 * j); vb[j] = *(const u32x2*)(xa + 4096 + (lo2 >> 1) + 512 * j); } } }
        f32x4 a0 = {0.f, 0.f, 0.f, 0.f}, a1 = {0.f, 0.f, 0.f, 0.f};
        f32x4 ab[2][2];
        unsigned abase[4];
        { const int ln = lane_now(), rw = ln & 15, kk = ln >> 4;
#pragma unroll
          for (int q = 0; q < 4; ++q) abase[q] = (unsigned)(rw * 8192 + ((64 * w + ((4 * q + kk) ^ rw)) << 4)); }
#define P6_LDA(g) do { _Pragma("unroll") for (int q = 0; q < 2; ++q) { const int s_ = 2 * (g) + q; ab[(g) & 1][q] = *(const LAS f32x4*)(tile + abase[s_ & 3] + (s_ >> 2) * 256); } } while (0)
        P6_LDA(0);
#pragma unroll
        for (int g = 0; g < 8; ++g) {
            if (g < 7) P6_LDA(g + 1);
#pragma unroll
            for (int q = 0; q < 2; ++q)
#pragma unroll
                for (int i = 0; i < 4; ++i) { a0 = __builtin_amdgcn_mfma_f32_16x16x4f32(ab[g & 1][q][i], Breg[2 * g + q][i][0], a0, 0, 0, 0); a1 = __builtin_amdgcn_mfma_f32_16x16x4f32(ab[g & 1][q][i], Breg[2 * g + q][i][1], a1, 0, 0, 0); }
            __builtin_amdgcn_sched_barrier(0);
        }
#undef P6_LDA
#pragma unroll
        for (int j = 0; j < 4; ++j) { part[(w * 16 + 4 * kq + j) * 32 + row] = a0[j]; part[(w * 16 + 4 * kq + j) * 32 + 16 + row] = a1[j]; }
        __syncthreads();
        { const int tl = F.tid >> 5, e = F.tid & 31; float lg = br[e];
#pragma unroll
          for (int ww = 0; ww < 8; ++ww) lg += part[(ww * 16 + tl) * 32 + e];
          float tv[4]; int ti[4]; bool taken = false;
#pragma unroll
          for (int r = 0; r < 4; ++r) { float bv = taken ? -__builtin_inff() : lg; int bi = e;
#define P6_STEP(EXPR_F, EXPR_I) do { const float ov = __int_as_float(EXPR_F); const int oi = (EXPR_I); if (ov > bv || (ov == bv && oi < bi)) { bv = ov; bi = oi; } } while (0)
#define P6_DPP(v, c) __builtin_amdgcn_update_dpp((v), (v), (c), 0xf, 0xf, false)
              P6_STEP(P6_DPP(__float_as_int(bv), 0xB1), P6_DPP(bi, 0xB1));
              P6_STEP(P6_DPP(__float_as_int(bv), 0x4E), P6_DPP(bi, 0x4E));
              P6_STEP(P6_DPP(__float_as_int(bv), 0x141), P6_DPP(bi, 0x141));
              P6_STEP(P6_DPP(__float_as_int(bv), 0x140), P6_DPP(bi, 0x140));
              P6_STEP(__builtin_amdgcn_ds_swizzle(__float_as_int(bv), 0x401F), __builtin_amdgcn_ds_swizzle(bi, 0x401F));
#undef P6_STEP
#undef P6_DPP
              tv[r] = bv; ti[r] = bi; if (bi == e) taken = true; }
          const float e1 = __expf(tv[1] - tv[0]), e2 = __expf(tv[2] - tv[0]), e3 = __expf(tv[3] - tv[0]); const float inv = 1.0f / (1.0f + e1 + e2 + e3);
          if (e < 4) { const float wt = (e == 0 ? 1.0f : e == 1 ? e1 : e == 2 ? e2 : e3) * inv; const int ex = e == 0 ? ti[0] : e == 1 ? ti[1] : e == 2 ? ti[2] : ti[3];
              const int n = nasg * 64 + tl * 4 + e; asg[n * 4 + 0] = (unsigned)(ch * 16 + tl) * 4u + (unsigned)e; asg[n * 4 + 1] = (unsigned)ex; asg[n * 4 + 2] = __float_as_uint(wt); } }
        ++nasg;
        if (nasg == 8) {
            __syncthreads();
            const int tf = F.wave * 64 + lane_now();
            { const unsigned ex = asg[tf * 4 + 1]; asg[tf * 4 + 3] = __hip_atomic_fetch_add((LAS unsigned*)&hist[ex], 1u, __ATOMIC_RELAXED, __HIP_MEMORY_SCOPE_WORKGROUP); }
            __syncthreads();
            if (tf < 32) { const unsigned n = hist[tf]; hist[32 + tf] = n ? __hip_atomic_fetch_add((unsigned*)(F.ctl + CW_CNT + 64 * tf), n, RLX_AGENT) : 0u; }
            __syncthreads();
            { const unsigned tk = asg[tf * 4 + 0], ex = asg[tf * 4 + 1], wb = asg[tf * 4 + 2], pos = hist[32 + ex] + asg[tf * 4 + 3];
              ((int*)(F.ws + WS_LTOK))[(size_t)ex * LCAP + pos] = (int)(tk >> 2); ((unsigned*)(F.ws + WS_LW))[(size_t)ex * LCAP + pos] = wb;
              ((unsigned*)(F.ws + WS_TOKEP))[tk] = (ex << 16) | pos; }
            __syncthreads();
            if (tf < 64) hist[tf] = 0u;
            nasg = 0;
        }
    }
    if (nasg) {
        __syncthreads();
        const int tf = F.wave * 64 + lane_now();
        const bool act = tf < nasg * 64;
        if (act) { const unsigned ex = asg[tf * 4 + 1]; asg[tf * 4 + 3] = __hip_atomic_fetch_add((LAS unsigned*)&hist[ex], 1u, __ATOMIC_RELAXED, __HIP_MEMORY_SCOPE_WORKGROUP); }
        __syncthreads();
        if (tf < 32) { const unsigned n = hist[tf]; hist[32 + tf] = n ? __hip_atomic_fetch_add((unsigned*)(F.ctl + CW_CNT + 64 * tf), n, RLX_AGENT) : 0u; }
        __syncthreads();
        if (act) { const unsigned tk = asg[tf * 4 + 0], ex = asg[tf * 4 + 1], wb = asg[tf * 4 + 2], pos = hist[32 + ex] + asg[tf * 4 + 3];
          ((int*)(F.ws + WS_LTOK))[(size_t)ex * LCAP + pos] = (int)(tk >> 2); ((unsigned*)(F.ws + WS_LW))[(size_t)ex * LCAP + pos] = wb;
          ((unsigned*)(F.ws + WS_TOKEP))[tk] = (ex << 16) | pos; }
        __syncthreads();
    }
}

__device__ __forceinline__ int moe_tables(Frame& F) {
    LAS int* cnt = (LAS int*)(F.lds + TAB_OFF); LAS int* tstart = cnt + 32; LAS unsigned char* tile_e = (LAS unsigned char*)(F.lds + TAB_OFF + 384);
    __syncthreads();
    if (F.tid < 32) cnt[F.tid] = (int)__hip_atomic_load((unsigned*)(F.ctl + CW_CNT + 64 * F.tid), RLX_AGENT);
    __syncthreads();
    if (F.tid == 0) { int s = 0; for (int e = 0; e < NE; ++e) { tstart[e] = s; s += (cnt[e] + 255) >> 8; } tstart[NE] = s; }
    __syncthreads();
    const int TT = tstart[NE];
    for (int t = F.tid; t < TT; t += 512) { int e = 0;
#pragma unroll
        for (int k = 1; k < NE; ++k) e += (tstart[k] <= t) ? 1 : 0;
        tile_e[t] = (unsigned char)e; }
    __syncthreads();
    return TT;
}

#define f8lo(w, b) __builtin_amdgcn_cvt_f32_fp8((int)(w), b)
__device__ __forceinline__ void p9_combine(Frame& F) {
    const LAS int* tstart = (const LAS int*)(F.lds + TAB_OFF) + 32;
    const unsigned char* Y = (const unsigned char*)(F.ws + WS_Y); const unsigned* tokep = (const unsigned*)(F.ws + WS_TOKEP);
    const int gw = F.bx * NWAVES + F.wave, NGW = F.G * NWAVES, lane = F.lane;
    for (int t0 = gw; t0 < NTOK; t0 += 16 * NGW) {
        const int tk = t0 + (lane & 15) * NGW; u32x4 ep = {0u, 0u, 0u, 0u};
        if (tk < NTOK) ep = *(const u32x4*)(tokep + (size_t)tk * 4);
        unsigned so0 = (unsigned)tstart[ep.x >> 16] * 256u + (ep.x & 0xffffu), so1 = (unsigned)tstart[ep.y >> 16] * 256u + (ep.y & 0xffffu);
        unsigned so2 = (unsigned)tstart[ep.z >> 16] * 256u + (ep.z & 0xffffu), so3 = (unsigned)tstart[ep.w >> 16] * 256u + (ep.w & 0xffffu);
#pragma unroll 2
        for (int k = 0; k < 16; ++k) {
            const int t = t0 + k * NGW; if (t >= NTOK) break;
            const size_t s0 = (size_t)__builtin_amdgcn_readlane((int)so0, k), s1 = (size_t)__builtin_amdgcn_readlane((int)so1, k), s2 = (size_t)__builtin_amdgcn_readlane((int)so2, k), s3 = (size_t)__builtin_amdgcn_readlane((int)so3, k);
            float* xo = F.out + (size_t)t * D; const bf16_t* xi = (const bf16_t*)(F.ws + WS_X1B) + (size_t)t * D;
            u32x2 y0[4], y1[4], y2[4], y3[4]; f32x4 a[4], b[4];
#pragma unroll
            for (int j = 0; j < 4; ++j) { const int c = (lane + 64 * j) * 8;
                y0[j] = *(const u32x2*)(Y + s0 * D + c); y1[j] = *(const u32x2*)(Y + s1 * D + c); y2[j] = *(const u32x2*)(Y + s2 * D + c); y3[j] = *(const u32x2*)(Y + s3 * D + c);
                const u32x4 xw = *(const u32x4*)(xi + c); a[j] = (f32x4){bf_lo(xw.x), bf_hi(xw.x), bf_lo(xw.y), bf_hi(xw.y)}; b[j] = (f32x4){bf_lo(xw.z), bf_hi(xw.z), bf_lo(xw.w), bf_hi(xw.w)}; }
#pragma unroll
            for (int j = 0; j < 4; ++j) { const int c = (lane + 64 * j) * 8;
#define Y4(w, i) ((f8lo(y0[j].w, i) + f8lo(y1[j].w, i)) + (f8lo(y2[j].w, i) + f8lo(y3[j].w, i))) * 0.0625f
                a[j].x += Y4(x, 0); a[j].y += Y4(x, 1); a[j].z += Y4(x, 2); a[j].w += Y4(x, 3);
                b[j].x += Y4(y, 0); b[j].y += Y4(y, 1); b[j].z += Y4(y, 2); b[j].w += Y4(y, 3);
#undef Y4
                *(f32x4*)(xo + c) = a[j]; *(f32x4*)(xo + c + 4) = b[j]; }
        }
    }
}

struct Args { const float* in[20]; float* out; unsigned char* ws; int ph_lo, ph_hi, li, pad; };
__global__ void __launch_bounds__(NWAVES * 64, 2) mk_fwd(Args args) {
    extern __shared__ __attribute__((aligned(16))) unsigned char lds[];
    Frame F;
    F.lds = (LAS unsigned char*)lds;
    F.MISC = (volatile LAS unsigned*)(F.lds + MISC_OFF);
    F.tid = threadIdx.x; F.lane = F.tid & 63; F.wave = __builtin_amdgcn_readfirstlane(F.tid >> 6);
    F.G = gridDim.x; F.bx = blockIdx.x;
    F.out = args.out; F.ws = args.ws; F.ctl = (gu32*)(args.ws + WS_CTL);
    for (int u = F.tid; u < (LDS_BYTES - LDSCTL_OFF) / 4; u += NWAVES * 64) ((LAS unsigned*)(F.lds + LDSCTL_OFF))[u] = 0u;
    __syncthreads();
    XcdBarrier bar; bar.bar = (unsigned*)(F.ctl + CW_BAR); bar.x = 0; bar.st = nullptr;
    if (N_LAUNCHES != PER_PHASE) bar = xcd_barrier_post((unsigned*)(F.ctl + CW_BAR), F.MISC + 8, F.tid == 0);
#define GRID_BAR(seam) do { if (N_LAUNCHES == PER_PHASE) { if (F.tid == 0) __hip_atomic_store(F.ctl + CW_TMO, 0xBADBA0u | (unsigned)(seam), RLX_AGENT); } else { xcd_barrier(bar, F.wave == 0 && lane_now() == 0); } } while (0)
    const int lo = args.ph_lo, hi = args.ph_hi;
#ifndef PH_MASK
#define PH_MASK 0x3ff
#endif
#define IN(k) (((PH_MASK >> (k)) & 1) && lo <= (k) && (k) < hi)
#define BOTH(k) (IN(k) && IN((k) + 1))
#define REFRESH() do { F.lane = lane_now(); F.tid = F.wave * 64 + F.lane; } while (0)
    unsigned char* ws = args.ws;

    if (IN(0)) { REFRESH(); p0_prologue(F); if (BOTH(0)) GRID_BAR(0); }

    if (IN(1)) { REFRESH();
        pg8::Gemm g{ws + WS_H, ws + WS_WIN, D, F8_ONE, F8_W}; pg8::StaticOrder S; S.init(NTOK, NCOLS, F.G, F.bx);
        pg8::EpiProj E{ws};
        pg8::gemm_phase<pg8::EpiProj, pg8::StaticOrder, true, true>(F.lds + RING_OFF, g, S, E, F.wave);
        if (BOTH(1)) GRID_BAR(1);
    }
    if (IN(2)) { REFRESH(); p2_qknorm(F); if (BOTH(2)) GRID_BAR(2); }
    if (IN(3)) { REFRESH(); p3_attention(F, (char*)lds + RING_OFF); if (BOTH(3)) GRID_BAR(3); }
    if (IN(4)) { REFRESH();
        { pg8::Gemm g{ws + WS_YA, ws + WS_WPA, 1024, F8_Y, F8_W, (long long)(WS_YB - WS_YA), (long long)(WS_WPB - WS_WPA)}; pg8::StaticOrder S; S.init(NTOK, D, F.G, F.bx);
          pg8::EpiGateDual E{(unsigned char*)(ws + WS_MERGED8), (const unsigned char*)(ws + WS_G)};
          pg8::gemm_phase<pg8::EpiGateDual, pg8::StaticOrder, true, true, true>(F.lds + RING_OFF, g, S, E, F.wave); }
        if (BOTH(4)) GRID_BAR(4);
    }
    if (IN(5)) { REFRESH();
        pg8::Gemm g{ws + WS_MERGED8, ws + WS_WOUT, D, F8_M, F8_W}; pg8::StaticOrder S; S.init(NTOK, D, F.G, F.bx);
        pg8::EpiResidB E{inp(0), (bf16_t*)(ws + WS_X1B), D};
        pg8::gemm_phase<pg8::EpiResidB, pg8::StaticOrder, true, true>(F.lds + RING_OFF, g, S, E, F.wave);
        if (BOTH(5)) GRID_BAR(5);
    }
    if (IN(6)) { REFRESH(); p6_router(F); if (BOTH(6)) GRID_BAR(6); }
    if (IN(7)) { REFRESH();
        const int TT = moe_tables(F);
        const LAS int* cnt = (const LAS int*)(F.lds + TAB_OFF);
        pg8::Gemm g{ws + WS_H8, ws + WS_WGU, D, F8_ONE, F8_W};
        pg8::MoeOrder S{cnt, cnt + 32, (const LAS unsigned char*)(F.lds + TAB_OFF + 384), TT, 16, F.G, F.bx, (const int*)(ws + WS_LTOK), true, (size_t)4096};
        pg8::EpiSwiglu E{(unsigned char*)(ws + WS_ACT), inp(15), inp(17)};
        pg8::gemm_phase<pg8::EpiSwiglu, pg8::MoeOrder, true, true>(F.lds + RING_OFF, g, S, E, F.wave);
        if (BOTH(7)) GRID_BAR(7);
    }
    if (IN(8)) { REFRESH();
        const int TT = moe_tables(F);
        const LAS int* cnt = (const LAS int*)(F.lds + TAB_OFF);
        pg8::Gemm g{ws + WS_ACT, ws + WS_WD, DE, F8_ONE, F8_W};
        pg8::MoeOrder S{cnt, cnt + 32, (const LAS unsigned char*)(F.lds + TAB_OFF + 384), TT, 8, F.G, F.bx, (const int*)(ws + WS_LTOK), false, (size_t)2048};
        pg8::EpiDown E{(unsigned char*)(ws + WS_Y), inp(19), (const float*)(ws + WS_LW), cnt + 32};
        pg8::gemm_phase<pg8::EpiDown, pg8::MoeOrder, true, true>(F.lds + RING_OFF, g, S, E, F.wave);
        if (BOTH(8)) GRID_BAR(8);
    }
    if (IN(9)) { REFRESH(); (void)moe_tables(F); p9_combine(F); }
#undef IN
#undef BOTH
}

extern "C" void kernel_launch(void* const* d_in, const int* in_sizes, int n_in, void* d_out, int out_size, void* d_ws, size_t ws_size, hipStream_t stream) {
    static int grid = 0;
    if (grid == 0) {
        if (n_in != 20 || out_size != NTOK * D || ws_size < WS_END) { fprintf(stderr, "kernel_launch: shape mismatch n_in %d out %d ws %zu (need %zu)\n", n_in, out_size, ws_size, (size_t)WS_END); grid = -1; return; }
        int dev = 0, cus = 0, per_cu = 0;
        if (hipGetDevice(&dev) != hipSuccess || hipDeviceGetAttribute(&cus, hipDeviceAttributeMultiprocessorCount, dev) != hipSuccess) { grid = -1; return; }
        if (hipFuncSetAttribute((const void*)mk_fwd, hipFuncAttributeMaxDynamicSharedMemorySize, LDS_BYTES) != hipSuccess) { fprintf(stderr, "kernel_launch: hipFuncSetAttribute failed\n"); grid = -1; return; }
        if (hipOccupancyMaxActiveBlocksPerMultiprocessor(&per_cu, (const void*)mk_fwd, NWAVES * 64, LDS_BYTES) != hipSuccess || per_cu < 1) fprintf(stderr, "kernel_launch: occupancy query reports %d\n", per_cu);
        (void)hipGetLastError();
        grid = cus < 256 ? cus : 256;
    }
    if (grid < 0) return;
    if (hipMemsetAsync((char*)d_ws + WS_CTL, 0, CTL_ZERO_BYTES, stream) != hipSuccess) return;
    Args a{};
    for (int i = 0; i < 20; ++i) a.in[i] = (const float*)d_in[i];
    a.out = (float*)d_out; a.ws = (unsigned char*)d_ws;
    for (int li = 0; li < N_LAUNCHES; ++li) {
        a.ph_lo = (N_LAUNCHES == PER_PHASE) ? li : 0; a.ph_hi = (N_LAUNCHES == PER_PHASE) ? li + 1 : PER_PHASE; a.li = li; a.pad = 0;
        for (int rep = 0; rep < ((N_LAUNCHES == PER_PHASE && li == DUP_PHASE) ? DUP_TIMES : 1) - 1; ++rep) hipLaunchKernelGGL(mk_fwd, dim3(grid), dim3(NWAVES * 64), LDS_BYTES, stream, a);
        hipLaunchKernelGGL(mk_fwd, dim3(grid), dim3(NWAVES * 64), LDS_BYTES, stream, a);
        const hipError_t le = hipPeekAtLastError();
        if (le != hipSuccess) { fprintf(stderr, "kernel_launch: launch %d failed: %s\n", li, hipGetErrorName(le)); break; }
    }
}
```

```cpp
#include <hip/hip_runtime.h>
#include <cstdio>
#include <cstdint>

#ifndef MK_N_LAUNCHES
#define MK_N_LAUNCHES 1
#endif
#ifndef DUP_PHASE
#define DUP_PHASE -1
#endif
#ifndef DUP_TIMES
#define DUP_TIMES 2
#endif
constexpr int PER_PHASE = 10;
constexpr int N_LAUNCHES = MK_N_LAUNCHES;

#define GAS __attribute__((address_space(1)))
#define LAS __attribute__((address_space(3)))
typedef unsigned short bf16_t;
typedef short bf16x8 __attribute__((ext_vector_type(8)));
typedef short s16x4 __attribute__((ext_vector_type(4)));
typedef float f32x2 __attribute__((ext_vector_type(2)));
typedef float f32x4 __attribute__((ext_vector_type(4)));
typedef float f32x8 __attribute__((ext_vector_type(8)));
typedef float f32x16 __attribute__((ext_vector_type(16)));
typedef unsigned u32x2 __attribute__((ext_vector_type(2)));
typedef unsigned u32x4 __attribute__((ext_vector_type(4)));
typedef int i32x2 __attribute__((ext_vector_type(2)));
typedef int i32x4 __attribute__((ext_vector_type(4)));
typedef int i32x8 __attribute__((ext_vector_type(8)));
typedef GAS unsigned gu32;
constexpr int F8_ONE = 127, F8_W = 121, F8_Y = 121, F8_M = 123;
constexpr float F8_WMUL = 64.0f, F8_YMUL = 64.0f, F8_MMUL = 16.0f;

constexpr int D = 2048, NTOK = 32768, SEQ = 16384, GW = 64, ROWS = 256, HD = 128;
constexpr int NCOLS = 8704;
constexpr int C_QA = 0, C_KA = 1024, C_VA = 1280, C_QB = 1536, C_KB = 2560, C_VB = 3584, C_GA = 4608, C_GB = 6656;
constexpr int NE = 32, DE = 2048, LCAP = 32768;
constexpr int MAXT = 544;
constexpr float EPS = 1e-6f;
constexpr int NWAVES = 8;

constexpr size_t MiB = 1u << 20;
constexpr size_t WS_CTL = 0, CTL_ZERO_BYTES = 1 * MiB;
constexpr size_t WS_TAB = 1 * MiB;
constexpr size_t WS_TOKEP = 1 * MiB + 128 * 1024;
constexpr size_t WS_LTOK = 2 * MiB;
constexpr size_t WS_LW = 6 * MiB;
constexpr size_t WS_WIN = 10 * MiB;
constexpr size_t WS_WPA = 44 * MiB, WS_WPB = 48 * MiB, WS_WOUT = 52 * MiB;
constexpr size_t WS_WD = 64 * MiB;
constexpr size_t WS_WGU = 320 * MiB;
constexpr size_t WS_MERGED = 832 * MiB;
constexpr size_t WS_X1B = 832 * MiB;
constexpr size_t WS_MERGED8 = 1760 * MiB;
constexpr size_t WS_Y = 320 * MiB;
constexpr size_t WS_H = 960 * MiB;
constexpr size_t WS_H8 = 1024 * MiB;
constexpr size_t WS_PROJ = 1088 * MiB;
constexpr size_t WS_QA = WS_PROJ, WS_KA = WS_PROJ + 64 * MiB, WS_VA = WS_PROJ + 80 * MiB, WS_QB = WS_PROJ + 96 * MiB, WS_KB = WS_PROJ + 160 * MiB, WS_VB = WS_PROJ + 224 * MiB, WS_G = WS_PROJ + 288 * MiB;
constexpr size_t WS_ACT = 1088 * MiB;
constexpr size_t WS_YA = 1632 * MiB, WS_YB = 1696 * MiB;
constexpr size_t WS_Q8 = 1824 * MiB;
constexpr size_t WS_K8 = 1856 * MiB;
constexpr size_t WS_VT8 = 1864 * MiB;
constexpr size_t WS_END = 1872 * MiB;
static_assert(WS_Y + (size_t)MAXT * 256 * 2048 * 2 <= WS_H && WS_ACT + (size_t)MAXT * 256 * 2048 * 2 <= WS_YA, "ws map");
static_assert(WS_Y + (size_t)MAXT * 256 * 2048 <= WS_X1B && WS_X1B + (size_t)NTOK * D * 2 <= WS_H, "ws map: fp8 Y below the bf16 residual stream");
constexpr int CW_TMO = 0, CW_CODE = 1;
constexpr int CW_BAR = 4096;
constexpr int CW_CNT = 16384;

constexpr int RING_OFF = 0, RING_BYTES = 131072;
constexpr int PART_OFF = 131072;
constexpr int ASG_OFF = 147456;
constexpr int TAB_OFF = 155648;
constexpr int HIST_OFF = 156672;
constexpr int MISC_OFF = 156928;
constexpr int LDS_BYTES = 157696;
constexpr int LDSCTL_OFF = HIST_OFF;

#define RLX_AGENT __ATOMIC_RELAXED, __HIP_MEMORY_SCOPE_AGENT
#define LDS_WAIT() asm volatile("s_waitcnt lgkmcnt(0)" ::: "memory")
#define VM_WAIT() asm volatile("s_waitcnt vmcnt(0)" ::: "memory")
__device__ __forceinline__ unsigned cvt_pk_bf16(float lo, float hi) { unsigned r; asm volatile("v_cvt_pk_bf16_f32 %0, %1, %2" : "=v"(r) : "v"(lo), "v"(hi)); return r; }
__device__ __forceinline__ unsigned f6_e2m3(float v) {
    const float y = fminf(__builtin_fabsf(v), 7.5f);
    const unsigned eb = __float_as_uint(fmaxf(y, 1.0f)) >> 23;
    const float q = __builtin_rintf(y * __uint_as_float((257u - eb) << 23));
    return ((unsigned)(int)q + 8u * eb - 1016u) | ((__float_as_uint(v) >> 26) & 32u);
}
__device__ __forceinline__ unsigned pk4_fp8(float a, float b, float c, float d) { int w = __builtin_amdgcn_cvt_pk_fp8_f32(a, b, 0, false); w = __builtin_amdgcn_cvt_pk_fp8_f32(c, d, w, true); return (unsigned)w; }
__device__ __forceinline__ int lane_now() { int l; asm volatile("v_mbcnt_lo_u32_b32 %0, -1, 0\n\tv_mbcnt_hi_u32_b32 %0, -1, %0" : "=v"(l)); return l; }
__device__ __forceinline__ float bf_lo(unsigned w) { return __uint_as_float(w << 16); }
__device__ __forceinline__ float bf_hi(unsigned w) { return __uint_as_float(w & 0xffff0000u); }
__device__ __forceinline__ float sigmoidf_(float x) { return __builtin_amdgcn_rcpf(1.0f + __builtin_amdgcn_exp2f(-1.4426950408889634f * x)); }

namespace pg8 {
constexpr int BM = 256, BK = 64, HALF = 128, HTB = HALF * BK * 2, STAGE_BYTES = 8 * HTB, NXCD = 8, WGM = 8;
__host__ __device__ __forceinline__ int lds_byte(int r, int c) { const int st = (r >> 4) * 2 + (c >> 5), rr = r & 15, cc = c & 31, ob = rr * 64 + cc * 2; return st * 1024 + (ob ^ (((ob >> 9) & 1) << 5)); }
__host__ __device__ __forceinline__ void stage_rc(int b, int& R, int& C) { const int st = b / 1024, sb = b % 1024, swz = sb ^ (((sb >> 9) & 1) << 5); R = (st >> 1) * 16 + swz / 64; C = (st & 1) * 32 + (swz % 64) / 2; }
__host__ __device__ __forceinline__ int perm32(int rho) { const int n = rho >> 4, i = rho & 15; return 8 * (i >> 2) + 4 * n + (i & 3); }

struct Unit { int pm, pn, e, cnt; };
struct Gemm { const void* A; const void* Bt; int rb; int sa, sb; long long dA = 0, dB = 0; };

__device__ __forceinline__ bool tile_order(int i, int G, int c, int nM, int nN, int& pm, int& pn) {
    const int nwg = nM * nN; const long L = (long)i * G + c; if (L >= nwg) return false;
    int wgid = (int)L; { const int q = nwg / NXCD, r = nwg % NXCD, xcd = wgid % NXCD, off = wgid / NXCD; wgid = (xcd < r ? xcd * (q + 1) : r * (q + 1) + (xcd - r) * q) + off; }
    const int nig = WGM * nN, gid = wgid / nig, fm = gid * WGM, gsz = (nM - fm) < WGM ? (nM - fm) : WGM;
    pm = fm + ((wgid % nig) % gsz); pn = (wgid % nig) / gsz; return true;
}
struct StaticOrder {
    int nM, nN, G, c;
    __device__ void init(int M, int N, int G_, int c_) { nM = M / BM; nN = N / BM; G = G_; c = c_; }
    __device__ __forceinline__ bool next(int i, Unit& u) const { u.e = 0; u.cnt = 256; return tile_order(i, G, c, nM, nN, u.pm, u.pn); }
    __device__ __forceinline__ void a_offs(const Gemm& g, const Unit& u, const int (&R)[2], const int (&C)[2], unsigned (&ao)[2][2]) const {
#pragma unroll
        for (int h = 0; h < 2; ++h)
#pragma unroll
            for (int i = 0; i < 2; ++i) ao[h][i] = (unsigned)((u.pm * BM + h * HALF + R[i]) * g.rb + C[i] * 2);
    }
    __device__ __forceinline__ const char* b_ptr(const Gemm& g, const Unit& u) const { return (const char*)g.Bt + (size_t)u.pn * BM * g.rb; }
};

template <class Epi, class Sched, bool ALIGN_EPI, bool FP8 = false, bool DUAL = false>
__device__ __forceinline__ void gemm_phase(LAS unsigned char* lds, const Gemm g, const Sched& S, const Epi& E, const int wid) {
    const int lane = lane_now(), tid = wid * 64 + lane, wr = wid >> 2, wc = wid & 3, fr = lane & 15, fq = lane >> 4;
    const int rb = g.rb, nt1 = rb / (BK * 2), nt = DUAL ? 2 * nt1 : nt1;
    unsigned voffB[2]; int RR[2], CC[2];
#pragma unroll
    for (int i = 0; i < 2; ++i) { int R, C; stage_rc(tid * 16 + i * 8192, R, C); RR[i] = R; CC[i] = C; int Rs;
        if constexpr ((int)Epi::PERM == 2) Rs = 64 * (R >> 5) + 16 * ((R & 15) >> 2) + 4 * ((R >> 4) & 1) + (R & 3);
        else Rs = (int)Epi::PERM ? ((R & ~31) + perm32(R & 31)) : R;
        voffB[i] = (unsigned)(Rs * rb + C * 2); }
    const size_t hstep = (size_t)(((int)Epi::PERM == 2) ? 8 : HALF) * rb;
    const size_t kstep = (size_t)(BK * 2);
    const unsigned ldsw = (unsigned)wid * 1024u;
    const int aoff = lds_byte(wr * 64 + fr, fq * 8), boff = lds_byte(wc * 32 + fr, fq * 8);
#define PG8_SA(b, h) (((b) * 2 + (h)) * HTB)
#define PG8_SB(b, h) ((4 + (b) * 2 + (h)) * HTB)
#define PG8_STAGE(bufoff, gbase, voff) do { _Pragma("unroll") for (int _i = 0; _i < 2; ++_i) \
        __builtin_amdgcn_global_load_lds((const unsigned*)((const char*)(gbase) + (voff)[_i]), (LAS unsigned*)(lds + (bufoff) + ldsw + _i * 8192), 16, 0, 0); } while (0)
#define PG8_STAGE_A(bufoff, kb, ao, h) PG8_STAGE(bufoff, (const char*)g.A + (kb), (ao)[h])
#define PG8_LDA(dst, b, h) do { _Pragma("unroll") for (int m = 0; m < 4; ++m) { if constexpr (FP8) { const i32x4 lo_ = *(const LAS i32x4*)(lds + PG8_SA(b, h) + aoff + m * 2048), hi_ = *(const LAS i32x4*)(lds + PG8_SA(b, h) + aoff + m * 2048 + 1024); \
            dst##8[m] = __builtin_shufflevector(lo_, hi_, 0, 1, 2, 3, 4, 5, 6, 7); } else { _Pragma("unroll") for (int k = 0; k < 2; ++k) dst[m][k] = *(const LAS bf16x8*)(lds + PG8_SA(b, h) + aoff + m * 2048 + k * 1024); } } } while (0)
#define PG8_LDB(dst, b, h) do { _Pragma("unroll") for (int n = 0; n < 2; ++n) { if constexpr (FP8) { const i32x4 lo_ = *(const LAS i32x4*)(lds + PG8_SB(b, h) + boff + n * 2048), hi_ = *(const LAS i32x4*)(lds + PG8_SB(b, h) + boff + n * 2048 + 1024); \
            dst##8[n] = __builtin_shufflevector(lo_, hi_, 0, 1, 2, 3, 4, 5, 6, 7); } else { _Pragma("unroll") for (int k = 0; k < 2; ++k) dst[n][k] = *(const LAS bf16x8*)(lds + PG8_SB(b, h) + boff + n * 2048 + k * 1024); } } } while (0)
#define PG8_MMA(ai, bj, At, Bt) do { __builtin_amdgcn_s_setprio(1); if constexpr (FP8) { asm volatile("s_nop 1" ::: "memory"); }     \
          \
        _Pragma("unroll") for (int m_ = 0; m_ < 4; ++m_) _Pragma("unroll") for (int n_ = 0; n_ < 2; ++n_) { const int m = (bj) ? 3 - m_ : m_, n = (m_ & 1) ? 1 - n_ : n_; \
        if constexpr (FP8) { asm volatile("v_mfma_scale_f32_16x16x128_f8f6f4 %0, %1, %2, %0, %3, %4 op_sel_hi:[0,0,0]" : "+v"(acc[ai][bj][m][n]) : "v"(Bt##8[n]), "v"(At##8[m]), "v"(sclB), "v"(sclA)); } \
        else { _Pragma("unroll") for (int k = 0; k < 2; ++k) acc[ai][bj][m][n] = __builtin_amdgcn_mfma_f32_16x16x32_bf16(Bt[n][k], At[m][k], acc[ai][bj][m][n], 0, 0, 0); } } \
        __builtin_amdgcn_s_setprio(0); } while (0)
#define PG8_WAIT_V(n) asm volatile("s_waitcnt vmcnt(" #n ")" ::: "memory")
#define PG8_WAIT_L(n) asm volatile("s_waitcnt lgkmcnt(" #n ")" ::: "memory")
#define PG8_BAR __builtin_amdgcn_s_barrier()
#define PG8_SCHED __builtin_amdgcn_sched_barrier(0)
    Unit cur, nxt; int ui = 0;
    if (!S.next(0, cur)) return;
    f32x4 acc[2][2][4][2];
#pragma unroll
    for (int a = 0; a < 2; ++a)
#pragma unroll
        for (int b = 0; b < 2; ++b)
#pragma unroll
            for (int m = 0; m < 4; ++m)
#pragma unroll
                for (int n = 0; n < 2; ++n) acc[a][b][m][n] = (f32x4){0.f, 0.f, 0.f, 0.f};
    bf16x8 At[4][2], B0[2][2], B1[2][2]; i32x8 At8[4], B08[2], B18[2];
    int sclA = g.sa, sclB = g.sb; if constexpr (FP8) { asm volatile("" : "+v"(sclA), "+v"(sclB)); }
    unsigned aoC[2][2], aoN[2][2];
    S.a_offs(g, cur, RR, CC, aoC);
    const char* cB = S.b_ptr(g, cur);
    PG8_STAGE(PG8_SB(0, 0), cB, voffB); PG8_STAGE(PG8_SB(0, 1), cB + hstep, voffB); PG8_STAGE_A(PG8_SA(0, 0), 0, aoC, 0); PG8_STAGE_A(PG8_SA(0, 1), 0, aoC, 1);
    if (wr == 1) PG8_BAR;
    PG8_WAIT_V(2); PG8_BAR;
    PG8_STAGE(PG8_SB(1, 0), cB + kstep, voffB); PG8_STAGE_A(PG8_SA(1, 0), kstep, aoC, 0); PG8_STAGE(PG8_SB(1, 1), cB + hstep + kstep, voffB);
    PG8_WAIT_V(6); PG8_BAR;
    for (;;) {
        const bool has_next = S.next(ui + 1, nxt);
        const char* nB = cB;
#pragma unroll
        for (int h = 0; h < 2; ++h)
#pragma unroll
            for (int i = 0; i < 2; ++i) aoN[h][i] = aoC[h][i];
        if (has_next) { S.a_offs(g, nxt, RR, CC, aoN); nB = S.b_ptr(g, nxt); }
        for (int t = 0; t < nt; t += 2) {
            const bool last = (t == nt - 2);
            if constexpr (DUAL) { if (t == nt1) { asm volatile("s_nop 15\n\ts_nop 15" ::: "memory"); if (wr == 0) PG8_BAR; E.mid(acc, cur, wr, wc, fr, fq); asm volatile("s_nop 7" ::: "memory"); if (wr == 1) PG8_BAR; } }
            size_t k1 = (size_t)(t + 1) * kstep, kk2 = (size_t)(t + 2) * kstep, kb2 = kk2;
            if constexpr (DUAL) { if (t >= nt1) k1 = (size_t)g.dA + (size_t)(t + 1 - nt1) * kstep;
                                  if (t + 2 >= nt1) { kk2 = (size_t)g.dA + (size_t)(t + 2 - nt1) * kstep; kb2 = (size_t)g.dB + (size_t)(t + 2 - nt1) * kstep; } }
            const size_t k2 = last ? 0 : kk2, k3 = k2 + kstep;
            const char* b2 = last ? nB : cB + kb2; const char* b3 = b2 + kstep;
            unsigned ao2[2][2];
#pragma unroll
            for (int h = 0; h < 2; ++h)
#pragma unroll
                for (int i = 0; i < 2; ++i) ao2[h][i] = last ? aoN[h][i] : aoC[h][i];
            PG8_LDB(B0, 0, 0); PG8_LDB(B1, 0, 1); PG8_SCHED; PG8_LDA(At, 0, 0); PG8_STAGE_A(PG8_SA(1, 1), k1, aoC, 1);
            PG8_WAIT_V(8); PG8_WAIT_L(0); PG8_BAR; PG8_MMA(0, 0, At, B0); PG8_MMA(0, 1, At, B1); PG8_BAR; PG8_SCHED;
            PG8_LDA(At, 0, 1); PG8_STAGE(PG8_SB(0, 0), b2, voffB); PG8_STAGE(PG8_SB(0, 1), b2 + hstep, voffB); PG8_STAGE_A(PG8_SA(0, 0), k2, ao2, 0);
            PG8_WAIT_V(8); PG8_WAIT_L(0); PG8_BAR; PG8_MMA(1, 0, At, B0); PG8_MMA(1, 1, At, B1); PG8_BAR; PG8_SCHED;
            PG8_LDB(B0, 1, 0); PG8_LDB(B1, 1, 1); PG8_SCHED; PG8_LDA(At, 1, 0); PG8_STAGE_A(PG8_SA(0, 1), k2, ao2, 1);
            PG8_WAIT_V(8); PG8_WAIT_L(0); PG8_BAR; PG8_MMA(0, 0, At, B0); PG8_MMA(0, 1, At, B1); PG8_BAR; PG8_SCHED;
            PG8_LDA(At, 1, 1); PG8_STAGE(PG8_SB(1, 0), b3, voffB); PG8_STAGE(PG8_SB(1, 1), b3 + hstep, voffB); PG8_STAGE_A(PG8_SA(1, 0), k3, ao2, 0);
            PG8_WAIT_V(8); PG8_WAIT_L(0); PG8_BAR; PG8_MMA(1, 0, At, B0); PG8_MMA(1, 1, At, B1); PG8_BAR; PG8_SCHED;
        }
        if constexpr (FP8) { asm volatile("s_nop 15\n\ts_nop 15" ::: "memory"); }
        if constexpr (ALIGN_EPI) { if (wr == 0) PG8_BAR; }
        E(acc, cur, wr, wc, fr, fq);
        if (!has_next) break;
#pragma unroll
        for (int a = 0; a < 2; ++a)
#pragma unroll
            for (int b = 0; b < 2; ++b)
#pragma unroll
                for (int m = 0; m < 4; ++m)
#pragma unroll
                    for (int n = 0; n < 2; ++n) acc[a][b][m][n] = (f32x4){0.f, 0.f, 0.f, 0.f};
        cur = nxt; cB = nB; ++ui;
#pragma unroll
        for (int h = 0; h < 2; ++h)
#pragma unroll
            for (int i = 0; i < 2; ++i) aoC[h][i] = aoN[h][i];
        if constexpr (ALIGN_EPI) { if (wr == 1) PG8_BAR; }
    }
    PG8_WAIT_V(0);
    if constexpr (!ALIGN_EPI) { if (wr == 0) PG8_BAR; }
    PG8_BAR;
#undef PG8_SA
#undef PG8_SB
#undef PG8_STAGE
#undef PG8_STAGE_A
#undef PG8_LDA
#undef PG8_LDB
#undef PG8_MMA
#undef PG8_WAIT_V
#undef PG8_WAIT_L
#undef PG8_BAR
#undef PG8_SCHED
}

struct EpiBf16 {
    static constexpr bool PERM = true;
    bf16_t* O; int ldc;
    __device__ __forceinline__ void operator()(const f32x4 (&acc)[2][2][4][2], const Unit& u, int wr, int wc, int fr, int fq) const {
        const int row0 = u.pm * BM + wr * 64 + fr, col0 = u.pn * BM + wc * 32 + 8 * fq;
#pragma unroll
        for (int ai = 0; ai < 2; ++ai)
#pragma unroll
            for (int m = 0; m < 4; ++m) { bf16_t* rowp = O + (size_t)(row0 + ai * HALF + m * 16) * ldc + col0;
#pragma unroll
                for (int bj = 0; bj < 2; ++bj) { const f32x4 v0 = acc[ai][bj][m][0], v1 = acc[ai][bj][m][1];
                    u32x4 w; w.x = cvt_pk_bf16(v0[0], v0[1]); w.y = cvt_pk_bf16(v0[2], v0[3]); w.z = cvt_pk_bf16(v1[0], v1[1]); w.w = cvt_pk_bf16(v1[2], v1[3]);
                    *(u32x4*)(rowp + bj * HALF) = w; } }
    }
};
struct EpiProj {
    static constexpr int PERM = 2;
    unsigned char* ws;
    __device__ __forceinline__ void operator()(const f32x4 (&acc)[2][2][4][2], const Unit& u, int wr, int wc, int fr, int fq) const {
        const int pn = u.pn; size_t base; int H, h0; bool gate = false;
        if (pn < 4) { base = WS_QA; H = 8; h0 = 2 * pn; } else if (pn == 4) { base = WS_KA; H = 2; h0 = 0; } else if (pn == 5) { base = WS_VA; H = 2; h0 = 0; }
        else if (pn < 10) { base = WS_QB; H = 8; h0 = 2 * (pn - 6); } else if (pn < 14) { base = WS_KB; H = 8; h0 = 2 * (pn - 10); } else if (pn < 18) { base = WS_VB; H = 8; h0 = 2 * (pn - 14); }
        else { base = WS_G; H = 0; h0 = 0; gate = true; }
        const int row0 = u.pm * BM + wr * 64 + fr, ct = wc * 64 + 16 * fq;
        unsigned char* O = ws + base + (size_t)(h0 + (wc >> 1)) * SEQ * HD + (ct & 127);
        unsigned char* G8 = ws + WS_G + (size_t)(pn - 18) * BM + ct;
#pragma unroll
        for (int ai = 0; ai < 2; ++ai)
#pragma unroll
            for (int m = 0; m < 4; ++m) { const int r = row0 + ai * HALF + m * 16;
                if (gate) { u32x4 w8; w8.x = pk4_fp8(acc[ai][0][m][0][0], acc[ai][0][m][0][1], acc[ai][0][m][0][2], acc[ai][0][m][0][3]); w8.y = pk4_fp8(acc[ai][0][m][1][0], acc[ai][0][m][1][1], acc[ai][0][m][1][2], acc[ai][0][m][1][3]);
                    w8.z = pk4_fp8(acc[ai][1][m][0][0], acc[ai][1][m][0][1], acc[ai][1][m][0][2], acc[ai][1][m][0][3]); w8.w = pk4_fp8(acc[ai][1][m][1][0], acc[ai][1][m][1][1], acc[ai][1][m][1][2], acc[ai][1][m][1][3]);
                    *(u32x4*)(G8 + (size_t)r * 4096) = w8; }
                else { u32x4 w8; w8.x = pk4_fp8(acc[ai][0][m][0][0], acc[ai][0][m][0][1], acc[ai][0][m][0][2], acc[ai][0][m][0][3]); w8.y = pk4_fp8(acc[ai][0][m][1][0], acc[ai][0][m][1][1], acc[ai][0][m][1][2], acc[ai][0][m][1][3]);
                    w8.z = pk4_fp8(acc[ai][1][m][0][0], acc[ai][1][m][0][1], acc[ai][1][m][0][2], acc[ai][1][m][0][3]); w8.w = pk4_fp8(acc[ai][1][m][1][0], acc[ai][1][m][1][1], acc[ai][1][m][1][2], acc[ai][1][m][1][3]);
                    *(u32x4*)(O + ((size_t)(r >> 14) * H * SEQ + (size_t)(r & (SEQ - 1))) * HD) = w8; } }
    }
};
template <bool ADD> struct EpiGate {
    static constexpr bool PERM = true;
    bf16_t* O; unsigned char* O8; int ldc; const bf16_t* Gt; int ldg;
    __device__ __forceinline__ void operator()(const f32x4 (&acc)[2][2][4][2], const Unit& u, int wr, int wc, int fr, int fq) const {
        const int row0 = u.pm * BM + wr * 64 + fr, col0 = u.pn * BM + wc * 32 + 8 * fq;
#pragma unroll
        for (int ai = 0; ai < 2; ++ai)
#pragma unroll
            for (int m = 0; m < 4; ++m) { const size_t r = (size_t)(row0 + ai * HALF + m * 16);
#pragma unroll
                for (int bj = 0; bj < 2; ++bj) { const f32x4 v0 = acc[ai][bj][m][0], v1 = acc[ai][bj][m][1];
                    const u32x4 gw = *(const u32x4*)(Gt + r * ldg + col0 + bj * HALF);
                    bf16_t* op = O + r * ldc + col0 + bj * HALF;
                    float o[8] = {0.f, 0.f, 0.f, 0.f, 0.f, 0.f, 0.f, 0.f};
                    if (ADD) { const u32x4 ow = *(const u32x4*)op; o[0] = bf_lo(ow.x); o[1] = bf_hi(ow.x); o[2] = bf_lo(ow.y); o[3] = bf_hi(ow.y); o[4] = bf_lo(ow.z); o[5] = bf_hi(ow.z); o[6] = bf_lo(ow.w); o[7] = bf_hi(ow.w); }
                    o[0] += sigmoidf_(bf_lo(gw.x)) * v0[0]; o[1] += sigmoidf_(bf_hi(gw.x)) * v0[1]; o[2] += sigmoidf_(bf_lo(gw.y)) * v0[2]; o[3] += sigmoidf_(bf_hi(gw.y)) * v0[3];
                    o[4] += sigmoidf_(bf_lo(gw.z)) * v1[0]; o[5] += sigmoidf_(bf_hi(gw.z)) * v1[1]; o[6] += sigmoidf_(bf_lo(gw.w)) * v1[2]; o[7] += sigmoidf_(bf_hi(gw.w)) * v1[3];
                    if (ADD) { u32x2 w; w.x = pk4_fp8(o[0] * F8_MMUL, o[1] * F8_MMUL, o[2] * F8_MMUL, o[3] * F8_MMUL); w.y = pk4_fp8(o[4] * F8_MMUL, o[5] * F8_MMUL, o[6] * F8_MMUL, o[7] * F8_MMUL);
                        *(u32x2*)(O8 + r * ldc + col0 + bj * HALF) = w; }
                    else { u32x4 w; w.x = cvt_pk_bf16(o[0], o[1]); w.y = cvt_pk_bf16(o[2], o[3]); w.z = cvt_pk_bf16(o[4], o[5]); w.w = cvt_pk_bf16(o[6], o[7]);
                        *(u32x4*)op = w; } } }
    }
};
struct EpiGateDual {
    static constexpr int PERM = 2;
    static constexpr int LDC = 2048, LDG = 4096;
    unsigned char* O8; const unsigned char* Gt;
    static __device__ __forceinline__ float eneg(float g) { return __builtin_amdgcn_exp2f(-1.4426950408889634f * g); }
    static __device__ __forceinline__ float clampb(float g) { return fmaxf(g, -30.0f); }
#define GD8(w, b) __builtin_amdgcn_cvt_f32_fp8((int)(w), b)
    __device__ __forceinline__ void mid(f32x4 (&acc)[2][2][4][2], const Unit& u, int wr, int wc, int fr, int fq) const {
        unsigned gb0 = (unsigned)((u.pm * BM + wr * 64 + fr) * LDG + u.pn * BM + wc * 64 + 16 * fq);
        asm volatile("" : "+v"(gb0));
        const unsigned char* gt = Gt;
#pragma unroll
        for (int ai = 0; ai < 2; ++ai)
#pragma unroll
            for (int m = 0; m < 4; ++m) { const unsigned off = gb0 + (unsigned)((ai * HALF + m * 16) * LDG);
                const u32x4 ga = *(const u32x4*)(gt + off), gb = *(const u32x4*)(gt + off + 2048u);
#define GDR(wa, wb, b) ((1.0f + eneg(clampb(GD8(wb, b)))) * __builtin_amdgcn_rcpf(1.0f + eneg(GD8(wa, b))))
#define GDQ(bj, n, wa, wb) do { acc[ai][bj][m][n][0] *= GDR(wa, wb, 0); acc[ai][bj][m][n][1] *= GDR(wa, wb, 1); acc[ai][bj][m][n][2] *= GDR(wa, wb, 2); acc[ai][bj][m][n][3] *= GDR(wa, wb, 3); } while (0)
                GDQ(0, 0, ga.x, gb.x); GDQ(0, 1, ga.y, gb.y); GDQ(1, 0, ga.z, gb.z); GDQ(1, 1, ga.w, gb.w);
#undef GDQ
#undef GDR
            }
    }
    __device__ __forceinline__ void operator()(const f32x4 (&acc)[2][2][4][2], const Unit& u, int wr, int wc, int fr, int fq) const {
        unsigned rc0 = (unsigned)((u.pm * BM + wr * 64 + fr) * LDC + u.pn * BM + wc * 64 + 16 * fq);
        asm volatile("" : "+v"(rc0));
        const unsigned row0 = rc0 / LDC, col0 = rc0 % LDC;
        const unsigned char* gt = Gt;
#pragma unroll
        for (int ai = 0; ai < 2; ++ai)
#pragma unroll
            for (int m = 0; m < 4; ++m) { const unsigned r = row0 + ai * HALF + m * 16;
                const u32x4 gw = *(const u32x4*)(gt + (r * LDG + 2048u + col0));
#define GSO(bj, n, w) pk4_fp8(sigmoidf_(clampb(GD8(w, 0))) * acc[ai][bj][m][n][0] * F8_MMUL, sigmoidf_(clampb(GD8(w, 1))) * acc[ai][bj][m][n][1] * F8_MMUL, sigmoidf_(clampb(GD8(w, 2))) * acc[ai][bj][m][n][2] * F8_MMUL, sigmoidf_(clampb(GD8(w, 3))) * acc[ai][bj][m][n][3] * F8_MMUL)
                u32x4 w; w.x = GSO(0, 0, gw.x); w.y = GSO(0, 1, gw.y); w.z = GSO(1, 0, gw.z); w.w = GSO(1, 1, gw.w);
#undef GSO
                *(u32x4*)(O8 + (r * LDC + col0)) = w; }
    }
#undef GD8
};
struct EpiResid {
    static constexpr bool PERM = false;
    const float* base; float* out; int ldc;
    __device__ __forceinline__ void operator()(const f32x4 (&acc)[2][2][4][2], const Unit& u, int wr, int wc, int fr, int fq) const {
        const int row0 = u.pm * BM + wr * 64 + fr, col0 = u.pn * BM + wc * 32 + 4 * fq;
#pragma unroll
        for (int ai = 0; ai < 2; ++ai)
#pragma unroll
            for (int m = 0; m < 4; ++m) { const size_t off = (size_t)(row0 + ai * HALF + m * 16) * ldc + col0;
#pragma unroll
                for (int bj = 0; bj < 2; ++bj)
#pragma unroll
                    for (int n = 0; n < 2; ++n) { const f32x4 b = *(const f32x4*)(base + off + bj * HALF + n * 16); *(f32x4*)(out + off + bj * HALF + n * 16) = b + acc[ai][bj][m][n]; } }
    }
};
struct EpiResidB {
    static constexpr bool PERM = true;
    const float* base; bf16_t* out; int ldc;
    __device__ __forceinline__ void operator()(const f32x4 (&acc)[2][2][4][2], const Unit& u, int wr, int wc, int fr, int fq) const {
        const int row0 = u.pm * BM + wr * 64 + fr, col0 = u.pn * BM + wc * 32 + 8 * fq;
#pragma unroll
        for (int ai = 0; ai < 2; ++ai)
#pragma unroll
            for (int m = 0; m < 4; ++m) { const size_t off = (size_t)(row0 + ai * HALF + m * 16) * ldc + col0;
#pragma unroll
                for (int bj = 0; bj < 2; ++bj) { const f32x4 v0 = *(const f32x4*)(base + off + bj * HALF) + acc[ai][bj][m][0], v1 = *(const f32x4*)(base + off + bj * HALF + 4) + acc[ai][bj][m][1];
                    u32x4 w; w.x = cvt_pk_bf16(v0[0], v0[1]); w.y = cvt_pk_bf16(v0[2], v0[3]); w.z = cvt_pk_bf16(v1[0], v1[1]); w.w = cvt_pk_bf16(v1[2], v1[3]);
                    *(u32x4*)(out + off + bj * HALF) = w; } }
    }
};
struct EpiSwiglu {
    static constexpr bool PERM = true;
    unsigned char* act; const float* bg; const float* bu;
    __device__ __forceinline__ void operator()(const f32x4 (&acc)[2][2][4][2], const Unit& u, int wr, int wc, int fr, int fq) const {
        const int row0 = u.pm * BM + wr * 64 + fr, j0 = u.pn * HALF + wc * 32 + 8 * fq;
        const f32x4 g0 = *(const f32x4*)(bg + (size_t)u.e * DE + j0), g1 = *(const f32x4*)(bg + (size_t)u.e * DE + j0 + 4);
        const f32x4 u0 = *(const f32x4*)(bu + (size_t)u.e * DE + j0), u1 = *(const f32x4*)(bu + (size_t)u.e * DE + j0 + 4);
#pragma unroll
        for (int ai = 0; ai < 2; ++ai)
#pragma unroll
            for (int m = 0; m < 4; ++m) {
                float o[8];
#pragma unroll
                for (int n = 0; n < 2; ++n)
#pragma unroll
                    for (int i = 0; i < 4; ++i) {
                        float gt = acc[ai][0][m][n][i] + (n ? g1[i] : g0[i]), up = acc[ai][1][m][n][i] + (n ? u1[i] : u0[i]);
                        gt = fminf(gt, 7.0f); up = fminf(fmaxf(up, -7.0f), 7.0f);
                        o[n * 4 + i] = gt * sigmoidf_(1.702f * gt) * (up + 1.0f); }
                u32x2 w; w.x = pk4_fp8(o[0], o[1], o[2], o[3]); w.y = pk4_fp8(o[4], o[5], o[6], o[7]);
                *(u32x2*)(act + (size_t)(row0 + ai * HALF + m * 16) * DE + j0) = w; }
    }
};
struct EpiDown {
    static constexpr int PERM = 2;
    unsigned char* Y; const float* bd; const float* lw; const LAS int* tstart;
    __device__ __forceinline__ void operator()(const f32x4 (&acc)[2][2][4][2], const Unit& u, int wr, int wc, int fr, int fq) const {
        const int rl0 = wr * 64 + fr, col0 = u.pn * BM + wc * 64 + 16 * fq;
        const int lt = u.pm - tstart[u.e];
        f32x4 bv[2][2];
#pragma unroll
        for (int bj = 0; bj < 2; ++bj)
#pragma unroll
            for (int n = 0; n < 2; ++n) bv[bj][n] = *(const f32x4*)(bd + (size_t)u.e * D + col0 + 8 * bj + 4 * n);
#pragma unroll
        for (int ai = 0; ai < 2; ++ai)
#pragma unroll
            for (int m = 0; m < 4; ++m) { const int rl = rl0 + ai * HALF + m * 16;
                const float wl = lw[(size_t)u.e * LCAP + lt * 256 + (rl < u.cnt ? rl : u.cnt - 1)]; const float w = rl < u.cnt ? wl : 0.f;
                unsigned char* rowp = Y + (size_t)(u.pm * BM + rl) * D + col0; const float w16 = w * 16.0f;
                u32x4 q;
                { const f32x4 v = (acc[ai][0][m][0] + bv[0][0]) * w16; q.x = pk4_fp8(v[0], v[1], v[2], v[3]); }
                { const f32x4 v = (acc[ai][0][m][1] + bv[0][1]) * w16; q.y = pk4_fp8(v[0], v[1], v[2], v[3]); }
                { const f32x4 v = (acc[ai][1][m][0] + bv[1][0]) * w16; q.z = pk4_fp8(v[0], v[1], v[2], v[3]); }
                { const f32x4 v = (acc[ai][1][m][1] + bv[1][1]) * w16; q.w = pk4_fp8(v[0], v[1], v[2], v[3]); }
                *(u32x4*)rowp = q; }
    }
};
struct MoeOrder {
    const LAS int* cnt; const LAS int* tstart; const LAS unsigned char* tile_e; int TT, NC, G, c;
    const int* ltok; bool gather; size_t brows;
    __device__ __forceinline__ bool next(int i, Unit& u) const {
        if (!tile_order(i, G, c, TT, NC, u.pm, u.pn)) return false;
        u.e = tile_e[u.pm]; const int lt = u.pm - tstart[u.e]; const int rem = cnt[u.e] - lt * 256; u.cnt = rem < 256 ? rem : 256; return true;
    }
    __device__ __forceinline__ void a_offs(const Gemm& g, const Unit& u, const int (&R)[2], const int (&C)[2], unsigned (&ao)[2][2]) const {
        const int lt = u.pm - tstart[u.e];
#pragma unroll
        for (int h = 0; h < 2; ++h)
#pragma unroll
            for (int i = 0; i < 2; ++i) {
                int row;
                if (gather) { int rl = h * HALF + R[i]; rl = rl < u.cnt ? rl : u.cnt - 1;
                    row = ltok[(size_t)u.e * LCAP + lt * 256 + rl]; }
                else row = u.pm * BM + h * HALF + R[i];
                ao[h][i] = (unsigned)(row * g.rb + C[i] * 2); }
    }
    __device__ __forceinline__ const char* b_ptr(const Gemm& g, const Unit& u) const { return (const char*)g.Bt + ((size_t)u.e * brows + (size_t)u.pn * BM) * g.rb; }
};
}

#define F8D(w, b) __builtin_amdgcn_cvt_f32_fp8((int)(w), b)
namespace att {
constexpr int NW = 8, QBLK = 32, KVBLK = 64;
constexpr float SCALE = 0.088388347648318440f;
constexpr float THR = 8.f;
constexpr float QMUL = 0.088388347648318440f * 1.4426950408889634f * 16.0f;
constexpr float PTHR = 0.75f, PHEAD0 = 2.0f, PHEAD = 1.0f;
constexpr float KMUL = 2.0f, VMUL = 2.0f;
constexpr size_t SHM_V = KVBLK * HD * 2, SHM_K = KVBLK * HD * 2, SHM_ATTN = 2 * SHM_V + 2 * SHM_K + NW * 64 * 4;
constexpr int BIAS_OFF = 67584;
#define KSWZ(row, colB) ((row) * 256 + ((colB) ^ (((row) & 15) << 4)))
#define SBAR() __builtin_amdgcn_sched_barrier(0)
__device__ __forceinline__ int crow(int r, int hi) { return (r & 3) + 8 * (r >> 2) + 4 * hi; }
__device__ __forceinline__ unsigned cvtpk(float lo, float hi) { unsigned r; asm volatile("v_cvt_pk_bf16_f32 %0, %1, %2" : "=v"(r) : "v"(lo), "v"(hi)); return r; }
__device__ __forceinline__ bf16x8 ld8(const bf16_t* p) { return *reinterpret_cast<const bf16x8*>(p); }

__device__ __forceinline__ void partialSM(f32x16& p0, f32x16& p1, float& m_reg, float& mn, float& alpha) {
  constexpr float C = SCALE * 1.4426950408889634f;
  float pmax = p0[0]; for (int r = 1; r < 16; ++r) pmax = fmaxf(pmax, p0[r]); for (int r = 0; r < 16; ++r) pmax = fmaxf(pmax, p1[r]);
  { auto rr = __builtin_amdgcn_permlane32_swap(__float_as_uint(pmax), __float_as_uint(pmax), false, false);
    pmax = fmaxf(__uint_as_float(rr[0]), __uint_as_float(rr[1])); }
  if (__builtin_expect(__all(pmax - m_reg <= THR / SCALE), 1)) { mn = m_reg; alpha = 1.f; }
  else { mn = fmaxf(m_reg, pmax); alpha = __builtin_amdgcn_exp2f((m_reg - mn) * C); m_reg = mn; }
  float mnC = -mn * C;
  for (int r = 0; r < 16; ++r) p0[r] = fmaf(p0[r], C, mnC); for (int r = 0; r < 16; ++r) p1[r] = fmaf(p1[r], C, mnC);
  for (int r = 0; r < 16; ++r) p0[r] = __builtin_amdgcn_exp2f(p0[r]);
}
__device__ __forceinline__ void finishSM(f32x16& p0, f32x16& p1, float alpha, float& l_reg, bf16x8& pa0, bf16x8& pa1, bf16x8& pa2, bf16x8& pa3) {
  for (int r = 0; r < 16; ++r) p1[r] = __builtin_amdgcn_exp2f(p1[r]);
  float ps = 0; for (int r = 0; r < 16; ++r) ps += p0[r]; for (int r = 0; r < 16; ++r) ps += p1[r];
  { auto rr = __builtin_amdgcn_permlane32_swap(__float_as_uint(ps), __float_as_uint(ps), false, false);
    ps = __uint_as_float(rr[0]) + __uint_as_float(rr[1]); }
  l_reg = l_reg * alpha + ps;
#define PK4(P, BASE, OUT) do { unsigned a0 = cvtpk(P[BASE + 0], P[BASE + 1]), a1 = cvtpk(P[BASE + 2], P[BASE + 3]);   \
    unsigned b0 = cvtpk(P[BASE + 4], P[BASE + 5]), b1 = cvtpk(P[BASE + 6], P[BASE + 7]);                              \
    auto r0 = __builtin_amdgcn_permlane32_swap(a0, b0, false, false); auto r1 = __builtin_amdgcn_permlane32_swap(a1, b1, false, false); \
    u32x4 w = {r0[0], r1[0], r0[1], r1[1]}; OUT = *reinterpret_cast<bf16x8*>(&w); } while (0)
  PK4(p0, 0, pa0); PK4(p0, 8, pa1); PK4(p1, 0, pa2); PK4(p1, 8, pa3);
#undef PK4
}
__device__ __forceinline__ void qkt(f32x16& p0, f32x16& p1, const bf16_t* Ks, const bf16x8* qr, int r32, int hi) {
  p0 = f32x16{}; p1 = f32x16{};
  for (int d0 = 0; d0 < 8; ++d0) { int cb = (d0 * 16 + hi * 8) * 2;
    bf16x8 b0 = *reinterpret_cast<const bf16x8*>((const char*)Ks + KSWZ(r32, cb));
    bf16x8 b1 = *reinterpret_cast<const bf16x8*>((const char*)Ks + KSWZ(32 + r32, cb));
    p0 = __builtin_amdgcn_mfma_f32_32x32x16_bf16(b0, qr[d0], p0, 0, 0, 0);
    p1 = __builtin_amdgcn_mfma_f32_32x32x16_bf16(b1, qr[d0], p1, 0, 0, 0); }
}
__device__ __forceinline__ int v_st(int k, int c) { const int kk = (k & ~0xC) | ((k & 4) << 1) | ((k & 8) >> 1); return ((kk >> 3) * 4 + (c >> 5)) * 512 + ((kk & 7) * 32 + (c & 31)) * 2; }
__device__ __forceinline__ int v_rd_base(int lane) { return ((lane & 3) << 3) | (((lane >> 2) & 3) << 6) | (((lane >> 4) & 1) << 5) | (((lane >> 5) & 1) << 8); }
constexpr int v_rd_off(int d0, int ks, int half) { return d0 * 512 + ks * 4096 + half * 2048; }
template <int OFF> __device__ __forceinline__ s16x4 tr_read(int vb) {
  s16x4 r; asm volatile("ds_read_b64_tr_b16 %0, %1 offset:%2" : "=&v"(r) : "v"(vb), "i"(OFF) : "memory"); return r;
}
template <int D0> __device__ __forceinline__ void pv_one(f32x16& od, int vb, bf16x8 pa0, bf16x8 pa1, bf16x8 pa2, bf16x8 pa3) {
  const s16x4 l0 = tr_read<v_rd_off(D0, 0, 0)>(vb), h0 = tr_read<v_rd_off(D0, 0, 1)>(vb), l1 = tr_read<v_rd_off(D0, 1, 0)>(vb), h1 = tr_read<v_rd_off(D0, 1, 1)>(vb);
  const s16x4 l2 = tr_read<v_rd_off(D0, 2, 0)>(vb), h2 = tr_read<v_rd_off(D0, 2, 1)>(vb), l3 = tr_read<v_rd_off(D0, 3, 0)>(vb), h3 = tr_read<v_rd_off(D0, 3, 1)>(vb);
  asm volatile("s_waitcnt lgkmcnt(0)" ::: "memory"); SBAR();
#define PK(L, H) (bf16x8){L[0], L[1], L[2], L[3], H[0], H[1], H[2], H[3]}
  od = __builtin_amdgcn_mfma_f32_32x32x16_bf16(pa0, PK(l0, h0), od, 0, 0, 0);
  od = __builtin_amdgcn_mfma_f32_32x32x16_bf16(pa1, PK(l1, h1), od, 0, 0, 0);
  od = __builtin_amdgcn_mfma_f32_32x32x16_bf16(pa2, PK(l2, h2), od, 0, 0, 0);
  od = __builtin_amdgcn_mfma_f32_32x32x16_bf16(pa3, PK(l3, h3), od, 0, 0, 0);
#undef PK
}
__device__ __forceinline__ void pv_d0(f32x16* o, int vb, bf16x8 pa0, bf16x8 pa1, bf16x8 pa2, bf16x8 pa3) {
  pv_one<0>(o[0], vb, pa0, pa1, pa2, pa3); pv_one<1>(o[1], vb, pa0, pa1, pa2, pa3); pv_one<2>(o[2], vb, pa0, pa1, pa2, pa3); pv_one<3>(o[3], vb, pa0, pa1, pa2, pa3);
}
struct NoMask { __device__ __forceinline__ void operator()(f32x16&, f32x16&, int) const {} };
struct NaMask {
  const float* bias; int kr0, rq, c, cs, hi;
  __device__ __forceinline__ void operator()(f32x16& p0, f32x16& p1, int j) const {
    const int kr = kr0 + j; int rs = rq - 4; rs = rs < 0 ? 0 : (rs > ROWS - 8 ? ROWS - 8 : rs);
    const bool vrow = (kr >= rs) && (kr < rs + 8);
    int ro = kr - rq + 7; ro = ro < 0 ? 0 : (ro > 14 ? 14 : ro);
    const float* br = bias + ro * 32; const float ninf = -__builtin_inff();
#pragma unroll
    for (int r = 0; r < 16; ++r) { const int kc = crow(r, hi);
      { const bool v = vrow && ((unsigned)(kc - cs) < 16u); const int co = v ? (kc - c + 15) : 0; const float b = br[co]; p0[r] = v ? p0[r] + b : ninf; }
      { const int kc1 = kc + 32; const bool v = vrow && ((unsigned)(kc1 - cs) < 16u); const int co = v ? (kc1 - c + 15) : 0; const float b = br[co]; p1[r] = v ? p1[r] + b : ninf; } }
  }
};

template <int LDQ, int LDK, int LDO, class Mask>
__device__ __forceinline__ void attn_body(const bf16_t* __restrict__ Qb, const bf16_t* __restrict__ Kh, const bf16_t* __restrict__ Vh,
                                          unsigned char* __restrict__ Ob, int seq, char* lds, const Mask& MK, const int wid) {
  const int lane = lane_now(), tid = wid * 64 + lane, r32 = lane & 31, hi = lane >> 5;
  bf16_t* V_lds = (bf16_t*)lds; bf16_t* K_lds = (bf16_t*)(lds + 2 * SHM_V);
  float* ws = (float*)(lds + 2 * SHM_V + 2 * SHM_K) + wid * 64; float* li_l = ws; float* al_l = ws + 32;
  float m_reg = -1e30f, l_reg = 0; f32x16 o[4] = {}; bf16x8 qr[8];
  const bf16_t* Qw = Qb + (long)(wid * QBLK + r32) * LDQ + hi * 8;
#pragma unroll
  for (int d0 = 0; d0 < 8; ++d0) qr[d0] = ld8(Qw + d0 * 16);
  const int sr = tid >> 4, sc = (tid & 15) * 8, vst0 = v_st(sr, sc), vst1 = v_st(32 + sr, sc);
  const unsigned lo0 = (unsigned)(sr * LDK + sc) * 2u, lo1 = lo0 + 32u * LDK * 2u;
  const int vb0 = (int)(uintptr_t)V_lds + v_rd_base(lane);
  constexpr int SDEPTH = 2;
  struct { bf16x8 vs0, vs1, ks0, ks1; } sr_[SDEPTH];
#define SLOAD(i, k0) do { const char* kb_ = (const char*)Kh + (size_t)(k0) * (LDK * 2); const char* vb_ = (const char*)Vh + (size_t)(k0) * (LDK * 2); \
    sr_[i].vs0 = *(const bf16x8*)(vb_ + lo0); sr_[i].vs1 = *(const bf16x8*)(vb_ + 32 * LDK * 2 + lo0); \
    sr_[i].ks0 = *(const bf16x8*)(kb_ + lo0); sr_[i].ks1 = *(const bf16x8*)(kb_ + 32 * LDK * 2 + lo0); } while (0)
#define SWRITE(b, i) do { *(bf16x8*)((char*)V_lds + (b) * SHM_V + vst0) = sr_[i].vs0;          \
    *(bf16x8*)((char*)V_lds + (b) * SHM_V + vst1) = sr_[i].vs1; int kc = sc * 2;               \
    *(bf16x8*)((char*)K_lds + (b) * SHM_K + KSWZ(sr, kc)) = sr_[i].ks0;                       \
    *(bf16x8*)((char*)K_lds + (b) * SHM_K + KSWZ(32 + sr, kc)) = sr_[i].ks1; } while (0)
#define SWAIT() do { if constexpr (SDEPTH == 2) asm volatile("s_waitcnt vmcnt(4)" ::: "memory"); else asm volatile("s_waitcnt vmcnt(0)" ::: "memory"); } while (0)
#define RESC(a) do { if (__any((a) < 1.f)) { const int ln_ = lane_now(), r32_ = ln_ & 31, hi_ = ln_ >> 5; float* al2_ = (float*)(lds + 2 * SHM_V + 2 * SHM_K) + wid * 64 + 32; \
    if (hi_ == 0) al2_[r32_] = (a); asm volatile("s_waitcnt lgkmcnt(0)" ::: "memory"); \
    for (int d = 0; d < 4; ++d) for (int r = 0; r < 16; ++r) o[d][r] *= al2_[crow(r, hi_)]; } } while (0)
  f32x16 pA0, pA1, pB0, pB1; float mnA, mnB, alA, alB; bf16x8 pa0, pa1, pa2, pa3; const int NT = seq / KVBLK;
  constexpr int SE = 0, SO = SDEPTH - 1;
  SLOAD(SE, 0); asm volatile("s_waitcnt vmcnt(0)" ::: "memory"); SWRITE(0, SE); __syncthreads();
  qkt(pA0, pA1, K_lds, qr, r32, hi); MK(pA0, pA1, 0); partialSM(pA0, pA1, m_reg, mnA, alA);
  SLOAD(SO, KVBLK); if constexpr (SDEPTH == 2) { if (2 < NT) SLOAD(SE, 2 * KVBLK); }
  SWAIT(); SWRITE(1, SO); __syncthreads();
  for (int j = 1; j + 1 < NT; j += 2) {
    SBAR(); qkt(pB0, pB1, (bf16_t*)((char*)K_lds + SHM_K), qr, r32, hi); MK(pB0, pB1, j);
    finishSM(pA0, pA1, alA, l_reg, pa0, pa1, pa2, pa3); SBAR();
    SLOAD(SO, (j + SDEPTH) * KVBLK); SBAR();
    pv_d0(o, vb0, pa0, pa1, pa2, pa3); partialSM(pB0, pB1, m_reg, mnB, alB);
    __syncthreads(); SWAIT(); SWRITE(0, SE);
    RESC(alB); __syncthreads();
    SBAR(); qkt(pA0, pA1, K_lds, qr, r32, hi); MK(pA0, pA1, j + 1);
    finishSM(pB0, pB1, alB, l_reg, pa0, pa1, pa2, pa3); SBAR();
    if (SDEPTH == 1 || j + 3 < NT) SLOAD(SE, (j + 1 + SDEPTH) * KVBLK); SBAR();
    pv_d0(o, vb0 + (int)SHM_V, pa0, pa1, pa2, pa3); partialSM(pA0, pA1, m_reg, mnA, alA);
    __syncthreads(); SWAIT(); SWRITE(1, SO);
    RESC(alA); __syncthreads();
  }
  SBAR(); qkt(pB0, pB1, (bf16_t*)((char*)K_lds + SHM_K), qr, r32, hi); MK(pB0, pB1, NT - 1);
  finishSM(pA0, pA1, alA, l_reg, pa0, pa1, pa2, pa3); SBAR();
  pv_d0(o, vb0, pa0, pa1, pa2, pa3); partialSM(pB0, pB1, m_reg, mnB, alB);
  __syncthreads(); RESC(alB);
  finishSM(pB0, pB1, alB, l_reg, pa0, pa1, pa2, pa3); SBAR();
  pv_d0(o, vb0 + (int)SHM_V, pa0, pa1, pa2, pa3);
  if (hi == 0) li_l[r32] = l_reg; asm volatile("s_waitcnt lgkmcnt(0)" ::: "memory");
  float rli[16];
#pragma unroll
  for (int r = 0; r < 16; ++r) rli[r] = __builtin_amdgcn_rcpf(li_l[crow(r, hi)]) * F8_YMUL;
  unsigned char* Ow = Ob + (long)(wid * QBLK) * LDO; const unsigned lane_off = (unsigned)(4 * hi * LDO + r32);
#pragma unroll
  for (int r = 0; r < 16; ++r) { unsigned char* rowb = Ow + ((r & 3) + 8 * (r >> 2)) * LDO;
#pragma unroll
    for (int d0 = 0; d0 < 4; ++d0) { const float v = o[d0][r] * rli[r]; rowb[lane_off + d0 * 32] = (unsigned char)(__builtin_amdgcn_cvt_pk_fp8_f32(v, v, 0, false) & 0xff); } }
#undef SLOAD
#undef SWRITE
#undef SWAIT
#undef RESC
}

__device__ __forceinline__ bf16x8 f8x8_to_bf16(const u32x2 w) { u32x4 o; o.x = cvtpk(F8D(w.x, 0), F8D(w.x, 1)); o.y = cvtpk(F8D(w.x, 2), F8D(w.x, 3)); o.z = cvtpk(F8D(w.y, 0), F8D(w.y, 1)); o.w = cvtpk(F8D(w.y, 2), F8D(w.y, 3)); return __builtin_bit_cast(bf16x8, o); }
template <int LDQ, int LDK, int LDO, class Mask>
__device__ __forceinline__ void attn_body_simple(const unsigned char* __restrict__ Qb, const unsigned char* __restrict__ Kh, const unsigned char* __restrict__ Vh,
                                                 unsigned char* __restrict__ Ob, int NT, char* lds, const Mask& MK, const int wid, const float* __restrict__ gq, const float* __restrict__ gk) {
  const int lane = lane_now(), tid = wid * 64 + lane, r32 = lane & 31, hi = lane >> 5;
  bf16_t* V_lds = (bf16_t*)lds; bf16_t* K_lds = (bf16_t*)(lds + 2 * SHM_V);
  float* ws = (float*)(lds + 2 * SHM_V + 2 * SHM_K) + wid * 64; float* li_l = ws; float* al_l = ws + 32;
  float m_reg = -1e30f, l_reg = 0; f32x16 o[4] = {}; bf16x8 qr[8];
  const unsigned char* Qw = Qb + (long)(wid * QBLK + r32) * LDQ + hi * 8;
#pragma unroll
  for (int d0 = 0; d0 < 8; ++d0) qr[d0] = f8x8_to_bf16(*(const u32x2*)(Qw + d0 * 16));
  { float ss = 0.f;
#pragma unroll
    for (int d0 = 0; d0 < 8; ++d0) { const u32x4 w = __builtin_bit_cast(u32x4, qr[d0]); const float a0 = bf_lo(w.x), a1 = bf_hi(w.x), a2 = bf_lo(w.y), a3 = bf_hi(w.y), a4 = bf_lo(w.z), a5 = bf_hi(w.z), a6 = bf_lo(w.w), a7 = bf_hi(w.w);
        ss += (a0 * a0 + a1 * a1) + (a2 * a2 + a3 * a3) + (a4 * a4 + a5 * a5) + (a6 * a6 + a7 * a7); }
    { auto rr = __builtin_amdgcn_permlane32_swap(__float_as_uint(ss), __float_as_uint(ss), false, false); ss = __uint_as_float(rr[0]) + __uint_as_float(rr[1]); }
    const float rstd = 1.0f / sqrtf(ss * (1.f / 128.f) + EPS);
#pragma unroll
    for (int d0 = 0; d0 < 8; ++d0) { const u32x4 w = __builtin_bit_cast(u32x4, qr[d0]); const f32x4 g0 = *(const f32x4*)(gq + d0 * 16 + hi * 8), g1 = *(const f32x4*)(gq + d0 * 16 + hi * 8 + 4);
        u32x4 o; o.x = cvtpk(bf_lo(w.x) * rstd * g0.x, bf_hi(w.x) * rstd * g0.y); o.y = cvtpk(bf_lo(w.y) * rstd * g0.z, bf_hi(w.y) * rstd * g0.w);
        o.z = cvtpk(bf_lo(w.z) * rstd * g1.x, bf_hi(w.z) * rstd * g1.y); o.w = cvtpk(bf_lo(w.w) * rstd * g1.z, bf_hi(w.w) * rstd * g1.w); qr[d0] = __builtin_bit_cast(bf16x8, o); } }
  const int sr = tid >> 4, sc = (tid & 15) * 8, vst0 = v_st(sr, sc), vst1 = v_st(32 + sr, sc);
  const unsigned lo0 = (unsigned)(sr * LDK + sc), lo1 = lo0 + 32u * LDK;
  const int vb0 = (int)(uintptr_t)V_lds + v_rd_base(lane);
  const f32x4 gk0 = *(const f32x4*)(gk + sc), gk1 = *(const f32x4*)(gk + sc + 4);
  bf16x8 vs0, vs1, ks0, ks1; u32x2 vr0, vr1, kr0, kr1;
#define KNORM(kv) do { const u32x4 w_ = __builtin_bit_cast(u32x4, kv); const float a0 = bf_lo(w_.x), a1 = bf_hi(w_.x), a2 = bf_lo(w_.y), a3 = bf_hi(w_.y), a4 = bf_lo(w_.z), a5 = bf_hi(w_.z), a6 = bf_lo(w_.w), a7 = bf_hi(w_.w); \
    float ss_ = (a0 * a0 + a1 * a1) + (a2 * a2 + a3 * a3) + (a4 * a4 + a5 * a5) + (a6 * a6 + a7 * a7); ss_ += __shfl_xor(ss_, 1); ss_ += __shfl_xor(ss_, 2); ss_ += __shfl_xor(ss_, 4); ss_ += __shfl_xor(ss_, 8); \
    const float r_ = 1.0f / sqrtf(ss_ * (1.f / 128.f) + EPS); u32x4 o_; o_.x = cvtpk(a0 * r_ * gk0.x, a1 * r_ * gk0.y); o_.y = cvtpk(a2 * r_ * gk0.z, a3 * r_ * gk0.w); o_.z = cvtpk(a4 * r_ * gk1.x, a5 * r_ * gk1.y); o_.w = cvtpk(a6 * r_ * gk1.z, a7 * r_ * gk1.w); \
    kv = __builtin_bit_cast(bf16x8, o_); } while (0)
#define NLOAD(k0) do { const unsigned char* kb_ = Kh + (size_t)(k0) * LDK; const unsigned char* vb_ = Vh + (size_t)(k0) * LDK; \
    vr0 = *(const u32x2*)(vb_ + lo0); vr1 = *(const u32x2*)(vb_ + lo1); kr0 = *(const u32x2*)(kb_ + lo0); kr1 = *(const u32x2*)(kb_ + lo1); } while (0)
#define NWRITE(b) do { vs0 = f8x8_to_bf16(vr0); vs1 = f8x8_to_bf16(vr1); ks0 = f8x8_to_bf16(kr0); ks1 = f8x8_to_bf16(kr1); KNORM(ks0); KNORM(ks1); *(bf16x8*)((char*)V_lds + (b) * SHM_V + vst0) = vs0; *(bf16x8*)((char*)V_lds + (b) * SHM_V + vst1) = vs1; const int kc = sc * 2; \
    *(bf16x8*)((char*)K_lds + (b) * SHM_K + KSWZ(sr, kc)) = ks0; *(bf16x8*)((char*)K_lds + (b) * SHM_K + KSWZ(32 + sr, kc)) = ks1; } while (0)
  NLOAD(0); asm volatile("s_waitcnt vmcnt(0)" ::: "memory"); NWRITE(0); __syncthreads();
  for (int j = 0; j < NT; ++j) {
    const int bsel = j & 1;
    if (j + 1 < NT) NLOAD((j + 1) * KVBLK);
    f32x16 p0, p1; float mn, al; bf16x8 pa0, pa1, pa2, pa3;
    qkt(p0, p1, (const bf16_t*)((const char*)K_lds + bsel * SHM_K), qr, r32, hi); MK(p0, p1, j);
    partialSM(p0, p1, m_reg, mn, al);
    if (__any(al < 1.f)) { if (hi == 0) al_l[r32] = al; asm volatile("s_waitcnt lgkmcnt(0)" ::: "memory");
      for (int d = 0; d < 4; ++d) for (int r = 0; r < 16; ++r) o[d][r] *= al_l[crow(r, hi)]; }
    finishSM(p0, p1, al, l_reg, pa0, pa1, pa2, pa3); SBAR();
    pv_d0(o, vb0 + bsel * (int)SHM_V, pa0, pa1, pa2, pa3);
    if (j + 1 < NT) { asm volatile("s_waitcnt vmcnt(0)" ::: "memory"); NWRITE(bsel ^ 1); }
    __syncthreads();
  }
  if (hi == 0) li_l[r32] = l_reg; asm volatile("s_waitcnt lgkmcnt(0)" ::: "memory");
  float rli[16];
#pragma unroll
  for (int r = 0; r < 16; ++r) rli[r] = __builtin_amdgcn_rcpf(li_l[crow(r, hi)]) * F8_YMUL;
  unsigned char* Ow = Ob + (long)(wid * QBLK) * LDO; const unsigned lane_off = (unsigned)(4 * hi * LDO + r32);
#pragma unroll
  for (int r = 0; r < 16; ++r) { unsigned char* rowb = Ow + ((r & 3) + 8 * (r >> 2)) * LDO;
#pragma unroll
    for (int d0 = 0; d0 < 4; ++d0) { const float v = o[d0][r] * rli[r]; rowb[lane_off + d0 * 32] = (unsigned char)(__builtin_amdgcn_cvt_pk_fp8_f32(v, v, 0, false) & 0xff); } }
#undef NLOAD
#undef NWRITE
#undef KNORM
}
constexpr int F8_KT = 8192, F8_SCR = 49152;
#define MF8(a, b, c, sa, sb) __builtin_amdgcn_mfma_scale_f32_32x32x64_f8f6f4(a, b, c, 0, 0, 0, sa, 0, sb)
#define MFPV(a, b, c, sa, sb) __builtin_amdgcn_mfma_scale_f32_32x32x64_f8f6f4(a, b, c, 3, 2, 0, sa, 0, sb)
#define MF6(a, b, c, sa, sb) __builtin_amdgcn_mfma_scale_f32_32x32x64_f8f6f4(a, b, c, 2, 2, 0, sa, 0, sb)
__device__ __forceinline__ i32x8 cat8(const i32x4 lo, const i32x4 hi) { return __builtin_shufflevector(lo, hi, 0, 1, 2, 3, 4, 5, 6, 7); }
__device__ __forceinline__ i32x8 cat6(const i32x4 lo, const i32x2 hi) { i32x8 r; r[0] = lo[0]; r[1] = lo[1]; r[2] = lo[2]; r[3] = lo[3]; r[4] = hi[0]; r[5] = hi[1]; int u0, u1; asm volatile("" : "=v"(u0), "=v"(u1)); r[6] = u0; r[7] = u1; return r; }
template <bool REL>
__device__ __forceinline__ void qkt8(f32x16& p0, f32x16& p1, const char* Kt, const i32x8 (&qf)[2], const int (&ka)[2][2], const f32x16& negm) {
  const i32x8 k00 = cat6(*(const i32x4*)(Kt + ka[0][0]), *(const i32x2*)(Kt + ka[0][1])), k10 = cat6(*(const i32x4*)(Kt + 4096 + ka[0][0]), *(const i32x2*)(Kt + 4096 + ka[0][1]));
  const i32x8 k01 = cat6(*(const i32x4*)(Kt + ka[1][0]), *(const i32x2*)(Kt + ka[1][1])), k11 = cat6(*(const i32x4*)(Kt + 4096 + ka[1][0]), *(const i32x2*)(Kt + 4096 + ka[1][1]));
  asm volatile("" ::: "memory");
  const f32x16 zero = {};
  p0 = MF6(k00, qf[0], REL ? negm : zero, 126, 123); p1 = MF6(k10, qf[0], REL ? negm : zero, 126, 123); p0 = MF6(k01, qf[1], p0, 126, 123); p1 = MF6(k11, qf[1], p1, 126, 123);
}
__device__ __forceinline__ void partial8(f32x16& p0, f32x16& p1, float& m_reg, float& alpha) {
  float pmax = p0[0]; for (int r = 1; r < 16; ++r) pmax = fmaxf(pmax, p0[r]); for (int r = 0; r < 16; ++r) pmax = fmaxf(pmax, p1[r]);
  { auto rr = __builtin_amdgcn_permlane32_swap(__float_as_uint(pmax), __float_as_uint(pmax), false, false);
    pmax = fmaxf(__uint_as_float(rr[0]), __uint_as_float(rr[1])); }
  float mn;
  if (__builtin_expect(__all(pmax - m_reg <= PTHR), 1)) { mn = m_reg; alpha = 1.f; }
  else { mn = fmaxf(m_reg, pmax) + PHEAD0; alpha = __builtin_amdgcn_exp2f(m_reg - mn); m_reg = mn; }
  const float mb = mn - 4.0f;
  for (int r = 0; r < 16; ++r) p0[r] = p0[r] - mb; for (int r = 0; r < 16; ++r) p1[r] = p1[r] - mb;
  for (int r = 0; r < 16; ++r) p0[r] = __builtin_amdgcn_exp2f(p0[r]);
}
__device__ __forceinline__ void partial8r(f32x16& p0, f32x16& p1, float& m_reg, float& alpha, f32x16& negm) {
  float pmax = p0[0]; for (int r = 1; r < 16; ++r) pmax = fmaxf(pmax, p0[r]); for (int r = 0; r < 16; ++r) pmax = fmaxf(pmax, p1[r]);
  { auto rr = __builtin_amdgcn_permlane32_swap(__float_as_uint(pmax), __float_as_uint(pmax), false, false);
    pmax = fmaxf(__uint_as_float(rr[0]), __uint_as_float(rr[1])); }
  if (__builtin_expect(__all(pmax <= 4.0f + PTHR), 1)) { alpha = 1.f; }
  else { const float d = fmaxf(pmax - 4.0f + PHEAD, 0.f); alpha = __builtin_amdgcn_exp2f(-d); m_reg += d;
    for (int r = 0; r < 16; ++r) { p0[r] -= d; p1[r] -= d; negm[r] -= d; } }
  for (int r = 0; r < 16; ++r) p0[r] = __builtin_amdgcn_exp2f(p0[r]);
}
__device__ __forceinline__ int pk4_fp8_nz(float a, float b, float c, float d, int old) { int w = __builtin_amdgcn_cvt_pk_fp8_f32(a, b, old, false); return __builtin_amdgcn_cvt_pk_fp8_f32(c, d, w, true); }
__device__ __forceinline__ void finish8(const f32x16& p0, f32x16& p1, i32x8& pa) {
  for (int r = 0; r < 16; ++r) p1[r] = __builtin_amdgcn_exp2f(p1[r]);
  typedef unsigned u32x6_ __attribute__((ext_vector_type(6)));
  const u32x6_ pk = __builtin_amdgcn_cvt_scalef32_2xpk16_bf6_f32(p0, p1, 1.0f);
#pragma unroll
  for (int i = 0; i < 6; ++i) pa[i] = (int)pk[i];
  { int u0, u1; asm volatile("" : "=v"(u0), "=v"(u1)); pa[6] = u0; pa[7] = u1; }
}
__device__ __forceinline__ void pv8(f32x16 (&o)[4], f32x16& lacc, const char* Vt, const i32x8& pa, const int (&va)[2], const i32x8& ones) {
  lacc = MFPV(pa, ones, lacc, 127, 127);
#pragma unroll
  for (int d0 = 0; d0 < 4; ++d0) { const i32x8 vf = cat6(*(const i32x4*)(Vt + d0 * 2048 + va[0]), *(const i32x2*)(Vt + d0 * 2048 + va[1]));
    o[d0] = MFPV(pa, vf, o[d0], 127, 126); }
}
struct NoConv { static constexpr bool ON = false; __device__ __forceinline__ bool on() const { return false; } __device__ __forceinline__ void step(int, int) {} __device__ __forceinline__ void end() {} };
template <int LDO, class CV>
__device__ __forceinline__ void attn_body_f8(const unsigned char* __restrict__ Q8b, const unsigned char* __restrict__ K8h, const unsigned char* __restrict__ Vt8h,
                                             unsigned char* __restrict__ Ob, int seq, char* lds, LAS unsigned char* ldsl, const int wid, CV& cvx) {
  const int lane = lane_now(), tid = wid * 64 + lane, r32 = lane & 31, hi = lane >> 5;
  char* K_lds = lds; char* V_lds = lds + 3 * F8_KT;
  float m_reg = -1e30f; f32x16 o[4] = {}; f32x16 lacc = {}; i32x8 qf[2];
  { const unsigned char* qrow = Q8b + (size_t)(wid * QBLK + r32) * HD + hi * 32;
#pragma unroll
    for (int dh = 0; dh < 2; ++dh) qf[dh] = cat8(*(const i32x4*)(qrow + dh * 64), *(const i32x4*)(qrow + dh * 64 + 16)); }
  int ka[2][2]; { const int sw = (r32 >> 1) & 7;
#pragma unroll
    for (int dh = 0; dh < 2; ++dh)
#pragma unroll
      for (int e = 0; e < 2; ++e) ka[dh][e] = r32 * 128 + (((dh * 4 + hi * 2 + e) ^ sw) << 4); }
  int va[2]; { const int sw = (r32 >> 2) & 3;
#pragma unroll
    for (int e = 0; e < 2; ++e) va[e] = r32 * 64 + (((hi * 2 + e) ^ sw) << 4); }
  const int kp_row = wid * 8 + (lane >> 3), kp_c = (lane & 7) ^ ((kp_row >> 1) & 7); const unsigned kgo = (unsigned)(kp_row * 128 + kp_c * 16);
  const int vp_d = wid * 16 + (lane >> 2), vp_c = (lane & 3) ^ ((vp_d >> 2) & 3); const unsigned vgo = (unsigned)(vp_d * 64 + vp_c * 16);
#define DMA8(slot, t) do { \
    __builtin_amdgcn_global_load_lds((const unsigned*)(K8h + (size_t)(t) * 8192 + kgo), (LAS unsigned*)(ldsl + (slot) * F8_KT + wid * 1024), 16, 0, 0); \
    __builtin_amdgcn_global_load_lds((const unsigned*)(Vt8h + (size_t)(t) * 8192 + vgo), (LAS unsigned*)(ldsl + (3 + (slot)) * F8_KT + wid * 1024), 16, 0, 0); } while (0)
#define TBAR() do { if (cvx.on()) asm volatile("s_waitcnt vmcnt(1) lgkmcnt(0)" ::: "memory"); else asm volatile("s_waitcnt vmcnt(0) lgkmcnt(0)" ::: "memory"); \
    __builtin_amdgcn_s_barrier(); asm volatile("" ::: "memory"); } while (0)
#define RESC8(a) do { if (__any((a) < 1.f)) { const int ln_ = lane_now(), r32_ = ln_ & 31, hi_ = ln_ >> 5; float* al2_ = (float*)(lds + F8_SCR) + wid * 64; \
    if (hi_ == 0) al2_[r32_] = (a); asm volatile("s_waitcnt lgkmcnt(0)" ::: "memory"); \
    for (int r = 0; r < 16; ++r) { const float f_ = al2_[crow(r, hi_)]; for (int d = 0; d < 4; ++d) o[d][r] *= f_; lacc[r] *= f_; } } } while (0)
  f32x16 pA0, pA1, pB0, pB1; float alA, alB; i32x8 pa; const int NT = seq / KVBLK;
  i32x8 ones = {(int)0x08208208, (int)0x82082082, (int)0x20820820, (int)0x08208208, (int)0x82082082, (int)0x20820820, 0, 0};
  asm volatile("" : "+v"(ones));
  DMA8(0, 0); DMA8(1, 1);
  cvx.step(0, 0);
  asm volatile("s_waitcnt vmcnt(0)" ::: "memory"); __builtin_amdgcn_s_barrier(); asm volatile("" ::: "memory");
  f32x16 negm = {};
  qkt8<false>(pA0, pA1, K_lds, qf, ka, negm); partial8(pA0, pA1, m_reg, alA);
  { const float nm = 4.0f - m_reg; for (int r = 0; r < 16; ++r) negm[r] = nm; }
  int ks = 1, vs = 0, wsl = 2;
#define RING_NEXT() do { ks = (ks == 2) ? 0 : ks + 1; vs = (vs == 2) ? 0 : vs + 1; wsl = (wsl == 2) ? 0 : wsl + 1; } while (0)
  for (int j = 1; j + 1 < NT; j += 2) {
    TBAR(); DMA8(wsl, j + 1);
    cvx.step(j, 2);
    SBAR(); qkt8<true>(pB0, pB1, K_lds + ks * F8_KT, qf, ka, negm);
    finish8(pA0, pA1, pa); SBAR();
    pv8(o, lacc, V_lds + vs * F8_KT, pa, va, ones); partial8r(pB0, pB1, m_reg, alB, negm);
    RESC8(alB); RING_NEXT();
    TBAR(); const bool more = j + 2 < NT; if (more) DMA8(wsl, j + 2);
    cvx.step(j + 1, more ? 2 : 0);
    SBAR(); qkt8<true>(pA0, pA1, K_lds + ks * F8_KT, qf, ka, negm);
    finish8(pB0, pB1, pa); SBAR();
    pv8(o, lacc, V_lds + vs * F8_KT, pa, va, ones); partial8r(pA0, pA1, m_reg, alA, negm);
    RESC8(alA); RING_NEXT();
  }
  TBAR();
  cvx.step(NT - 1, 0);
  SBAR(); qkt8<true>(pB0, pB1, K_lds + ks * F8_KT, qf, ka, negm);
  finish8(pA0, pA1, pa); SBAR();
  pv8(o, lacc, V_lds + vs * F8_KT, pa, va, ones); partial8r(pB0, pB1, m_reg, alB, negm);
  RESC8(alB); RING_NEXT();
  finish8(pB0, pB1, pa); SBAR();
  pv8(o, lacc, V_lds + vs * F8_KT, pa, va, ones);
#undef RING_NEXT
  cvx.end();
  const int le_ = lane_now();
  unsigned char* Ow = Ob + (long)(wid * QBLK) * LDO; const unsigned lane_off = (unsigned)(4 * (le_ >> 5) * LDO + (le_ & 31));
#pragma unroll
  for (int r = 0; r < 16; ++r) { unsigned char* rowb = Ow + ((r & 3) + 8 * (r >> 2)) * LDO; const float rl = __builtin_amdgcn_rcpf(lacc[r]) * F8_YMUL;
#pragma unroll
    for (int d0 = 0; d0 < 4; ++d0) { const float v = o[d0][r] * rl; rowb[lane_off + d0 * 32] = (unsigned char)(__builtin_amdgcn_cvt_pk_fp8_f32(v, v, 0, false) & 0xff); } }
#undef DMA8
#undef TBAR
#undef RESC8
}
}

#define XB_TMO      128
#define XB_XCNT(j)  (256  + 64 * (j))
#define XB_XSUB(j)  (1280 + 64 * (j))
#define XB_XGEN(j)  (2304 + 64 * (j))
#define XB_TOP      3328
#define XB_TOPGEN   3392
#define XCD_BAR_WORDS 3456
#define XB_SPIN_CAP (1u << 18)
__device__ __forceinline__ unsigned xb_ld(unsigned* p)              { return __hip_atomic_load(p, __ATOMIC_RELAXED, __HIP_MEMORY_SCOPE_AGENT); }
__device__ __forceinline__ unsigned xb_add(unsigned* p, unsigned v) { return __hip_atomic_fetch_add(p, v, __ATOMIC_RELAXED, __HIP_MEMORY_SCOPE_AGENT); }
__device__ __forceinline__ unsigned xb_xcc_id() { return (unsigned)__builtin_amdgcn_s_getreg((3 << 11) | 20) & 0xFu; }
#define XB_SPIN(cond, bar) do { unsigned _sp = 0; while (cond) { __builtin_amdgcn_s_sleep(1); \
    if ((++_sp & 255u) == 0u) { if (xb_ld(&(bar)[XB_TMO])) break; if (_sp > XB_SPIN_CAP) { atomicAdd(&(bar)[XB_TMO], 1u); break; } } } } while (0)
struct XcdBarrier { unsigned* bar; unsigned x; volatile LAS unsigned* st; };
__device__ __forceinline__ XcdBarrier xcd_barrier_post(unsigned* bar, volatile LAS unsigned* st, const bool t0) {
    XcdBarrier b; b.bar = bar; b.x = xb_xcc_id(); b.st = st;
    if (t0) (void)xb_add(&bar[XB_XCNT(b.x)], 1u);
    return b;
}
__device__ __forceinline__ void xcd_barrier_complete(unsigned* bar, unsigned x, unsigned& nloc, unsigned& nx) {
    const unsigned G = gridDim.x * gridDim.y * gridDim.z;
    unsigned sum, cnt, mine, sp = 0u;
    for (;;) {
        sum = 0u; cnt = 0u; mine = 0u;
#pragma unroll
        for (unsigned j = 0; j < 16; ++j) { const unsigned c = xb_ld(&bar[XB_XCNT(j)]); sum += c; cnt += (c > 0u) ? 1u : 0u; mine = (j == x) ? c : mine; }
        if (sum == G) break;
        __builtin_amdgcn_s_sleep(1);
        if ((++sp & 255u) == 0u) { if (xb_ld(&bar[XB_TMO])) break; if (sp > XB_SPIN_CAP) { atomicAdd(&bar[XB_TMO], 1u); break; } }
    }
    nloc = mine > 0u ? mine : 1u; nx = cnt > 0u ? cnt : 1u;
}
__device__ __forceinline__ void xcd_barrier(const XcdBarrier& b, const bool t0) {
    asm volatile("s_waitcnt vmcnt(0)" ::: "memory");
    __syncthreads();
    if (t0) {
        unsigned* bar = b.bar;
        __builtin_amdgcn_s_waitcnt(0);
        unsigned nloc = b.st[0], nx = b.st[1];
        if (nloc == 0u) { xcd_barrier_complete(bar, b.x, nloc, nx); b.st[0] = nloc; b.st[1] = nx; }
        const unsigned old = xb_add(&bar[XB_XSUB(b.x)], 1u);
        const unsigned gen = old / nloc;
        if (old + 1u == (gen + 1u) * nloc) {
            __builtin_amdgcn_fence(__ATOMIC_RELEASE, "agent");
            asm volatile("s_waitcnt vmcnt(0)" ::: "memory");
            const unsigned og = xb_add(&bar[XB_TOP], 1u);
            const unsigned tg = og / nx;
            if (og + 1u == (tg + 1u) * nx) xb_add(&bar[XB_TOPGEN], 1u);
            else XB_SPIN(xb_ld(&bar[XB_TOPGEN]) == tg, bar);
            __builtin_amdgcn_fence(__ATOMIC_ACQUIRE, "agent");
            xb_add(&bar[XB_XGEN(b.x)], 1u);
            asm volatile("s_waitcnt vmcnt(0)" ::: "memory");
        } else {
            XB_SPIN(xb_ld(&bar[XB_XGEN(b.x)]) == gen, bar);
            __builtin_amdgcn_fence(__ATOMIC_ACQUIRE, "agent");
            asm volatile("s_waitcnt vmcnt(0)" ::: "memory");
        }
    }
    __syncthreads();
}

struct Frame {
    LAS unsigned char* lds;
    volatile LAS unsigned* MISC;
    gu32* ctl;
    int tid, lane, wave, G, bx;
    float* out; unsigned char* ws;
};
__device__ __forceinline__ const float* inp(int k) {
    const __attribute__((address_space(4))) char* kp = (const __attribute__((address_space(4))) char*)__builtin_amdgcn_kernarg_segment_ptr();
    asm volatile("" : "+s"(kp));
    return *(const float* const __attribute__((address_space(4)))*)(kp + 8 * k);
}
__device__ __forceinline__ float wave_sum(float v) {
#pragma unroll
    for (int o = 1; o < 64; o <<= 1) v += __shfl_xor(v, o);
    return v;
}
__device__ __forceinline__ unsigned f2bf(float f) { unsigned u = __builtin_bit_cast(unsigned, f); return (u + 0x7fffu + ((u >> 16) & 1u)) >> 16; }
__device__ __forceinline__ unsigned pk2(float lo, float hi) { return f2bf(lo) | (f2bf(hi) << 16); }

__device__ __forceinline__ void tr_item(const float* W, int N, bf16_t* WT, int K, int k0, int n0, size_t dst_row0, LAS float* scr, int lane) {
#pragma unroll
    for (int i = 0; i < 32; ++i) { const int kk = 2 * i + (lane >> 5); scr[kk * 33 + (lane & 31)] = W[(size_t)(k0 + kk) * N + n0 + (lane & 31)]; }
    LDS_WAIT(); asm volatile("" ::: "memory");
    const int c = lane & 7;
#pragma unroll
    for (int j = 0; j < 4; ++j) { const int n = (lane >> 3) + 8 * j; const LAS float* s = scr + (8 * c) * 33 + n;
        u32x4 o; o.x = pk2(s[0 * 33], s[1 * 33]); o.y = pk2(s[2 * 33], s[3 * 33]); o.z = pk2(s[4 * 33], s[5 * 33]); o.w = pk2(s[6 * 33], s[7 * 33]);
        *(GAS u32x4*)(WT + (dst_row0 + n) * K + k0 + 8 * c) = o; }
    LDS_WAIT(); asm volatile("" ::: "memory");
}
template <bool KG> __device__ __forceinline__ void tr_item_f8(const float* W, int N, unsigned char* WT, int K, int k0, int n0, size_t dst_row0, LAS float* scr, int lane, const float* kg = nullptr) {
#pragma unroll
    for (int i = 0; i < 32; ++i) { const int kk = 2 * i + (lane >> 5); scr[kk * 33 + (lane & 31)] = W[(size_t)(k0 + kk) * N + n0 + (lane & 31)]; }
    LDS_WAIT(); asm volatile("" ::: "memory");
    const int c = lane & 7;
    f32x4 m0 = {F8_WMUL, F8_WMUL, F8_WMUL, F8_WMUL}, m1 = m0;
    if (KG) { m0 = *(const f32x4*)(kg + k0 + 8 * c) * F8_WMUL; m1 = *(const f32x4*)(kg + k0 + 8 * c + 4) * F8_WMUL; }
#pragma unroll
    for (int j = 0; j < 4; ++j) { const int n = (lane >> 3) + 8 * j; const LAS float* s = scr + (8 * c) * 33 + n;
        u32x2 o; o.x = pk4_fp8(s[0 * 33] * m0.x, s[1 * 33] * m0.y, s[2 * 33] * m0.z, s[3 * 33] * m0.w); o.y = pk4_fp8(s[4 * 33] * m1.x, s[5 * 33] * m1.y, s[6 * 33] * m1.z, s[7 * 33] * m1.w);
        *(GAS u32x2*)(WT + (dst_row0 + n) * K + k0 + 8 * c) = o; }
    LDS_WAIT(); asm volatile("" ::: "memory");
}
__device__ __forceinline__ void rms_row_to_fp8(int lane, const float* xrow, const float* g, unsigned char* orow) {
    const GAS f32x4* xr = (const GAS f32x4*)xrow + lane; const GAS f32x4* gr = (const GAS f32x4*)g + lane;
    f32x4 v[8]; float s = 0.f;
#pragma unroll
    for (int j = 0; j < 8; ++j) { v[j] = xr[64 * j]; s += (v[j].x * v[j].x + v[j].y * v[j].y) + (v[j].z * v[j].z + v[j].w * v[j].w); }
    const float rstd = 1.0f / sqrtf(wave_sum(s) * (1.f / D) + EPS);
    GAS unsigned* o8 = (GAS unsigned*)orow + lane;
#pragma unroll
    for (int j = 0; j < 8; ++j) { const f32x4 gg = gr[64 * j]; o8[64 * j] = pk4_fp8(v[j].x * rstd * gg.x, v[j].y * rstd * gg.y, v[j].z * rstd * gg.z, v[j].w * rstd * gg.w); }
}
__device__ __forceinline__ void sincos_d(double a, float& c, float& s) {
    const double TWO_OVER_PI = 0.63661977236758134308, PIO2_HI = 1.57079632679489655800e+00, PIO2_LO = 6.12323399573676603587e-17;
    const double q = __builtin_rint(a * TWO_OVER_PI); const double r = (a - q * PIO2_HI) - q * PIO2_LO; const int n = (int)q & 3;
    const double r2 = r * r;
    double sp = -1.0 / 1307674368000.0; sp = sp * r2 + 1.0 / 6227020800.0; sp = sp * r2 - 1.0 / 39916800.0; sp = sp * r2 + 1.0 / 362880.0; sp = sp * r2 - 1.0 / 5040.0; sp = sp * r2 + 1.0 / 120.0; sp = sp * r2 - 1.0 / 6.0; sp = sp * r2 + 1.0;
    const double sn = sp * r;
    double cp = 1.0 / 20922789888000.0; cp = cp * r2 - 1.0 / 87178291200.0; cp = cp * r2 + 1.0 / 479001600.0; cp = cp * r2 - 1.0 / 3628800.0; cp = cp * r2 + 1.0 / 40320.0; cp = cp * r2 - 1.0 / 720.0; cp = cp * r2 + 1.0 / 24.0; cp = cp * r2 - 0.5; cp = cp * r2 + 1.0;
    const double cs = cp;
    double so, co;
    if (n == 0) { so = sn; co = cs; } else if (n == 1) { so = cs; co = -sn; } else if (n == 2) { so = -sn; co = -cs; } else { so = -cs; co = sn; }
    c = (float)co; s = (float)so;
}
__device__ __forceinline__ double inv_freq_d(int f) {
    const double t[32] = {1.0, 0.7498942093324559, 0.5623413251903491, 0.4216965034285822, 0.31622776601683794, 0.23713737056616552, 0.1778279410038923, 0.1333521432163324, 0.09999999999999999, 0.07498942093324558, 0.056234132519034905, 0.042169650342858224, 0.03162277660168379, 0.023713737056616554, 0.01778279410038923, 0.013335214321633239, 0.01, 0.007498942093324559, 0.005623413251903491, 0.004216965034285822, 0.0031622776601683794, 0.002371373705661655, 0.0017782794100389228, 0.0013335214321633238, 0.001, 0.0007498942093324559, 0.000562341325190349, 0.00042169650342858224, 0.00031622776601683794, 0.00023713737056616554, 0.0001778279410038923, 0.0001333521432163324};
    double r = t[0];
#pragma unroll
    for (int i = 1; i < 32; ++i) r = (f == i) ? t[i] : r;
    return r;
}

struct P0Item { const float* src; unsigned char* dst; const float* kg; int N, K, k0, n0; size_t drow0; };
__device__ __forceinline__ void p0_decode(int it, unsigned char* ws, P0Item& d) {
    constexpr int I_IN = 32 * 272, I_PA = 16 * 64, I_OUT = 32 * 64, I_EX = NE * 32 * 64;
    int r = it; d.kg = nullptr;
    if (r < I_IN) { const int kb = r / 272, nb = r % 272; d.src = inp(2); d.N = NCOLS; d.dst = ws + WS_WIN; d.K = D; d.k0 = 64 * kb; d.n0 = 32 * nb; d.drow0 = (size_t)32 * nb; return; } r -= I_IN;
    if (r < I_PA) { const int kb = r / 64, nb = r % 64; d.src = inp(8); d.N = D; d.dst = ws + WS_WPA; d.K = 1024; d.k0 = 64 * kb; d.n0 = 32 * nb; d.drow0 = (size_t)32 * nb; return; } r -= I_PA;
    if (r < I_PA) { const int kb = r / 64, nb = r % 64; d.src = inp(9); d.N = D; d.dst = ws + WS_WPB; d.K = 1024; d.k0 = 64 * kb; d.n0 = 32 * nb; d.drow0 = (size_t)32 * nb; return; } r -= I_PA;
    if (r < I_OUT) { const int kb = r / 64, nb = r % 64; d.src = inp(10); d.N = D; d.dst = ws + WS_WOUT; d.K = D; d.k0 = 64 * kb; d.n0 = 32 * nb; d.drow0 = (size_t)32 * nb; return; } r -= I_OUT;
    const int which = r / I_EX; r -= which * I_EX; const int e = r / 2048, rr = r % 2048, kb = rr / 64, nb = rr % 64, n0 = 32 * nb;
    d.k0 = 64 * kb; d.n0 = n0;
    if (which == 0) { d.src = inp(14) + (size_t)e * D * DE; d.N = DE; d.dst = ws + WS_WGU + (size_t)e * 4096 * D; d.K = D; d.drow0 = (size_t)((n0 >> 7) * 256 + (n0 & 127)); d.kg = inp(11); }
    else if (which == 1) { d.src = inp(16) + (size_t)e * D * DE; d.N = DE; d.dst = ws + WS_WGU + (size_t)e * 4096 * D; d.K = D; d.drow0 = (size_t)((n0 >> 7) * 256 + 128 + (n0 & 127)); d.kg = inp(11); }
    else { d.src = inp(18) + (size_t)e * DE * D; d.N = D; d.dst = ws + WS_WD + (size_t)e * 2048 * DE; d.K = DE; d.drow0 = (size_t)n0; }
}
__device__ __forceinline__ void p0_load(const P0Item& d, float (&v)[32], int lane) {
    const float* p = d.src + (size_t)(d.k0 + (lane >> 5)) * d.N + d.n0 + (lane & 31);
#pragma unroll
    for (int i = 0; i < 32; ++i) v[i] = p[(size_t)(2 * i) * d.N];
}
__device__ __forceinline__ void p0_finish(const P0Item& d, const float (&v)[32], LAS float* scr, int lane) {
#pragma unroll
    for (int i = 0; i < 32; ++i) scr[(2 * i + (lane >> 5)) * 33 + (lane & 31)] = v[i];
    LDS_WAIT(); asm volatile("" ::: "memory");
    const int c = lane & 7;
    f32x4 m0 = {F8_WMUL, F8_WMUL, F8_WMUL, F8_WMUL}, m1 = m0;
    if (d.kg) { m0 = *(const f32x4*)(d.kg + d.k0 + 8 * c) * F8_WMUL; m1 = *(const f32x4*)(d.kg + d.k0 + 8 * c + 4) * F8_WMUL; }
#pragma unroll
    for (int j = 0; j < 4; ++j) { const int n = (lane >> 3) + 8 * j; const LAS float* s = scr + (8 * c) * 33 + n;
        u32x2 o; o.x = pk4_fp8(s[0 * 33] * m0.x, s[1 * 33] * m0.y, s[2 * 33] * m0.z, s[3 * 33] * m0.w); o.y = pk4_fp8(s[4 * 33] * m1.x, s[5 * 33] * m1.y, s[6 * 33] * m1.z, s[7 * 33] * m1.w);
        *(GAS u32x2*)(d.dst + (d.drow0 + n) * d.K + d.k0 + 8 * c) = o; }
    LDS_WAIT(); asm volatile("" ::: "memory");
}
constexpr int P0_I_FIRST = 32 * 272 + 2 * 16 * 64 + 32 * 64, P0_I_ALL = P0_I_FIRST + 3 * NE * 32 * 64;
struct ConvW {
    static constexpr bool ON = true;
    const float* src0; unsigned char* dst0; size_t sstride, dstride; int N, K, k0; size_t drow0; bool kgf, act;
    LAS float* scr; const LAS float* gl;
    __device__ __forceinline__ void init(unsigned char* ws, int unit, int slot) {
        P0Item d; p0_decode(P0_I_FIRST + (unit * 32) * 2048 + slot, ws, d);
        src0 = d.src + (size_t)d.k0 * d.N + d.n0; dst0 = d.dst; N = d.N; K = d.K; k0 = d.k0; drow0 = d.drow0; kgf = d.kg != nullptr;
        sstride = (size_t)D * DE; dstride = (unit < 2) ? (size_t)4096 * D : (size_t)2048 * DE;
    }
    __device__ __forceinline__ bool on() const { return act; }
    __device__ __forceinline__ void finish(int q) {
        const int lane = lane_now(), c = lane & 7;
        f32x4 m0 = {F8_WMUL, F8_WMUL, F8_WMUL, F8_WMUL}, m1 = m0;
        if (kgf) { m0 = *(const LAS f32x4*)(gl + k0 + 8 * c) * F8_WMUL; m1 = *(const LAS f32x4*)(gl + k0 + 8 * c + 4) * F8_WMUL; }
        unsigned char* dq = dst0 + (size_t)q * dstride;
#pragma unroll
        for (int j = 0; j < 4; ++j) { const int n = (lane >> 3) + 8 * j; const LAS float* s = scr + c * 256 + ((((n >> 2) + c) & 7) << 2) + (n & 3);
            u32x2 o; o.x = pk4_fp8(s[0 * 32] * m0.x, s[1 * 32] * m0.y, s[2 * 32] * m0.z, s[3 * 32] * m0.w); o.y = pk4_fp8(s[4 * 32] * m1.x, s[5 * 32] * m1.y, s[6 * 32] * m1.z, s[7 * 32] * m1.w);
            __builtin_nontemporal_store(o, (GAS u32x2*)(dq + (drow0 + n) * K + k0 + 8 * c)); }
    }
    __device__ __forceinline__ void step(int c, int newer) {
        if (!act) return;
        if ((c & 7) == 0 && c > 0) { if (newer == 2) asm volatile("s_waitcnt vmcnt(2)" ::: "memory"); else asm volatile("s_waitcnt vmcnt(0)" ::: "memory");
            finish((c >> 3) - 1); }
        const int lane = lane_now(), sblk = c & 7;
        const float* src = src0 + (size_t)(c >> 3) * sstride + (size_t)(8 * sblk + (lane >> 3)) * N + 4 * (((lane & 7) - sblk) & 7);
        __builtin_amdgcn_global_load_lds((const unsigned*)src, (LAS unsigned*)(scr + sblk * 256), 16, 0, 2);
    }
    __device__ __forceinline__ void end() { if (!act) return; asm volatile("s_waitcnt vmcnt(0)" ::: "memory"); finish(31); }
};
__device__ __forceinline__ void p0_prologue(Frame& F) {
    LAS float* scr = (LAS float*)(F.lds + RING_OFF + F.wave * 16384);
    const int gw = F.bx * NWAVES + F.wave, NGW = F.G * NWAVES;
    unsigned char* ws = F.ws;
    const int NITEMS = (F.G == 256) ? P0_I_FIRST : P0_I_ALL;
    { P0Item A, B; float va[32], vb[32]; int it = gw;
      if (it < NITEMS) { p0_decode(it, ws, A); p0_load(A, va, F.lane);
        for (;;) {
            const bool hb = it + NGW < NITEMS; if (hb) { p0_decode(it + NGW, ws, B); p0_load(B, vb, F.lane); }
            p0_finish(A, va, scr, F.lane); if (!hb) break;
            it += 2 * NGW; const bool ha = it < NITEMS; if (ha) { p0_decode(it, ws, A); p0_load(A, va, F.lane); }
            p0_finish(B, vb, scr, F.lane); if (!ha) break;
        } } }
    for (int m = gw; m < NTOK; m += NGW) rms_row_to_fp8(F.lane, inp(0) + (size_t)m * D, inp(1), (unsigned char*)(ws + WS_H) + (size_t)m * D);
    { float* tab = (float*)(ws + WS_TAB); const int gid = F.bx * 512 + F.tid;
      if (gid < 320 * 32) { const int pos = gid >> 5, f = gid & 31; const int p = pos < 256 ? pos : pos - 256; float c, s; sincos_d((double)p * inv_freq_d(f), c, s);
        if (pos < 256) { tab[pos * 32 + f] = c; tab[8192 + pos * 32 + f] = s; } else { tab[16384 + p * 32 + f] = c; tab[16384 + 2048 + p * 32 + f] = s; } } }
}

__device__ __forceinline__ void p2_qknorm(Frame& F) {
    const float* tab = (const float*)(F.ws + WS_TAB);
    const int l16 = F.lane & 15, g4 = F.lane >> 4, gw = F.bx * NWAVES + F.wave, NGW = F.G * NWAVES;
    constexpr int R_QA = 2 * 8 * SEQ, R_KA = 2 * 2 * SEQ, NCH = (R_QA + R_KA) / 16;
    const int axis = l16 >> 3, half = (l16 >> 2) & 1;
    const int cch = gw, cstep = NGW, cend = NCH;
    u32x2 w[4];
#define P2_LOAD(dst, chx) do { int r_ = (chx) * 16; const unsigned char* b_ = F.ws + WS_QA; if (r_ >= R_QA) { r_ -= R_QA; b_ = F.ws + WS_KA; } \
        _Pragma("unroll") for (int k = 0; k < 4; ++k) dst[k] = *(const u32x2*)(b_ + (size_t)(r_ + 4 * k + g4) * HD + 8 * l16); } while (0)
    if (cch < cend) P2_LOAD(w, cch);
    for (int ch = cch; ch < cend; ch += cstep) {
        int r0 = ch * 16; const float* g; unsigned char* o8; float omul = 1.0f;
        if (r0 < R_QA) { g = inp(3); o8 = F.ws + WS_Q8; omul = att::QMUL; }
        else { r0 -= R_QA; g = inp(4); o8 = F.ws + WS_K8; omul = att::KMUL; }
        u32x2 wn[4];
#pragma unroll
        for (int k = 0; k < 4; ++k) wn[k] = w[k];
        if (ch + cstep < cend) P2_LOAD(wn, ch + cstep);
        const f32x4 g0 = *(const f32x4*)(g + 8 * l16), g1 = *(const f32x4*)(g + 8 * l16 + 4);
#pragma unroll
        for (int k = 0; k < 4; ++k) {
            const int row = r0 + 4 * k + g4;
            float x[8] = {F8D(w[k].x, 0), F8D(w[k].x, 1), F8D(w[k].x, 2), F8D(w[k].x, 3), F8D(w[k].y, 0), F8D(w[k].y, 1), F8D(w[k].y, 2), F8D(w[k].y, 3)};
            float ss = 0.f;
#pragma unroll
            for (int i = 0; i < 8; ++i) ss += x[i] * x[i];
            ss += __shfl_xor(ss, 1); ss += __shfl_xor(ss, 2); ss += __shfl_xor(ss, 4); ss += __shfl_xor(ss, 8);
            const float rstd = 1.0f / sqrtf(ss * (1.f / 128.f) + EPS);
#pragma unroll
            for (int i = 0; i < 4; ++i) { x[i] = x[i] * rstd * g0[i]; x[4 + i] = x[4 + i] * rstd * g1[i]; }
            const int sq = row & (SEQ - 1), pos = axis ? (sq & 63) : (sq >> 6);
            const float* ct = tab + (axis ? 16384 : 0) + pos * 32 + 8 * (l16 & 3); const float* st = ct + (axis ? 2048 : 8192);
            const f32x4 c0 = *(const f32x4*)ct, c1 = *(const f32x4*)(ct + 4), s0 = *(const f32x4*)st, s1 = *(const f32x4*)(st + 4);
            float y[8];
#pragma unroll
            for (int i = 0; i < 8; ++i) { const float pr = __shfl_xor(x[i], 4); const float cc = i < 4 ? c0[i & 3] : c1[i & 3], sn = i < 4 ? s0[i & 3] : s1[i & 3];
                y[i] = half ? (x[i] * cc + pr * sn) : (x[i] * cc - pr * sn); }
            unsigned c6[8];
#pragma unroll
            for (int i = 0; i < 8; ++i) c6[i] = f6_e2m3(y[i] * omul);
            const unsigned lo = c6[0] | (c6[1] << 6) | (c6[2] << 12) | (c6[3] << 18) | (c6[4] << 24) | (c6[5] << 30), hi16 = (c6[5] >> 2) | (c6[6] << 4) | (c6[7] << 10);
            const unsigned plo = (unsigned)__builtin_amdgcn_update_dpp(0, (int)lo, 0xB1, 0xf, 0xf, false), phi = (unsigned)__builtin_amdgcn_update_dpp(0, (int)hi16, 0xB1, 0xf, 0xf, false);
            if (!(l16 & 1)) { unsigned* dst = (unsigned*)(o8 + (size_t)row * HD + (l16 >> 2) * 32 + ((l16 & 3) >> 1) * 12);
                dst[0] = lo; dst[1] = hi16 | (plo << 16); dst[2] = (plo >> 16) | (phi << 16); }
        }
#pragma unroll
        for (int k = 0; k < 4; ++k) w[k] = wn[k];
    }
#undef P2_LOAD
    LAS unsigned char* vt = F.lds + RING_OFF + F.wave * 16384;
    for (int T = gw; T < 2 * 2 * (SEQ / 64); T += NGW) {
        const unsigned char* vsrc = F.ws + WS_VA + ((size_t)T * 64 + F.lane) * HD;
#pragma unroll
        for (int c = 0; c < 16; ++c) { const u32x2 w = *(const u32x2*)(vsrc + 8 * c);
            u32x2 q;
            q.x = f6_e2m3(F8D(w.x, 0) * att::VMUL) | (f6_e2m3(F8D(w.x, 1) * att::VMUL) << 8) | (f6_e2m3(F8D(w.x, 2) * att::VMUL) << 16) | (f6_e2m3(F8D(w.x, 3) * att::VMUL) << 24);
            q.y = f6_e2m3(F8D(w.y, 0) * att::VMUL) | (f6_e2m3(F8D(w.y, 1) * att::VMUL) << 8) | (f6_e2m3(F8D(w.y, 2) * att::VMUL) << 16) | (f6_e2m3(F8D(w.y, 3) * att::VMUL) << 24);
            *(LAS u32x2*)(vt + F.lane * 144 + 8 * c) = q; }
        LDS_WAIT(); asm volatile("" ::: "memory");
#pragma unroll
        for (int dd = 0; dd < 2; ++dd) { const int d = F.lane + 64 * dd;
            unsigned char* dst = F.ws + WS_VT8 + (size_t)T * 8192 + (size_t)d * 64;
#pragma unroll
            for (int hh = 0; hh < 2; ++hh) { unsigned wv[6] = {0u, 0u, 0u, 0u, 0u, 0u};
#pragma unroll
                for (int j = 0; j < 32; ++j) { const int key = (j < 16) ? att::crow(j, hh) : 32 + att::crow(j - 16, hh); const unsigned code = vt[key * 144 + d];
                    const int fld = (j < 16) ? 2 * j : 2 * (j - 16) + 1;
                    const int bit = 6 * fld, wi = bit >> 5, sh = bit & 31; wv[wi] |= code << sh; if (sh > 26) wv[wi + 1] |= code >> (32 - sh); }
                *(u32x4*)(dst + 32 * hh) = (u32x4){wv[0], wv[1], wv[2], wv[3]}; *(u32x2*)(dst + 32 * hh + 16) = (u32x2){wv[4], wv[5]}; } }
        LDS_WAIT(); asm volatile("" ::: "memory");
    }
}

__device__ __forceinline__ void p3_attention(Frame& F, char* lds) {
    unsigned char* ya = (unsigned char*)(F.ws + WS_YA); unsigned char* yb = (unsigned char*)(F.ws + WS_YB);
    { const int tl = F.wave * 64 + lane_now(); *(LAS f32x4*)(F.lds + RING_OFF + 116736 + tl * 16) = *(const f32x4*)(inp(11) + tl * 4); }
    for (int i = 0; ; ++i) {
        int b, h, qb;
        if (F.G == 256) { if (i >= 4) break; const int x = F.bx & 7, combo = x & 3, cu = (x >> 2) * 32 + (F.bx >> 3); b = combo >> 1; h = (combo & 1) * 4 + i; qb = cu; }
        else { const int u = F.bx + i * F.G; if (u >= 1024) break; b = u >> 9; h = (u >> 6) & 7; qb = u & 63; }
        const size_t t0 = (size_t)b * SEQ;
        __syncthreads();
        ConvW cvx; cvx.scr = (LAS float*)(F.lds + RING_OFF + 51200 + F.wave * 8192); cvx.gl = (const LAS float*)(F.lds + RING_OFF + 116736);
        cvx.act = (F.G == 256) && (i < 3); cvx.init(F.ws, i < 3 ? i : 0, F.bx * NWAVES + F.wave);
        att::attn_body_f8<1024, ConvW>(F.ws + WS_Q8 + ((size_t)(b * 8 + h) * SEQ + (size_t)qb * 256) * HD, F.ws + WS_K8 + (size_t)(b * 2 + (h >> 2)) * SEQ * HD,
                                F.ws + WS_VT8 + (size_t)(b * 2 + (h >> 2)) * (SEQ / 64) * 8192, ya + (t0 + (size_t)qb * 256) * 1024 + 128 * h, SEQ, lds, F.lds + RING_OFF, F.wave, cvx);
    }
    float* bias_l = (float*)(lds + att::BIAS_OFF);
    for (int i = 0; ; ++i) {
        const int u = F.bx + i * F.G; if (u >= 1024) break;
        const int b = u >> 9, h = (u >> 6) & 7, rb = u & 63, R0 = rb * 4;
        int kr0 = R0 - 4; kr0 = kr0 < 0 ? 0 : (kr0 > ROWS - 12 ? ROWS - 12 : kr0);
        __syncthreads();
        const int lane = lane_now(), wid = F.wave, tl = wid * 64 + lane;
        if (tl < 15 * 32) { const int ro = tl >> 5, co = tl & 31; bias_l[tl] = co < 31 ? inp(7)[(h * 15 + ro) * 31 + co] * (1.0f / att::SCALE) : 0.f; }
        const size_t t0 = (size_t)b * SEQ;
        const int c = 32 * (wid & 1) + (lane & 31); int cs = c - 8; cs = cs < 0 ? 0 : (cs > GW - 16 ? GW - 16 : cs);
        att::NaMask mk{bias_l, kr0, R0 + (wid >> 1), c, cs, lane >> 5};
        att::attn_body_simple<HD, HD, 1024, att::NaMask>(F.ws + WS_QB + ((size_t)(b * 8 + h) * SEQ + (size_t)R0 * 64) * HD, F.ws + WS_KB + ((size_t)(b * 8 + h) * SEQ + (size_t)kr0 * 64) * HD,
                                                            F.ws + WS_VB + ((size_t)(b * 8 + h) * SEQ + (size_t)kr0 * 64) * HD, yb + (t0 + (size_t)R0 * 64) * 1024 + 128 * h, 12, lds, mk, F.wave, inp(5), inp(6));
    }
}

__device__ __forceinline__ void p6_router(Frame& F) {
    const bf16_t* x1 = (const bf16_t*)(F.ws + WS_X1B); const float* g2 = inp(11); const float* wr = inp(12); const float* br = inp(13);
    unsigned char* h2 = (unsigned char*)(F.ws + WS_H8);
    LAS unsigned char* tile = F.lds + RING_OFF;
    LAS float* part = (LAS float*)(F.lds + PART_OFF);
    LAS unsigned* asg = (LAS unsigned*)(F.lds + ASG_OFF);
    LAS unsigned* hist = (LAS unsigned*)(F.lds + HIST_OFF);
    const int lane = F.lane, w = F.wave, row = lane & 15, kq = lane >> 4;
    if (F.tid < 64) hist[F.tid] = 0u;
    float Breg[16][4][2];
#pragma unroll
    for (int s = 0; s < 16; ++s)
#pragma unroll
        for (int i = 0; i < 4; ++i)
#pragma unroll
            for (int hf = 0; hf < 2; ++hf) { const int k = 256 * w + 16 * s + 4 * kq + i; Breg[s][i][hf] = wr[(size_t)k * NE + row + 16 * hf] * g2[k]; }
    int nasg = 0;
    u32x2 va[8], vb[8];
    const unsigned lofs = (unsigned)lane * 16u;
    { const int ch = F.bx; if (ch < NTOK / 16) { const char* xa = (const char*)(x1 + ((size_t)ch * 16 + 2 * w) * D);
#pragma unroll
        for (int j = 0; j < 8; ++j) { va[j] = *(const u32x2*)(xa + (lofs >> 1) + 512 * j); vb[j] = *(const u32x2*)(xa + 4096 + (lofs >> 1) + 512 * j); } } }
    for (int ch = F.bx; ch < NTOK / 16; ch += F.G) {
        __syncthreads();
#define P6_ROW(vr, tt) do { const int tl = 2 * w + (tt); const size_t tok = (size_t)ch * 16 + tl; float ss = 0.f; f32x4 v[8]; \
            _Pragma("unroll") for (int j = 0; j < 8; ++j) { v[j] = (f32x4){bf_lo(vr[j].x), bf_hi(vr[j].x), bf_lo(vr[j].y), bf_hi(vr[j].y)}; ss += (v[j].x * v[j].x + v[j].y * v[j].y) + (v[j].z * v[j].z + v[j].w * v[j].w); } \
            const float rstd = 1.0f / sqrtf(wave_sum(ss) * (1.f / D) + EPS); unsigned char* o8 = h2 + tok * D; \
            _Pragma("unroll") for (int j = 0; j < 8; ++j) { const f32x4 y = v[j] * rstd;     \
                *(unsigned*)(o8 + (lofs >> 2) + 256 * j) = pk4_fp8(y.x, y.y, y.z, y.w); *(LAS f32x4*)(tile + tl * 8192 + (((lofs >> 4) ^ tl) << 4) + 1024 * j) = y; } } while (0)
        P6_ROW(va, 0); P6_ROW(vb, 1);
#undef P6_ROW
        __syncthreads();
        { const int chn = ch + F.G; if (chn < NTOK / 16) { const char* xa = (const char*)(x1 + ((size_t)chn * 16 + 2 * w) * D);
            const unsigned lo2 = (unsigned)lane_now() * 16u;
#pragma unroll
            for (int j = 0; j < 8; ++j) { va[j] = *(const u32x2*)(xa + (lo2 >> 1) + 512 * j); vb[j] = *(const u32x2*)(xa + 4096 + (lo2 >> 1) + 512 * j); } } }
        f32x4 a0 = {0.f, 0.f, 0.f, 0.f}, a1 = {0.f, 0.f, 0.f, 0.f};
        f32x4 ab[2][2];
        unsigned abase[4];
        { const int ln = lane_now(), rw = ln & 15, kk = ln >> 4;
#pragma unroll
          for (int q = 0; q < 4; ++q) abase[q] = (unsigned)(rw * 8192 + ((64 * w + ((4 * q + kk) ^ rw)) << 4)); }
#define P6_LDA(g) do { _Pragma("unroll") for (int q = 0; q < 2; ++q) { const int s_ = 2 * (g) + q; ab[(g) & 1][q] = *(const LAS f32x4*)(tile + abase[s_ & 3] + (s_ >> 2) * 256); } } while (0)
        P6_LDA(0);
#pragma unroll
        for (int g = 0; g < 8; ++g) {
            if (g < 7) P6_LDA(g + 1);
#pragma unroll
            for (int q = 0; q < 2; ++q)
#pragma unroll
                for (int i = 0; i < 4; ++i) { a0 = __builtin_amdgcn_mfma_f32_16x16x4f32(ab[g & 1][q][i], Breg[2 * g + q][i][0], a0, 0, 0, 0); a1 = __builtin_amdgcn_mfma_f32_16x16x4f32(ab[g & 1][q][i], Breg[2 * g + q][i][1], a1, 0, 0, 0); }
            __builtin_amdgcn_sched_barrier(0);
        }
#undef P6_LDA
#pragma unroll
        for (int j = 0; j < 4; ++j) { part[(w * 16 + 4 * kq + j) * 32 + row] = a0[j]; part[(w * 16 + 4 * kq + j) * 32 + 16 + row] = a1[j]; }
        __syncthreads();
        { const int tl = F.tid >> 5, e = F.tid & 31; float lg = br[e];
#pragma unroll
          for (int ww = 0; ww < 8; ++ww) lg += part[(ww * 16 + tl) * 32 + e];
          float tv[4]; int ti[4]; bool taken = false;
#pragma unroll
          for (int r = 0; r < 4; ++r) { float bv = taken ? -__builtin_inff() : lg; int bi = e;
#define P6_STEP(EXPR_F, EXPR_I) do { const float ov = __int_as_float(EXPR_F); const int oi = (EXPR_I); if (ov > bv || (ov == bv && oi < bi)) { bv = ov; bi = oi; } } while (0)
#define P6_DPP(v, c) __builtin_amdgcn_update_dpp((v), (v), (c), 0xf, 0xf, false)
              P6_STEP(P6_DPP(__float_as_int(bv), 0xB1), P6_DPP(bi, 0xB1));
              P6_STEP(P6_DPP(__float_as_int(bv), 0x4E), P6_DPP(bi, 0x4E));
              P6_STEP(P6_DPP(__float_as_int(bv), 0x141), P6_DPP(bi, 0x141));
              P6_STEP(P6_DPP(__float_as_int(bv), 0x140), P6_DPP(bi, 0x140));
              P6_STEP(__builtin_amdgcn_ds_swizzle(__float_as_int(bv), 0x401F), __builtin_amdgcn_ds_swizzle(bi, 0x401F));
#undef P6_STEP
#undef P6_DPP
              tv[r] = bv; ti[r] = bi; if (bi == e) taken = true; }
          const float e1 = __expf(tv[1] - tv[0]), e2 = __expf(tv[2] - tv[0]), e3 = __expf(tv[3] - tv[0]); const float inv = 1.0f / (1.0f + e1 + e2 + e3);
          if (e < 4) { const float wt = (e == 0 ? 1.0f : e == 1 ? e1 : e == 2 ? e2 : e3) * inv; const int ex = e == 0 ? ti[0] : e == 1 ? ti[1] : e == 2 ? ti[2] : ti[3];
              const int n = nasg * 64 + tl * 4 + e; asg[n * 4 + 0] = (unsigned)(ch * 16 + tl) * 4u + (unsigned)e; asg[n * 4 + 1] = (unsigned)ex; asg[n * 4 + 2] = __float_as_uint(wt); } }
        ++nasg;
        if (nasg == 8) {
            __syncthreads();
            const int tf = F.wave * 64 + lane_now();
            { const unsigned ex = asg[tf * 4 + 1]; asg[tf * 4 + 3] = __hip_atomic_fetch_add((LAS unsigned*)&hist[ex], 1u, __ATOMIC_RELAXED, __HIP_MEMORY_SCOPE_WORKGROUP); }
            __syncthreads();
            if (tf < 32) { const unsigned n = hist[tf]; hist[32 + tf] = n ? __hip_atomic_fetch_add((unsigned*)(F.ctl + CW_CNT + 64 * tf), n, RLX_AGENT) : 0u; }
            __syncthreads();
            { const unsigned tk = asg[tf * 4 + 0], ex = asg[tf * 4 + 1], wb = asg[tf * 4 + 2], pos = hist[32 + ex] + asg[tf * 4 + 3];
              ((int*)(F.ws + WS_LTOK))[(size_t)ex * LCAP + pos] = (int)(tk >> 2); ((unsigned*)(F.ws + WS_LW))[(size_t)ex * LCAP + pos] = wb;
              ((unsigned*)(F.ws + WS_TOKEP))[tk] = (ex << 16) | pos; }
            __syncthreads();
            if (tf < 64) hist[tf] = 0u;
            nasg = 0;
        }
    }
    if (nasg) {
        __syncthreads();
        const int tf = F.wave * 64 + lane_now();
        const bool act = tf < nasg * 64;
        if (act) { const unsigned ex = asg[tf * 4 + 1]; asg[tf * 4 + 3] = __hip_atomic_fetch_add((LAS unsigned*)&hist[ex], 1u, __ATOMIC_RELAXED, __HIP_MEMORY_SCOPE_WORKGROUP); }
        __syncthreads();
        if (tf < 32) { const unsigned n = hist[tf]; hist[32 + tf] = n ? __hip_atomic_fetch_add((unsigned*)(F.ctl + CW_CNT + 64 * tf), n, RLX_AGENT) : 0u; }
        __syncthreads();
        if (act) { const unsigned tk = asg[tf * 4 + 0], ex = asg[tf * 4 + 1], wb = asg[tf * 4 + 2], pos = hist[32 + ex] + asg[tf * 4 + 3];
          ((int*)(F.ws + WS_LTOK))[(size_t)ex * LCAP + pos] = (int)(tk >> 2); ((unsigned*)(F.ws + WS_LW))[(size_t)ex * LCAP + pos] = wb;
          ((unsigned*)(F.ws + WS_TOKEP))[tk] = (ex << 16) | pos; }
        __syncthreads();
    }
}

__device__ __forceinline__ int moe_tables(Frame& F) {
    LAS int* cnt = (LAS int*)(F.lds + TAB_OFF); LAS int* tstart = cnt + 32; LAS unsigned char* tile_e = (LAS unsigned char*)(F.lds + TAB_OFF + 384);
    __syncthreads();
    if (F.tid < 32) cnt[F.tid] = (int)__hip_atomic_load((unsigned*)(F.ctl + CW_CNT + 64 * F.tid), RLX_AGENT);
    __syncthreads();
    if (F.tid == 0) { int s = 0; for (int e = 0; e < NE; ++e) { tstart[e] = s; s += (cnt[e] + 255) >> 8; } tstart[NE] = s; }
    __syncthreads();
    const int TT = tstart[NE];
    for (int t = F.tid; t < TT; t += 512) { int e = 0;
#pragma unroll
        for (int k = 1; k < NE; ++k) e += (tstart[k] <= t) ? 1 : 0;
        tile_e[t] = (unsigned char)e; }
    __syncthreads();
    return TT;
}

#define f8lo(w, b) __builtin_amdgcn_cvt_f32_fp8((int)(w), b)
__device__ __forceinline__ void p9_combine(Frame& F) {
    const LAS int* tstart = (const LAS int*)(F.lds + TAB_OFF) + 32;
    const unsigned char* Y = (const unsigned char*)(F.ws + WS_Y); const unsigned* tokep = (const unsigned*)(F.ws + WS_TOKEP);
    const int gw = F.bx * NWAVES + F.wave, NGW = F.G * NWAVES, lane = F.lane;
    for (int t0 = gw; t0 < NTOK; t0 += 16 * NGW) {
        const int tk = t0 + (lane & 15) * NGW; u32x4 ep = {0u, 0u, 0u, 0u};
        if (tk < NTOK) ep = *(const u32x4*)(tokep + (size_t)tk * 4);
        unsigned so0 = (unsigned)tstart[ep.x >> 16] * 256u + (ep.x & 0xffffu), so1 = (unsigned)tstart[ep.y >> 16] * 256u + (ep.y & 0xffffu);
        unsigned so2 = (unsigned)tstart[ep.z >> 16] * 256u + (ep.z & 0xffffu), so3 = (unsigned)tstart[ep.w >> 16] * 256u + (ep.w & 0xffffu);
#pragma unroll 2
        for (int k = 0; k < 16; ++k) {
            const int t = t0 + k * NGW; if (t >= NTOK) break;
            const size_t s0 = (size_t)__builtin_amdgcn_readlane((int)so0, k), s1 = (size_t)__builtin_amdgcn_readlane((int)so1, k), s2 = (size_t)__builtin_amdgcn_readlane((int)so2, k), s3 = (size_t)__builtin_amdgcn_readlane((int)so3, k);
            float* xo = F.out + (size_t)t * D; const bf16_t* xi = (const bf16_t*)(F.ws + WS_X1B) + (size_t)t * D;
            u32x2 y0[4], y1[4], y2[4], y3[4]; f32x4 a[4], b[4];
#pragma unroll
            for (int j = 0; j < 4; ++j) { const int c = (lane + 64 * j) * 8;
                y0[j] = *(const u32x2*)(Y + s0 * D + c); y1[j] = *(const u32x2*)(Y + s1 * D + c); y2[j] = *(const u32x2*)(Y + s2 * D + c); y3[j] = *(const u32x2*)(Y + s3 * D + c);
                const u32x4 xw = *(const u32x4*)(xi + c); a[j] = (f32x4){bf_lo(xw.x), bf_hi(xw.x), bf_lo(xw.y), bf_hi(xw.y)}; b[j] = (f32x4){bf_lo(xw.z), bf_hi(xw.z), bf_lo(xw.w), bf_hi(xw.w)}; }
#pragma unroll
            for (int j = 0; j < 4; ++j) { const int c = (lane + 64 * j) * 8;
#define Y4(w, i) ((f8lo(y0[j].w, i) + f8lo(y1[j].w, i)) + (f8lo(y2[j].w, i) + f8lo(y3[j].w, i))) * 0.0625f
                a[j].x += Y4(x, 0); a[j].y += Y4(x, 1); a[j].z += Y4(x, 2); a[j].w += Y4(x, 3);
                b[j].x += Y4(y, 0); b[j].y += Y4(y, 1); b[j].z += Y4(y, 2); b[j].w += Y4(y, 3);
#undef Y4
                *(f32x4*)(xo + c) = a[j]; *(f32x4*)(xo + c + 4) = b[j]; }
        }
    }
}

struct Args { const float* in[20]; float* out; unsigned char* ws; int ph_lo, ph_hi, li, pad; };
__global__ void __launch_bounds__(NWAVES * 64, 2) mk_fwd(Args args) {
    extern __shared__ __attribute__((aligned(16))) unsigned char lds[];
    Frame F;
    F.lds = (LAS unsigned char*)lds;
    F.MISC = (volatile LAS unsigned*)(F.lds + MISC_OFF);
    F.tid = threadIdx.x; F.lane = F.tid & 63; F.wave = __builtin_amdgcn_readfirstlane(F.tid >> 6);
    F.G = gridDim.x; F.bx = blockIdx.x;
    F.out = args.out; F.ws = args.ws; F.ctl = (gu32*)(args.ws + WS_CTL);
    for (int u = F.tid; u < (LDS_BYTES - LDSCTL_OFF) / 4; u += NWAVES * 64) ((LAS unsigned*)(F.lds + LDSCTL_OFF))[u] = 0u;
    __syncthreads();
    XcdBarrier bar; bar.bar = (unsigned*)(F.ctl + CW_BAR); bar.x = 0; bar.st = nullptr;
    if (N_LAUNCHES != PER_PHASE) bar = xcd_barrier_post((unsigned*)(F.ctl + CW_BAR), F.MISC + 8, F.tid == 0);
#define GRID_BAR(seam) do { if (N_LAUNCHES == PER_PHASE) { if (F.tid == 0) __hip_atomic_store(F.ctl + CW_TMO, 0xBADBA0u | (unsigned)(seam), RLX_AGENT); } else { xcd_barrier(bar, F.wave == 0 && lane_now() == 0); } } while (0)
    const int lo = args.ph_lo, hi = args.ph_hi;
#ifndef PH_MASK
#define PH_MASK 0x3ff
#endif
#define IN(k) (((PH_MASK >> (k)) & 1) && lo <= (k) && (k) < hi)
#define BOTH(k) (IN(k) && IN((k) + 1))
#define REFRESH() do { F.lane = lane_now(); F.tid = F.wave * 64 + F.lane; } while (0)
    unsigned char* ws = args.ws;

    if (IN(0)) { REFRESH(); p0_prologue(F); if (BOTH(0)) GRID_BAR(0); }

    if (IN(1)) { REFRESH();
        pg8::Gemm g{ws + WS_H, ws + WS_WIN, D, F8_ONE, F8_W}; pg8::StaticOrder S; S.init(NTOK, NCOLS, F.G, F.bx);
        pg8::EpiProj E{ws};
        pg8::gemm_phase<pg8::EpiProj, pg8::StaticOrder, true, true>(F.lds + RING_OFF, g, S, E, F.wave);
        if (BOTH(1)) GRID_BAR(1);
    }
    if (IN(2)) { REFRESH(); p2_qknorm(F); if (BOTH(2)) GRID_BAR(2); }
    if (IN(3)) { REFRESH(); p3_attention(F, (char*)lds + RING_OFF); if (BOTH(3)) GRID_BAR(3); }
    if (IN(4)) { REFRESH();
        { pg8::Gemm g{ws + WS_YA, ws + WS_WPA, 1024, F8_Y, F8_W, (long long)(WS_YB - WS_YA), (long long)(WS_WPB - WS_WPA)}; pg8::StaticOrder S; S.init(NTOK, D, F.G, F.bx);
          pg8::EpiGateDual E{(unsigned char*)(ws + WS_MERGED8), (const unsigned char*)(ws + WS_G)};
          pg8::gemm_phase<pg8::EpiGateDual, pg8::StaticOrder, true, true, true>(F.lds + RING_OFF, g, S, E, F.wave); }
        if (BOTH(4)) GRID_BAR(4);
    }
    if (IN(5)) { REFRESH();
        pg8::Gemm g{ws + WS_MERGED8, ws + WS_WOUT, D, F8_M, F8_W}; pg8::StaticOrder S; S.init(NTOK, D, F.G, F.bx);
        pg8::EpiResidB E{inp(0), (bf16_t*)(ws + WS_X1B), D};
        pg8::gemm_phase<pg8::EpiResidB, pg8::StaticOrder, true, true>(F.lds + RING_OFF, g, S, E, F.wave);
        if (BOTH(5)) GRID_BAR(5);
    }
    if (IN(6)) { REFRESH(); p6_router(F); if (BOTH(6)) GRID_BAR(6); }
    if (IN(7)) { REFRESH();
        const int TT = moe_tables(F);
        const LAS int* cnt = (const LAS int*)(F.lds + TAB_OFF);
        pg8::Gemm g{ws + WS_H8, ws + WS_WGU, D, F8_ONE, F8_W};
        pg8::MoeOrder S{cnt, cnt + 32, (const LAS unsigned char*)(F.lds + TAB_OFF + 384), TT, 16, F.G, F.bx, (const int*)(ws + WS_LTOK), true, (size_t)4096};
        pg8::EpiSwiglu E{(unsigned char*)(ws + WS_ACT), inp(15), inp(17)};
        pg8::gemm_phase<pg8::EpiSwiglu, pg8::MoeOrder, true, true>(F.lds + RING_OFF, g, S, E, F.wave);
        if (BOTH(7)) GRID_BAR(7);
    }
    if (IN(8)) { REFRESH();
        const int TT = moe_tables(F);
        const LAS int* cnt = (const LAS int*)(F.lds + TAB_OFF);
        pg8::Gemm g{ws + WS_ACT, ws + WS_WD, DE, F8_ONE, F8_W};
        pg8::MoeOrder S{cnt, cnt + 32, (const LAS unsigned char*)(F.lds + TAB_OFF + 384), TT, 8, F.G, F.bx, (const int*)(ws + WS_LTOK), false, (size_t)2048};
        pg8::EpiDown E{(unsigned char*)(ws + WS_Y), inp(19), (const float*)(ws + WS_LW), cnt + 32};
        pg8::gemm_phase<pg8::EpiDown, pg8::MoeOrder, true, true>(F.lds + RING_OFF, g, S, E, F.wave);
        if (BOTH(8)) GRID_BAR(8);
    }
    if (IN(9)) { REFRESH(); (void)moe_tables(F); p9_combine(F); }
#undef IN
#undef BOTH
}

extern "C" void kernel_launch(void* const* d_in, const int* in_sizes, int n_in, void* d_out, int out_size, void* d_ws, size_t ws_size, hipStream_t stream) {
    static int grid = 0;
    if (grid == 0) {
        if (n_in != 20 || out_size != NTOK * D || ws_size < WS_END) { fprintf(stderr, "kernel_launch: shape mismatch n_in %d out %d ws %zu (need %zu)\n", n_in, out_size, ws_size, (size_t)WS_END); grid = -1; return; }
        int dev = 0, cus = 0, per_cu = 0;
        if (hipGetDevice(&dev) != hipSuccess || hipDeviceGetAttribute(&cus, hipDeviceAttributeMultiprocessorCount, dev) != hipSuccess) { grid = -1; return; }
        if (hipFuncSetAttribute((const void*)mk_fwd, hipFuncAttributeMaxDynamicSharedMemorySize, LDS_BYTES) != hipSuccess) { fprintf(stderr, "kernel_launch: hipFuncSetAttribute failed\n"); grid = -1; return; }
        if (hipOccupancyMaxActiveBlocksPerMultiprocessor(&per_cu, (const void*)mk_fwd, NWAVES * 64, LDS_BYTES) != hipSuccess || per_cu < 1) fprintf(stderr, "kernel_launch: occupancy query reports %d\n", per_cu);
        (void)hipGetLastError();
        grid = cus < 256 ? cus : 256;
    }
    if (grid < 0) return;
    if (hipMemsetAsync((char*)d_ws + WS_CTL, 0, CTL_ZERO_BYTES, stream) != hipSuccess) return;
    Args a{};
    for (int i = 0; i < 20; ++i) a.in[i] = (const float*)d_in[i];
    a.out = (float*)d_out; a.ws = (unsigned char*)d_ws;
    for (int li = 0; li < N_LAUNCHES; ++li) {
        a.ph_lo = (N_LAUNCHES == PER_PHASE) ? li : 0; a.ph_hi = (N_LAUNCHES == PER_PHASE) ? li + 1 : PER_PHASE; a.li = li; a.pad = 0;
        for (int rep = 0; rep < ((N_LAUNCHES == PER_PHASE && li == DUP_PHASE) ? DUP_TIMES : 1) - 1; ++rep) hipLaunchKernelGGL(mk_fwd, dim3(grid), dim3(NWAVES * 64), LDS_BYTES, stream, a);
        hipLaunchKernelGGL(mk_fwd, dim3(grid), dim3(NWAVES * 64), LDS_BYTES, stream, a);
        const hipError_t le = hipPeekAtLastError();
        if (le != hipSuccess) { fprintf(stderr, "kernel_launch: launch %d failed: %s\n", li, hipGetErrorName(le)); break; }
    }
}
```

```cpp
#include <hip/hip_runtime.h>
#include <cstdio>
#include <cstdint>

#ifndef MK_N_LAUNCHES
#define MK_N_LAUNCHES 1
#endif
#ifndef DUP_PHASE
#define DUP_PHASE -1
#endif
#ifndef DUP_TIMES
#define DUP_TIMES 2
#endif
constexpr int PER_PHASE = 10;
constexpr int N_LAUNCHES = MK_N_LAUNCHES;

#define GAS __attribute__((address_space(1)))
#define LAS __attribute__((address_space(3)))
typedef unsigned short bf16_t;
typedef short bf16x8 __attribute__((ext_vector_type(8)));
typedef short s16x4 __attribute__((ext_vector_type(4)));
typedef float f32x2 __attribute__((ext_vector_type(2)));
typedef float f32x4 __attribute__((ext_vector_type(4)));
typedef float f32x8 __attribute__((ext_vector_type(8)));
typedef float f32x16 __attribute__((ext_vector_type(16)));
typedef unsigned u32x2 __attribute__((ext_vector_type(2)));
typedef unsigned u32x4 __attribute__((ext_vector_type(4)));
typedef int i32x2 __attribute__((ext_vector_type(2)));
typedef int i32x4 __attribute__((ext_vector_type(4)));
typedef int i32x8 __attribute__((ext_vector_type(8)));
typedef GAS unsigned gu32;
constexpr int F8_ONE = 127, F8_W = 121, F8_Y = 121, F8_M = 123;
constexpr float F8_WMUL = 64.0f, F8_YMUL = 64.0f, F8_MMUL = 16.0f;

constexpr int D = 2048, NTOK = 32768, SEQ = 16384, GW = 64, ROWS = 256, HD = 128;
constexpr int NCOLS = 8704;
constexpr int C_QA = 0, C_KA = 1024, C_VA = 1280, C_QB = 1536, C_KB = 2560, C_VB = 3584, C_GA = 4608, C_GB = 6656;
constexpr int NE = 32, DE = 2048, LCAP = 32768;
constexpr int MAXT = 544;
constexpr float EPS = 1e-6f;
constexpr int NWAVES = 8;

constexpr size_t MiB = 1u << 20;
constexpr size_t WS_CTL = 0, CTL_ZERO_BYTES = 1 * MiB;
constexpr size_t WS_TAB = 1 * MiB;
constexpr size_t WS_TOKEP = 1 * MiB + 128 * 1024;
constexpr size_t WS_LTOK = 2 * MiB;
constexpr size_t WS_LW = 6 * MiB;
constexpr size_t WS_WIN = 10 * MiB;
constexpr size_t WS_WPA = 44 * MiB, WS_WPB = 48 * MiB, WS_WOUT = 52 * MiB;
constexpr size_t WS_WD = 64 * MiB;
constexpr size_t WS_WGU = 320 * MiB;
constexpr size_t WS_MERGED = 832 * MiB;
constexpr size_t WS_X1B = 832 * MiB;
constexpr size_t WS_MERGED8 = 1760 * MiB;
constexpr size_t WS_Y = 320 * MiB;
constexpr size_t WS_H = 960 * MiB;
constexpr size_t WS_H8 = 1024 * MiB;
constexpr size_t WS_PROJ = 1088 * MiB;
constexpr size_t WS_QA = WS_PROJ, WS_KA = WS_PROJ + 64 * MiB, WS_VA = WS_PROJ + 80 * MiB, WS_QB = WS_PROJ + 96 * MiB, WS_KB = WS_PROJ + 160 * MiB, WS_VB = WS_PROJ + 224 * MiB, WS_G = WS_PROJ + 288 * MiB;
constexpr size_t WS_ACT = 1088 * MiB;
constexpr size_t WS_YA = 1632 * MiB, WS_YB = 1696 * MiB;
constexpr size_t WS_Q8 = 1824 * MiB;
constexpr size_t WS_K8 = 1856 * MiB;
constexpr size_t WS_VT8 = 1864 * MiB;
constexpr size_t WS_END = 1872 * MiB;
static_assert(WS_Y + (size_t)MAXT * 256 * 2048 * 2 <= WS_H && WS_ACT + (size_t)MAXT * 256 * 2048 * 2 <= WS_YA, "ws map");
static_assert(WS_Y + (size_t)MAXT * 256 * 2048 <= WS_X1B && WS_X1B + (size_t)NTOK * D * 2 <= WS_H, "ws map: fp8 Y below the bf16 residual stream");
constexpr int CW_TMO = 0, CW_CODE = 1;
constexpr int CW_BAR = 4096;
constexpr int CW_CNT = 16384;

constexpr int RING_OFF = 0, RING_BYTES = 131072;
constexpr int PART_OFF = 131072;
constexpr int ASG_OFF = 147456;
constexpr int TAB_OFF = 155648;
constexpr int HIST_OFF = 156672;
constexpr int MISC_OFF = 156928;
constexpr int LDS_BYTES = 157696;
constexpr int LDSCTL_OFF = HIST_OFF;

#define RLX_AGENT __ATOMIC_RELAXED, __HIP_MEMORY_SCOPE_AGENT
#define LDS_WAIT() asm volatile("s_waitcnt lgkmcnt(0)" ::: "memory")
#define VM_WAIT() asm volatile("s_waitcnt vmcnt(0)" ::: "memory")
__device__ __forceinline__ unsigned cvt_pk_bf16(float lo, float hi) { unsigned r; asm volatile("v_cvt_pk_bf16_f32 %0, %1, %2" : "=v"(r) : "v"(lo), "v"(hi)); return r; }
__device__ __forceinline__ unsigned f6_e2m3(float v) {
    const float y = fminf(__builtin_fabsf(v), 7.5f);
    const unsigned eb = __float_as_uint(fmaxf(y, 1.0f)) >> 23;
    const float q = __builtin_rintf(y * __uint_as_float((257u - eb) << 23));
    return ((unsigned)(int)q + 8u * eb - 1016u) | ((__float_as_uint(v) >> 26) & 32u);
}
__device__ __forceinline__ unsigned f6x4_bytes(float a, float b, float c, float d, float mul) {
    const float lim = 7.5f * 0.015625f, m = mul * 0.015625f;
    int w = __builtin_amdgcn_cvt_pk_fp8_f32(__builtin_amdgcn_fmed3f(a * m, -lim, lim), __builtin_amdgcn_fmed3f(b * m, -lim, lim), 0, false);
    w = __builtin_amdgcn_cvt_pk_fp8_f32(__builtin_amdgcn_fmed3f(c * m, -lim, lim), __builtin_amdgcn_fmed3f(d * m, -lim, lim), w, true);
    return ((unsigned)w & 0x1f1f1f1fu) | (((unsigned)w >> 2) & 0x20202020u);
}
__device__ __forceinline__ unsigned f6pack24(unsigned t) { return (t & 0x3fu) | ((t >> 2) & 0xfc0u) | ((t >> 4) & 0x3f000u) | ((t >> 6) & 0xfc0000u); }
__device__ __forceinline__ unsigned pk4_fp8(float a, float b, float c, float d) { int w = __builtin_amdgcn_cvt_pk_fp8_f32(a, b, 0, false); w = __builtin_amdgcn_cvt_pk_fp8_f32(c, d, w, true); return (unsigned)w; }
__device__ __forceinline__ int lane_now() { int l; asm volatile("v_mbcnt_lo_u32_b32 %0, -1, 0\n\tv_mbcnt_hi_u32_b32 %0, -1, %0" : "=v"(l)); return l; }
__device__ __forceinline__ float bf_lo(unsigned w) { return __uint_as_float(w << 16); }
__device__ __forceinline__ float bf_hi(unsigned w) { return __uint_as_float(w & 0xffff0000u); }
__device__ __forceinline__ float sigmoidf_(float x) { return __builtin_amdgcn_rcpf(1.0f + __builtin_amdgcn_exp2f(-1.4426950408889634f * x)); }

namespace pg8 {
constexpr int BM = 256, BK = 64, HALF = 128, HTB = HALF * BK * 2, STAGE_BYTES = 8 * HTB, NXCD = 8, WGM = 8;
__host__ __device__ __forceinline__ int lds_byte(int r, int c) { const int st = (r >> 4) * 2 + (c >> 5), rr = r & 15, cc = c & 31, ob = rr * 64 + cc * 2; return st * 1024 + (ob ^ (((ob >> 9) & 1) << 5)); }
__host__ __device__ __forceinline__ void stage_rc(int b, int& R, int& C) { const int st = b / 1024, sb = b % 1024, swz = sb ^ (((sb >> 9) & 1) << 5); R = (st >> 1) * 16 + swz / 64; C = (st & 1) * 32 + (swz % 64) / 2; }
__host__ __device__ __forceinline__ int perm32(int rho) { const int n = rho >> 4, i = rho & 15; return 8 * (i >> 2) + 4 * n + (i & 3); }

struct Unit { int pm, pn, e, cnt; };
struct Gemm { const void* A; const void* Bt; int rb; int sa, sb; long long dA = 0, dB = 0; };

__device__ __forceinline__ bool tile_order(int i, int G, int c, int nM, int nN, int& pm, int& pn) {
    const int nwg = nM * nN; const long L = (long)i * G + c; if (L >= nwg) return false;
    int wgid = (int)L; { const int q = nwg / NXCD, r = nwg % NXCD, xcd = wgid % NXCD, off = wgid / NXCD; wgid = (xcd < r ? xcd * (q + 1) : r * (q + 1) + (xcd - r) * q) + off; }
    const int nig = WGM * nN, gid = wgid / nig, fm = gid * WGM, gsz = (nM - fm) < WGM ? (nM - fm) : WGM;
    pm = fm + ((wgid % nig) % gsz); pn = (wgid % nig) / gsz; return true;
}
struct StaticOrder {
    int nM, nN, G, c;
    __device__ void init(int M, int N, int G_, int c_) { nM = M / BM; nN = N / BM; G = G_; c = c_; }
    __device__ __forceinline__ bool next(int i, Unit& u) const { u.e = 0; u.cnt = 256; return tile_order(i, G, c, nM, nN, u.pm, u.pn); }
    __device__ __forceinline__ void a_offs(const Gemm& g, const Unit& u, const int (&R)[2], const int (&C)[2], unsigned (&ao)[2][2]) const {
#pragma unroll
        for (int h = 0; h < 2; ++h)
#pragma unroll
            for (int i = 0; i < 2; ++i) ao[h][i] = (unsigned)((u.pm * BM + h * HALF + R[i]) * g.rb + C[i] * 2);
    }
    __device__ __forceinline__ const char* b_ptr(const Gemm& g, const Unit& u) const { return (const char*)g.Bt + (size_t)u.pn * BM * g.rb; }
};

template <class Epi, class Sched, bool ALIGN_EPI, bool FP8 = false, bool DUAL = false>
__device__ __forceinline__ void gemm_phase(LAS unsigned char* lds, const Gemm g, const Sched& S, const Epi& E, const int wid) {
    const int lane = lane_now(), tid = wid * 64 + lane, wr = wid >> 2, wc = wid & 3, fr = lane & 15, fq = lane >> 4;
    const int rb = g.rb, nt1 = rb / (BK * 2), nt = DUAL ? 2 * nt1 : nt1;
    unsigned voffB[2]; int RR[2], CC[2];
#pragma unroll
    for (int i = 0; i < 2; ++i) { int R, C; stage_rc(tid * 16 + i * 8192, R, C); RR[i] = R; CC[i] = C; int Rs;
        if constexpr ((int)Epi::PERM == 2) Rs = 64 * (R >> 5) + 16 * ((R & 15) >> 2) + 4 * ((R >> 4) & 1) + (R & 3);
        else Rs = (int)Epi::PERM ? ((R & ~31) + perm32(R & 31)) : R;
        voffB[i] = (unsigned)(Rs * rb + C * 2); }
    const size_t hstep = (size_t)(((int)Epi::PERM == 2) ? 8 : HALF) * rb;
    const size_t kstep = (size_t)(BK * 2);
    const unsigned ldsw = (unsigned)wid * 1024u;
    const int aoff = lds_byte(wr * 64 + fr, fq * 8), boff = lds_byte(wc * 32 + fr, fq * 8);
#define PG8_SA(b, h) (((b) * 2 + (h)) * HTB)
#define PG8_SB(b, h) ((4 + (b) * 2 + (h)) * HTB)
#define PG8_STAGE(bufoff, gbase, voff) do { _Pragma("unroll") for (int _i = 0; _i < 2; ++_i) \
        __builtin_amdgcn_global_load_lds((const unsigned*)((const char*)(gbase) + (voff)[_i]), (LAS unsigned*)(lds + (bufoff) + ldsw + _i * 8192), 16, 0, 0); } while (0)
#define PG8_STAGE_A(bufoff, kb, ao, h) PG8_STAGE(bufoff, (const char*)g.A + (kb), (ao)[h])
#define PG8_LDA(dst, b, h) do { _Pragma("unroll") for (int m = 0; m < 4; ++m) { if constexpr (FP8) { const i32x4 lo_ = *(const LAS i32x4*)(lds + PG8_SA(b, h) + aoff + m * 2048), hi_ = *(const LAS i32x4*)(lds + PG8_SA(b, h) + aoff + m * 2048 + 1024); \
            dst##8[m] = __builtin_shufflevector(lo_, hi_, 0, 1, 2, 3, 4, 5, 6, 7); } else { _Pragma("unroll") for (int k = 0; k < 2; ++k) dst[m][k] = *(const LAS bf16x8*)(lds + PG8_SA(b, h) + aoff + m * 2048 + k * 1024); } } } while (0)
#define PG8_LDB(dst, b, h) do { _Pragma("unroll") for (int n = 0; n < 2; ++n) { if constexpr (FP8) { const i32x4 lo_ = *(const LAS i32x4*)(lds + PG8_SB(b, h) + boff + n * 2048), hi_ = *(const LAS i32x4*)(lds + PG8_SB(b, h) + boff + n * 2048 + 1024); \
            dst##8[n] = __builtin_shufflevector(lo_, hi_, 0, 1, 2, 3, 4, 5, 6, 7); } else { _Pragma("unroll") for (int k = 0; k < 2; ++k) dst[n][k] = *(const LAS bf16x8*)(lds + PG8_SB(b, h) + boff + n * 2048 + k * 1024); } } } while (0)
#define PG8_MMA(ai, bj, At, Bt) do { __builtin_amdgcn_s_setprio(1); if constexpr (FP8) { asm volatile("s_nop 1" ::: "memory"); }     \
          \
        _Pragma("unroll") for (int m_ = 0; m_ < 4; ++m_) _Pragma("unroll") for (int n_ = 0; n_ < 2; ++n_) { const int m = (bj) ? 3 - m_ : m_, n = (m_ & 1) ? 1 - n_ : n_; \
        if constexpr (FP8) { asm volatile("v_mfma_scale_f32_16x16x128_f8f6f4 %0, %1, %2, %0, %3, %4 op_sel_hi:[0,0,0]" : "+v"(acc[ai][bj][m][n]) : "v"(Bt##8[n]), "v"(At##8[m]), "v"(sclB), "v"(sclA)); } \
        else { _Pragma("unroll") for (int k = 0; k < 2; ++k) acc[ai][bj][m][n] = __builtin_amdgcn_mfma_f32_16x16x32_bf16(Bt[n][k], At[m][k], acc[ai][bj][m][n], 0, 0, 0); } } \
        __builtin_amdgcn_s_setprio(0); } while (0)
#define PG8_WAIT_V(n) asm volatile("s_waitcnt vmcnt(" #n ")" ::: "memory")
#define PG8_WAIT_L(n) asm volatile("s_waitcnt lgkmcnt(" #n ")" ::: "memory")
#define PG8_BAR __builtin_amdgcn_s_barrier()
#define PG8_SCHED __builtin_amdgcn_sched_barrier(0)
    Unit cur, nxt; int ui = 0;
    if (!S.next(0, cur)) return;
    f32x4 acc[2][2][4][2];
#pragma unroll
    for (int a = 0; a < 2; ++a)
#pragma unroll
        for (int b = 0; b < 2; ++b)
#pragma unroll
            for (int m = 0; m < 4; ++m)
#pragma unroll
                for (int n = 0; n < 2; ++n) acc[a][b][m][n] = (f32x4){0.f, 0.f, 0.f, 0.f};
    bf16x8 At[4][2], B0[2][2], B1[2][2]; i32x8 At8[4], B08[2], B18[2];
    int sclA = g.sa, sclB = g.sb; if constexpr (FP8) { asm volatile("" : "+v"(sclA), "+v"(sclB)); }
    unsigned aoC[2][2], aoN[2][2];
    S.a_offs(g, cur, RR, CC, aoC);
    const char* cB = S.b_ptr(g, cur);
    PG8_STAGE(PG8_SB(0, 0), cB, voffB); PG8_STAGE(PG8_SB(0, 1), cB + hstep, voffB); PG8_STAGE_A(PG8_SA(0, 0), 0, aoC, 0); PG8_STAGE_A(PG8_SA(0, 1), 0, aoC, 1);
    if (wr == 1) PG8_BAR;
    PG8_WAIT_V(2); PG8_BAR;
    PG8_STAGE(PG8_SB(1, 0), cB + kstep, voffB); PG8_STAGE_A(PG8_SA(1, 0), kstep, aoC, 0); PG8_STAGE(PG8_SB(1, 1), cB + hstep + kstep, voffB);
    PG8_WAIT_V(6); PG8_BAR;
    for (;;) {
        const bool has_next = S.next(ui + 1, nxt);
        const char* nB = cB;
#pragma unroll
        for (int h = 0; h < 2; ++h)
#pragma unroll
            for (int i = 0; i < 2; ++i) aoN[h][i] = aoC[h][i];
        if (has_next) { S.a_offs(g, nxt, RR, CC, aoN); nB = S.b_ptr(g, nxt); }
        for (int t = 0; t < nt; t += 2) {
            const bool last = (t == nt - 2);
            if constexpr (DUAL) { if (t == nt1) { asm volatile("s_nop 15\n\ts_nop 15" ::: "memory"); if (wr == 0) PG8_BAR; E.mid(acc, cur, wr, wc, fr, fq); asm volatile("s_nop 7" ::: "memory"); if (wr == 1) PG8_BAR; } }
            size_t k1 = (size_t)(t + 1) * kstep, kk2 = (size_t)(t + 2) * kstep, kb2 = kk2;
            if constexpr (DUAL) { if (t >= nt1) k1 = (size_t)g.dA + (size_t)(t + 1 - nt1) * kstep;
                                  if (t + 2 >= nt1) { kk2 = (size_t)g.dA + (size_t)(t + 2 - nt1) * kstep; kb2 = (size_t)g.dB + (size_t)(t + 2 - nt1) * kstep; } }
            const size_t k2 = last ? 0 : kk2, k3 = k2 + kstep;
            const char* b2 = last ? nB : cB + kb2; const char* b3 = b2 + kstep;
            unsigned ao2[2][2];
#pragma unroll
            for (int h = 0; h < 2; ++h)
#pragma unroll
                for (int i = 0; i < 2; ++i) ao2[h][i] = last ? aoN[h][i] : aoC[h][i];
            PG8_LDB(B0, 0, 0); PG8_LDB(B1, 0, 1); PG8_SCHED; PG8_LDA(At, 0, 0); PG8_STAGE_A(PG8_SA(1, 1), k1, aoC, 1);
            PG8_WAIT_V(8); PG8_WAIT_L(0); PG8_BAR; PG8_MMA(0, 0, At, B0); PG8_MMA(0, 1, At, B1); PG8_BAR; PG8_SCHED;
            PG8_LDA(At, 0, 1); PG8_STAGE(PG8_SB(0, 0), b2, voffB); PG8_STAGE(PG8_SB(0, 1), b2 + hstep, voffB); PG8_STAGE_A(PG8_SA(0, 0), k2, ao2, 0);
            PG8_WAIT_V(8); PG8_WAIT_L(0); PG8_BAR; PG8_MMA(1, 0, At, B0); PG8_MMA(1, 1, At, B1); PG8_BAR; PG8_SCHED;
            PG8_LDB(B0, 1, 0); PG8_LDB(B1, 1, 1); PG8_SCHED; PG8_LDA(At, 1, 0); PG8_STAGE_A(PG8_SA(0, 1), k2, ao2, 1);
            PG8_WAIT_V(8); PG8_WAIT_L(0); PG8_BAR; PG8_MMA(0, 0, At, B0); PG8_MMA(0, 1, At, B1); PG8_BAR; PG8_SCHED;
            PG8_LDA(At, 1, 1); PG8_STAGE(PG8_SB(1, 0), b3, voffB); PG8_STAGE(PG8_SB(1, 1), b3 + hstep, voffB); PG8_STAGE_A(PG8_SA(1, 0), k3, ao2, 0);
            PG8_WAIT_V(8); PG8_WAIT_L(0); PG8_BAR; PG8_MMA(1, 0, At, B0); PG8_MMA(1, 1, At, B1); PG8_BAR; PG8_SCHED;
        }
        if constexpr (FP8) { asm volatile("s_nop 15\n\ts_nop 15" ::: "memory"); }
        if constexpr (ALIGN_EPI) { if (wr == 0) PG8_BAR; }
        E(acc, cur, wr, wc, fr, fq);
        if (!has_next) break;
#pragma unroll
        for (int a = 0; a < 2; ++a)
#pragma unroll
            for (int b = 0; b < 2; ++b)
#pragma unroll
                for (int m = 0; m < 4; ++m)
#pragma unroll
                    for (int n = 0; n < 2; ++n) acc[a][b][m][n] = (f32x4){0.f, 0.f, 0.f, 0.f};
        cur = nxt; cB = nB; ++ui;
#pragma unroll
        for (int h = 0; h < 2; ++h)
#pragma unroll
            for (int i = 0; i < 2; ++i) aoC[h][i] = aoN[h][i];
        if constexpr (ALIGN_EPI) { if (wr == 1) PG8_BAR; }
    }
    PG8_WAIT_V(0);
    if constexpr (!ALIGN_EPI) { if (wr == 0) PG8_BAR; }
    PG8_BAR;
#undef PG8_SA
#undef PG8_SB
#undef PG8_STAGE
#undef PG8_STAGE_A
#undef PG8_LDA
#undef PG8_LDB
#undef PG8_MMA
#undef PG8_WAIT_V
#undef PG8_WAIT_L
#undef PG8_BAR
#undef PG8_SCHED
}

struct EpiBf16 {
    static constexpr bool PERM = true;
    bf16_t* O; int ldc;
    __device__ __forceinline__ void operator()(const f32x4 (&acc)[2][2][4][2], const Unit& u, int wr, int wc, int fr, int fq) const {
        const int row0 = u.pm * BM + wr * 64 + fr, col0 = u.pn * BM + wc * 32 + 8 * fq;
#pragma unroll
        for (int ai = 0; ai < 2; ++ai)
#pragma unroll
            for (int m = 0; m < 4; ++m) { bf16_t* rowp = O + (size_t)(row0 + ai * HALF + m * 16) * ldc + col0;
#pragma unroll
                for (int bj = 0; bj < 2; ++bj) { const f32x4 v0 = acc[ai][bj][m][0], v1 = acc[ai][bj][m][1];
                    u32x4 w; w.x = cvt_pk_bf16(v0[0], v0[1]); w.y = cvt_pk_bf16(v0[2], v0[3]); w.z = cvt_pk_bf16(v1[0], v1[1]); w.w = cvt_pk_bf16(v1[2], v1[3]);
                    *(u32x4*)(rowp + bj * HALF) = w; } }
    }
};
struct EpiProj {
    static constexpr int PERM = 2;
    unsigned char* ws;
    __device__ __forceinline__ void operator()(const f32x4 (&acc)[2][2][4][2], const Unit& u, int wr, int wc, int fr, int fq) const {
        const int pn = u.pn; size_t base; int H, h0; bool gate = false;
        if (pn < 4) { base = WS_QA; H = 8; h0 = 2 * pn; } else if (pn == 4) { base = WS_KA; H = 2; h0 = 0; } else if (pn == 5) { base = WS_VA; H = 2; h0 = 0; }
        else if (pn < 10) { base = WS_QB; H = 8; h0 = 2 * (pn - 6); } else if (pn < 14) { base = WS_KB; H = 8; h0 = 2 * (pn - 10); } else if (pn < 18) { base = WS_VB; H = 8; h0 = 2 * (pn - 14); }
        else { base = WS_G; H = 0; h0 = 0; gate = true; }
        const int row0 = u.pm * BM + wr * 64 + fr, ct = wc * 64 + 16 * fq;
        unsigned char* O = ws + base + (size_t)(h0 + (wc >> 1)) * SEQ * HD + (ct & 127);
        unsigned char* G8 = ws + WS_G + (size_t)(pn - 18) * BM + ct;
#pragma unroll
        for (int ai = 0; ai < 2; ++ai)
#pragma unroll
            for (int m = 0; m < 4; ++m) { const int r = row0 + ai * HALF + m * 16;
                if (gate) { u32x4 w8; w8.x = pk4_fp8(acc[ai][0][m][0][0], acc[ai][0][m][0][1], acc[ai][0][m][0][2], acc[ai][0][m][0][3]); w8.y = pk4_fp8(acc[ai][0][m][1][0], acc[ai][0][m][1][1], acc[ai][0][m][1][2], acc[ai][0][m][1][3]);
                    w8.z = pk4_fp8(acc[ai][1][m][0][0], acc[ai][1][m][0][1], acc[ai][1][m][0][2], acc[ai][1][m][0][3]); w8.w = pk4_fp8(acc[ai][1][m][1][0], acc[ai][1][m][1][1], acc[ai][1][m][1][2], acc[ai][1][m][1][3]);
                    *(u32x4*)(G8 + (size_t)r * 4096) = w8; }
                else { u32x4 w8; w8.x = pk4_fp8(acc[ai][0][m][0][0], acc[ai][0][m][0][1], acc[ai][0][m][0][2], acc[ai][0][m][0][3]); w8.y = pk4_fp8(acc[ai][0][m][1][0], acc[ai][0][m][1][1], acc[ai][0][m][1][2], acc[ai][0][m][1][3]);
                    w8.z = pk4_fp8(acc[ai][1][m][0][0], acc[ai][1][m][0][1], acc[ai][1][m][0][2], acc[ai][1][m][0][3]); w8.w = pk4_fp8(acc[ai][1][m][1][0], acc[ai][1][m][1][1], acc[ai][1][m][1][2], acc[ai][1][m][1][3]);
                    *(u32x4*)(O + ((size_t)(r >> 14) * H * SEQ + (size_t)(r & (SEQ - 1))) * HD) = w8; } }
    }
};
template <bool ADD> struct EpiGate {
    static constexpr bool PERM = true;
    bf16_t* O; unsigned char* O8; int ldc; const bf16_t* Gt; int ldg;
    __device__ __forceinline__ void operator()(const f32x4 (&acc)[2][2][4][2], const Unit& u, int wr, int wc, int fr, int fq) const {
        const int row0 = u.pm * BM + wr * 64 + fr, col0 = u.pn * BM + wc * 32 + 8 * fq;
#pragma unroll
        for (int ai = 0; ai < 2; ++ai)
#pragma unroll
            for (int m = 0; m < 4; ++m) { const size_t r = (size_t)(row0 + ai * HALF + m * 16);
#pragma unroll
                for (int bj = 0; bj < 2; ++bj) { const f32x4 v0 = acc[ai][bj][m][0], v1 = acc[ai][bj][m][1];
                    const u32x4 gw = *(const u32x4*)(Gt + r * ldg + col0 + bj * HALF);
                    bf16_t* op = O + r * ldc + col0 + bj * HALF;
                    float o[8] = {0.f, 0.f, 0.f, 0.f, 0.f, 0.f, 0.f, 0.f};
                    if (ADD) { const u32x4 ow = *(const u32x4*)op; o[0] = bf_lo(ow.x); o[1] = bf_hi(ow.x); o[2] = bf_lo(ow.y); o[3] = bf_hi(ow.y); o[4] = bf_lo(ow.z); o[5] = bf_hi(ow.z); o[6] = bf_lo(ow.w); o[7] = bf_hi(ow.w); }
                    o[0] += sigmoidf_(bf_lo(gw.x)) * v0[0]; o[1] += sigmoidf_(bf_hi(gw.x)) * v0[1]; o[2] += sigmoidf_(bf_lo(gw.y)) * v0[2]; o[3] += sigmoidf_(bf_hi(gw.y)) * v0[3];
                    o[4] += sigmoidf_(bf_lo(gw.z)) * v1[0]; o[5] += sigmoidf_(bf_hi(gw.z)) * v1[1]; o[6] += sigmoidf_(bf_lo(gw.w)) * v1[2]; o[7] += sigmoidf_(bf_hi(gw.w)) * v1[3];
                    if (ADD) { u32x2 w; w.x = pk4_fp8(o[0] * F8_MMUL, o[1] * F8_MMUL, o[2] * F8_MMUL, o[3] * F8_MMUL); w.y = pk4_fp8(o[4] * F8_MMUL, o[5] * F8_MMUL, o[6] * F8_MMUL, o[7] * F8_MMUL);
                        *(u32x2*)(O8 + r * ldc + col0 + bj * HALF) = w; }
                    else { u32x4 w; w.x = cvt_pk_bf16(o[0], o[1]); w.y = cvt_pk_bf16(o[2], o[3]); w.z = cvt_pk_bf16(o[4], o[5]); w.w = cvt_pk_bf16(o[6], o[7]);
                        *(u32x4*)op = w; } } }
    }
};
struct EpiGateDual {
    static constexpr int PERM = 2;
    static constexpr int LDC = 2048, LDG = 4096;
    unsigned char* O8; const unsigned char* Gt;
    static __device__ __forceinline__ float eneg(float g) { return __builtin_amdgcn_exp2f(-1.4426950408889634f * g); }
    static __device__ __forceinline__ float clampb(float g) { return fmaxf(g, -30.0f); }
#define GD8(w, b) __builtin_amdgcn_cvt_f32_fp8((int)(w), b)
    __device__ __forceinline__ void mid(f32x4 (&acc)[2][2][4][2], const Unit& u, int wr, int wc, int fr, int fq) const {
        unsigned gb0 = (unsigned)((u.pm * BM + wr * 64 + fr) * LDG + u.pn * BM + wc * 64 + 16 * fq);
        asm volatile("" : "+v"(gb0));
        const unsigned char* gt = Gt;
#pragma unroll
        for (int ai = 0; ai < 2; ++ai)
#pragma unroll
            for (int m = 0; m < 4; ++m) { const unsigned off = gb0 + (unsigned)((ai * HALF + m * 16) * LDG);
                const u32x4 ga = *(const u32x4*)(gt + off), gb = *(const u32x4*)(gt + off + 2048u);
#define GDR(wa, wb, b) ((1.0f + eneg(clampb(GD8(wb, b)))) * __builtin_amdgcn_rcpf(1.0f + eneg(GD8(wa, b))))
#define GDQ(bj, n, wa, wb) do { acc[ai][bj][m][n][0] *= GDR(wa, wb, 0); acc[ai][bj][m][n][1] *= GDR(wa, wb, 1); acc[ai][bj][m][n][2] *= GDR(wa, wb, 2); acc[ai][bj][m][n][3] *= GDR(wa, wb, 3); } while (0)
                GDQ(0, 0, ga.x, gb.x); GDQ(0, 1, ga.y, gb.y); GDQ(1, 0, ga.z, gb.z); GDQ(1, 1, ga.w, gb.w);
#undef GDQ
#undef GDR
            }
    }
    __device__ __forceinline__ void operator()(const f32x4 (&acc)[2][2][4][2], const Unit& u, int wr, int wc, int fr, int fq) const {
        unsigned rc0 = (unsigned)((u.pm * BM + wr * 64 + fr) * LDC + u.pn * BM + wc * 64 + 16 * fq);
        asm volatile("" : "+v"(rc0));
        const unsigned row0 = rc0 / LDC, col0 = rc0 % LDC;
        const unsigned char* gt = Gt;
#pragma unroll
        for (int ai = 0; ai < 2; ++ai)
#pragma unroll
            for (int m = 0; m < 4; ++m) { const unsigned r = row0 + ai * HALF + m * 16;
                const u32x4 gw = *(const u32x4*)(gt + (r * LDG + 2048u + col0));
#define GSO(bj, n, w) pk4_fp8(sigmoidf_(clampb(GD8(w, 0))) * acc[ai][bj][m][n][0] * F8_MMUL, sigmoidf_(clampb(GD8(w, 1))) * acc[ai][bj][m][n][1] * F8_MMUL, sigmoidf_(clampb(GD8(w, 2))) * acc[ai][bj][m][n][2] * F8_MMUL, sigmoidf_(clampb(GD8(w, 3))) * acc[ai][bj][m][n][3] * F8_MMUL)
                u32x4 w; w.x = GSO(0, 0, gw.x); w.y = GSO(0, 1, gw.y); w.z = GSO(1, 0, gw.z); w.w = GSO(1, 1, gw.w);
#undef GSO
                *(u32x4*)(O8 + (r * LDC + col0)) = w; }
    }
#undef GD8
};
struct EpiResid {
    static constexpr bool PERM = false;
    const float* base; float* out; int ldc;
    __device__ __forceinline__ void operator()(const f32x4 (&acc)[2][2][4][2], const Unit& u, int wr, int wc, int fr, int fq) const {
        const int row0 = u.pm * BM + wr * 64 + fr, col0 = u.pn * BM + wc * 32 + 4 * fq;
#pragma unroll
        for (int ai = 0; ai < 2; ++ai)
#pragma unroll
            for (int m = 0; m < 4; ++m) { const size_t off = (size_t)(row0 + ai * HALF + m * 16) * ldc + col0;
#pragma unroll
                for (int bj = 0; bj < 2; ++bj)
#pragma unroll
                    for (int n = 0; n < 2; ++n) { const f32x4 b = *(const f32x4*)(base + off + bj * HALF + n * 16); *(f32x4*)(out + off + bj * HALF + n * 16) = b + acc[ai][bj][m][n]; } }
    }
};
struct EpiResidB {
    static constexpr bool PERM = true;
    const float* base; bf16_t* out; int ldc;
    __device__ __forceinline__ void operator()(const f32x4 (&acc)[2][2][4][2], const Unit& u, int wr, int wc, int fr, int fq) const {
        const int row0 = u.pm * BM + wr * 64 + fr, col0 = u.pn * BM + wc * 32 + 8 * fq;
#pragma unroll
        for (int ai = 0; ai < 2; ++ai)
#pragma unroll
            for (int m = 0; m < 4; ++m) { const size_t off = (size_t)(row0 + ai * HALF + m * 16) * ldc + col0;
#pragma unroll
                for (int bj = 0; bj < 2; ++bj) { const f32x4 v0 = *(const f32x4*)(base + off + bj * HALF) + acc[ai][bj][m][0], v1 = *(const f32x4*)(base + off + bj * HALF + 4) + acc[ai][bj][m][1];
                    u32x4 w; w.x = cvt_pk_bf16(v0[0], v0[1]); w.y = cvt_pk_bf16(v0[2], v0[3]); w.z = cvt_pk_bf16(v1[0], v1[1]); w.w = cvt_pk_bf16(v1[2], v1[3]);
                    *(u32x4*)(out + off + bj * HALF) = w; } }
    }
};
struct EpiSwiglu {
    static constexpr bool PERM = true;
    unsigned char* act; const float* bg; const float* bu;
    __device__ __forceinline__ void operator()(const f32x4 (&acc)[2][2][4][2], const Unit& u, int wr, int wc, int fr, int fq) const {
        const int row0 = u.pm * BM + wr * 64 + fr, j0 = u.pn * HALF + wc * 32 + 8 * fq;
        const f32x4 g0 = *(const f32x4*)(bg + (size_t)u.e * DE + j0), g1 = *(const f32x4*)(bg + (size_t)u.e * DE + j0 + 4);
        const f32x4 u0 = *(const f32x4*)(bu + (size_t)u.e * DE + j0), u1 = *(const f32x4*)(bu + (size_t)u.e * DE + j0 + 4);
#pragma unroll
        for (int ai = 0; ai < 2; ++ai)
#pragma unroll
            for (int m = 0; m < 4; ++m) {
                float o[8];
#pragma unroll
                for (int n = 0; n < 2; ++n)
#pragma unroll
                    for (int i = 0; i < 4; ++i) {
                        float gt = acc[ai][0][m][n][i] + (n ? g1[i] : g0[i]), up = acc[ai][1][m][n][i] + (n ? u1[i] : u0[i]);
                        gt = fminf(gt, 7.0f); up = fminf(fmaxf(up, -7.0f), 7.0f);
                        o[n * 4 + i] = gt * sigmoidf_(1.702f * gt) * (up + 1.0f); }
                u32x2 w; w.x = pk4_fp8(o[0], o[1], o[2], o[3]); w.y = pk4_fp8(o[4], o[5], o[6], o[7]);
                *(u32x2*)(act + (size_t)(row0 + ai * HALF + m * 16) * DE + j0) = w; }
    }
};
struct EpiDown {
    static constexpr int PERM = 2;
    unsigned char* Y; const float* bd; const float* lw; const LAS int* tstart;
    __device__ __forceinline__ void operator()(const f32x4 (&acc)[2][2][4][2], const Unit& u, int wr, int wc, int fr, int fq) const {
        const int rl0 = wr * 64 + fr, col0 = u.pn * BM + wc * 64 + 16 * fq;
        const int lt = u.pm - tstart[u.e];
        f32x4 bv[2][2];
#pragma unroll
        for (int bj = 0; bj < 2; ++bj)
#pragma unroll
            for (int n = 0; n < 2; ++n) bv[bj][n] = *(const f32x4*)(bd + (size_t)u.e * D + col0 + 8 * bj + 4 * n);
#pragma unroll
        for (int ai = 0; ai < 2; ++ai)
#pragma unroll
            for (int m = 0; m < 4; ++m) { const int rl = rl0 + ai * HALF + m * 16;
                const float wl = lw[(size_t)u.e * LCAP + lt * 256 + (rl < u.cnt ? rl : u.cnt - 1)]; const float w = rl < u.cnt ? wl : 0.f;
                unsigned char* rowp = Y + (size_t)(u.pm * BM + rl) * D + col0; const float w16 = w * 16.0f;
                u32x4 q;
                { const f32x4 v = (acc[ai][0][m][0] + bv[0][0]) * w16; q.x = pk4_fp8(v[0], v[1], v[2], v[3]); }
                { const f32x4 v = (acc[ai][0][m][1] + bv[0][1]) * w16; q.y = pk4_fp8(v[0], v[1], v[2], v[3]); }
                { const f32x4 v = (acc[ai][1][m][0] + bv[1][0]) * w16; q.z = pk4_fp8(v[0], v[1], v[2], v[3]); }
                { const f32x4 v = (acc[ai][1][m][1] + bv[1][1]) * w16; q.w = pk4_fp8(v[0], v[1], v[2], v[3]); }
                *(u32x4*)rowp = q; }
    }
};
struct MoeOrder {
    const LAS int* cnt; const LAS int* tstart; const LAS unsigned char* tile_e; int TT, NC, G, c;
    const int* ltok; bool gather; size_t brows;
    __device__ __forceinline__ bool next(int i, Unit& u) const {
        if (!tile_order(i, G, c, TT, NC, u.pm, u.pn)) return false;
        u.e = tile_e[u.pm]; const int lt = u.pm - tstart[u.e]; const int rem = cnt[u.e] - lt * 256; u.cnt = rem < 256 ? rem : 256; return true;
    }
    __device__ __forceinline__ void a_offs(const Gemm& g, const Unit& u, const int (&R)[2], const int (&C)[2], unsigned (&ao)[2][2]) const {
        const int lt = u.pm - tstart[u.e];
#pragma unroll
        for (int h = 0; h < 2; ++h)
#pragma unroll
            for (int i = 0; i < 2; ++i) {
                int row;
                if (gather) { int rl = h * HALF + R[i]; rl = rl < u.cnt ? rl : u.cnt - 1;
                    row = ltok[(size_t)u.e * LCAP + lt * 256 + rl]; }
                else row = u.pm * BM + h * HALF + R[i];
                ao[h][i] = (unsigned)(row * g.rb + C[i] * 2); }
    }
    __device__ __forceinline__ const char* b_ptr(const Gemm& g, const Unit& u) const { return (const char*)g.Bt + ((size_t)u.e * brows + (size_t)u.pn * BM) * g.rb; }
};
}

#define F8D(w, b) __builtin_amdgcn_cvt_f32_fp8((int)(w), b)
namespace att {
constexpr int NW = 8, QBLK = 32, KVBLK = 64;
constexpr float SCALE = 0.088388347648318440f;
constexpr float THR = 8.f;
constexpr float QMUL = 0.088388347648318440f * 1.4426950408889634f * 16.0f;
constexpr float PTHR = 0.75f, PHEAD0 = 2.0f, PHEAD = 1.0f;
constexpr float KMUL = 2.0f, VMUL = 2.0f;
constexpr size_t SHM_V = KVBLK * HD * 2, SHM_K = KVBLK * HD * 2, SHM_ATTN = 2 * SHM_V + 2 * SHM_K + NW * 64 * 4;
constexpr int BIAS_OFF = 67584;
#define KSWZ(row, colB) ((row) * 256 + ((colB) ^ (((row) & 15) << 4)))
#define SBAR() __builtin_amdgcn_sched_barrier(0)
__device__ __forceinline__ int crow(int r, int hi) { return (r & 3) + 8 * (r >> 2) + 4 * hi; }
__device__ __forceinline__ unsigned cvtpk(float lo, float hi) { unsigned r; asm volatile("v_cvt_pk_bf16_f32 %0, %1, %2" : "=v"(r) : "v"(lo), "v"(hi)); return r; }
__device__ __forceinline__ bf16x8 ld8(const bf16_t* p) { return *reinterpret_cast<const bf16x8*>(p); }

__device__ __forceinline__ void partialSM(f32x16& p0, f32x16& p1, float& m_reg, float& mn, float& alpha) {
  constexpr float C = SCALE * 1.4426950408889634f;
  float pmax = p0[0]; for (int r = 1; r < 16; ++r) pmax = fmaxf(pmax, p0[r]); for (int r = 0; r < 16; ++r) pmax = fmaxf(pmax, p1[r]);
  { auto rr = __builtin_amdgcn_permlane32_swap(__float_as_uint(pmax), __float_as_uint(pmax), false, false);
    pmax = fmaxf(__uint_as_float(rr[0]), __uint_as_float(rr[1])); }
  if (__builtin_expect(__all(pmax - m_reg <= THR / SCALE), 1)) { mn = m_reg; alpha = 1.f; }
  else { mn = fmaxf(m_reg, pmax); alpha = __builtin_amdgcn_exp2f((m_reg - mn) * C); m_reg = mn; }
  float mnC = -mn * C;
  for (int r = 0; r < 16; ++r) p0[r] = fmaf(p0[r], C, mnC); for (int r = 0; r < 16; ++r) p1[r] = fmaf(p1[r], C, mnC);
  for (int r = 0; r < 16; ++r) p0[r] = __builtin_amdgcn_exp2f(p0[r]);
}
__device__ __forceinline__ void finishSM(f32x16& p0, f32x16& p1, float alpha, float& l_reg, bf16x8& pa0, bf16x8& pa1, bf16x8& pa2, bf16x8& pa3) {
  for (int r = 0; r < 16; ++r) p1[r] = __builtin_amdgcn_exp2f(p1[r]);
  float ps = 0; for (int r = 0; r < 16; ++r) ps += p0[r]; for (int r = 0; r < 16; ++r) ps += p1[r];
  { auto rr = __builtin_amdgcn_permlane32_swap(__float_as_uint(ps), __float_as_uint(ps), false, false);
    ps = __uint_as_float(rr[0]) + __uint_as_float(rr[1]); }
  l_reg = l_reg * alpha + ps;
#define PK4(P, BASE, OUT) do { unsigned a0 = cvtpk(P[BASE + 0], P[BASE + 1]), a1 = cvtpk(P[BASE + 2], P[BASE + 3]);   \
    unsigned b0 = cvtpk(P[BASE + 4], P[BASE + 5]), b1 = cvtpk(P[BASE + 6], P[BASE + 7]);                              \
    auto r0 = __builtin_amdgcn_permlane32_swap(a0, b0, false, false); auto r1 = __builtin_amdgcn_permlane32_swap(a1, b1, false, false); \
    u32x4 w = {r0[0], r1[0], r0[1], r1[1]}; OUT = *reinterpret_cast<bf16x8*>(&w); } while (0)
  PK4(p0, 0, pa0); PK4(p0, 8, pa1); PK4(p1, 0, pa2); PK4(p1, 8, pa3);
#undef PK4
}
__device__ __forceinline__ void qkt(f32x16& p0, f32x16& p1, const bf16_t* Ks, const bf16x8* qr, int r32, int hi) {
  p0 = f32x16{}; p1 = f32x16{};
  for (int d0 = 0; d0 < 8; ++d0) { int cb = (d0 * 16 + hi * 8) * 2;
    bf16x8 b0 = *reinterpret_cast<const bf16x8*>((const char*)Ks + KSWZ(r32, cb));
    bf16x8 b1 = *reinterpret_cast<const bf16x8*>((const char*)Ks + KSWZ(32 + r32, cb));
    p0 = __builtin_amdgcn_mfma_f32_32x32x16_bf16(b0, qr[d0], p0, 0, 0, 0);
    p1 = __builtin_amdgcn_mfma_f32_32x32x16_bf16(b1, qr[d0], p1, 0, 0, 0); }
}
__device__ __forceinline__ int v_st(int k, int c) { const int kk = (k & ~0xC) | ((k & 4) << 1) | ((k & 8) >> 1); return ((kk >> 3) * 4 + (c >> 5)) * 512 + ((kk & 7) * 32 + (c & 31)) * 2; }
__device__ __forceinline__ int v_rd_base(int lane) { return ((lane & 3) << 3) | (((lane >> 2) & 3) << 6) | (((lane >> 4) & 1) << 5) | (((lane >> 5) & 1) << 8); }
constexpr int v_rd_off(int d0, int ks, int half) { return d0 * 512 + ks * 4096 + half * 2048; }
template <int OFF> __device__ __forceinline__ s16x4 tr_read(int vb) {
  s16x4 r; asm volatile("ds_read_b64_tr_b16 %0, %1 offset:%2" : "=&v"(r) : "v"(vb), "i"(OFF) : "memory"); return r;
}
template <int D0> __device__ __forceinline__ void pv_one(f32x16& od, int vb, bf16x8 pa0, bf16x8 pa1, bf16x8 pa2, bf16x8 pa3) {
  const s16x4 l0 = tr_read<v_rd_off(D0, 0, 0)>(vb), h0 = tr_read<v_rd_off(D0, 0, 1)>(vb), l1 = tr_read<v_rd_off(D0, 1, 0)>(vb), h1 = tr_read<v_rd_off(D0, 1, 1)>(vb);
  const s16x4 l2 = tr_read<v_rd_off(D0, 2, 0)>(vb), h2 = tr_read<v_rd_off(D0, 2, 1)>(vb), l3 = tr_read<v_rd_off(D0, 3, 0)>(vb), h3 = tr_read<v_rd_off(D0, 3, 1)>(vb);
  asm volatile("s_waitcnt lgkmcnt(0)" ::: "memory"); SBAR();
#define PK(L, H) (bf16x8){L[0], L[1], L[2], L[3], H[0], H[1], H[2], H[3]}
  od = __builtin_amdgcn_mfma_f32_32x32x16_bf16(pa0, PK(l0, h0), od, 0, 0, 0);
  od = __builtin_amdgcn_mfma_f32_32x32x16_bf16(pa1, PK(l1, h1), od, 0, 0, 0);
  od = __builtin_amdgcn_mfma_f32_32x32x16_bf16(pa2, PK(l2, h2), od, 0, 0, 0);
  od = __builtin_amdgcn_mfma_f32_32x32x16_bf16(pa3, PK(l3, h3), od, 0, 0, 0);
#undef PK
}
__device__ __forceinline__ void pv_d0(f32x16* o, int vb, bf16x8 pa0, bf16x8 pa1, bf16x8 pa2, bf16x8 pa3) {
  pv_one<0>(o[0], vb, pa0, pa1, pa2, pa3); pv_one<1>(o[1], vb, pa0, pa1, pa2, pa3); pv_one<2>(o[2], vb, pa0, pa1, pa2, pa3); pv_one<3>(o[3], vb, pa0, pa1, pa2, pa3);
}
struct NoMask { __device__ __forceinline__ void operator()(f32x16&, f32x16&, int) const {} };
struct NaMask {
  const float* bias; int kr0, rq, c, cs, hi;
  __device__ __forceinline__ void operator()(f32x16& p0, f32x16& p1, int j) const {
    const int kr = kr0 + j; int rs = rq - 4; rs = rs < 0 ? 0 : (rs > ROWS - 8 ? ROWS - 8 : rs);
    const bool vrow = (kr >= rs) && (kr < rs + 8);
    int ro = kr - rq + 7; ro = ro < 0 ? 0 : (ro > 14 ? 14 : ro);
    const float* br = bias + ro * 32; const float ninf = -__builtin_inff();
#pragma unroll
    for (int r = 0; r < 16; ++r) { const int kc = crow(r, hi);
      { const bool v = vrow && ((unsigned)(kc - cs) < 16u); const int co = v ? (kc - c + 15) : 0; const float b = br[co]; p0[r] = v ? p0[r] + b : ninf; }
      { const int kc1 = kc + 32; const bool v = vrow && ((unsigned)(kc1 - cs) < 16u); const int co = v ? (kc1 - c + 15) : 0; const float b = br[co]; p1[r] = v ? p1[r] + b : ninf; } }
  }
};

template <int LDQ, int LDK, int LDO, class Mask>
__device__ __forceinline__ void attn_body(const bf16_t* __restrict__ Qb, const bf16_t* __restrict__ Kh, const bf16_t* __restrict__ Vh,
                                          unsigned char* __restrict__ Ob, int seq, char* lds, const Mask& MK, const int wid) {
  const int lane = lane_now(), tid = wid * 64 + lane, r32 = lane & 31, hi = lane >> 5;
  bf16_t* V_lds = (bf16_t*)lds; bf16_t* K_lds = (bf16_t*)(lds + 2 * SHM_V);
  float* ws = (float*)(lds + 2 * SHM_V + 2 * SHM_K) + wid * 64; float* li_l = ws; float* al_l = ws + 32;
  float m_reg = -1e30f, l_reg = 0; f32x16 o[4] = {}; bf16x8 qr[8];
  const bf16_t* Qw = Qb + (long)(wid * QBLK + r32) * LDQ + hi * 8;
#pragma unroll
  for (int d0 = 0; d0 < 8; ++d0) qr[d0] = ld8(Qw + d0 * 16);
  const int sr = tid >> 4, sc = (tid & 15) * 8, vst0 = v_st(sr, sc), vst1 = v_st(32 + sr, sc);
  const unsigned lo0 = (unsigned)(sr * LDK + sc) * 2u, lo1 = lo0 + 32u * LDK * 2u;
  const int vb0 = (int)(uintptr_t)V_lds + v_rd_base(lane);
  constexpr int SDEPTH = 2;
  struct { bf16x8 vs0, vs1, ks0, ks1; } sr_[SDEPTH];
#define SLOAD(i, k0) do { const char* kb_ = (const char*)Kh + (size_t)(k0) * (LDK * 2); const char* vb_ = (const char*)Vh + (size_t)(k0) * (LDK * 2); \
    sr_[i].vs0 = *(const bf16x8*)(vb_ + lo0); sr_[i].vs1 = *(const bf16x8*)(vb_ + 32 * LDK * 2 + lo0); \
    sr_[i].ks0 = *(const bf16x8*)(kb_ + lo0); sr_[i].ks1 = *(const bf16x8*)(kb_ + 32 * LDK * 2 + lo0); } while (0)
#define SWRITE(b, i) do { *(bf16x8*)((char*)V_lds + (b) * SHM_V + vst0) = sr_[i].vs0;          \
    *(bf16x8*)((char*)V_lds + (b) * SHM_V + vst1) = sr_[i].vs1; int kc = sc * 2;               \
    *(bf16x8*)((char*)K_lds + (b) * SHM_K + KSWZ(sr, kc)) = sr_[i].ks0;                       \
    *(bf16x8*)((char*)K_lds + (b) * SHM_K + KSWZ(32 + sr, kc)) = sr_[i].ks1; } while (0)
#define SWAIT() do { if constexpr (SDEPTH == 2) asm volatile("s_waitcnt vmcnt(4)" ::: "memory"); else asm volatile("s_waitcnt vmcnt(0)" ::: "memory"); } while (0)
#define RESC(a) do { if (__any((a) < 1.f)) { const int ln_ = lane_now(), r32_ = ln_ & 31, hi_ = ln_ >> 5; float* al2_ = (float*)(lds + 2 * SHM_V + 2 * SHM_K) + wid * 64 + 32; \
    if (hi_ == 0) al2_[r32_] = (a); asm volatile("s_waitcnt lgkmcnt(0)" ::: "memory"); \
    for (int d = 0; d < 4; ++d) for (int r = 0; r < 16; ++r) o[d][r] *= al2_[crow(r, hi_)]; } } while (0)
  f32x16 pA0, pA1, pB0, pB1; float mnA, mnB, alA, alB; bf16x8 pa0, pa1, pa2, pa3; const int NT = seq / KVBLK;
  constexpr int SE = 0, SO = SDEPTH - 1;
  SLOAD(SE, 0); asm volatile("s_waitcnt vmcnt(0)" ::: "memory"); SWRITE(0, SE); __syncthreads();
  qkt(pA0, pA1, K_lds, qr, r32, hi); MK(pA0, pA1, 0); partialSM(pA0, pA1, m_reg, mnA, alA);
  SLOAD(SO, KVBLK); if constexpr (SDEPTH == 2) { if (2 < NT) SLOAD(SE, 2 * KVBLK); }
  SWAIT(); SWRITE(1, SO); __syncthreads();
  for (int j = 1; j + 1 < NT; j += 2) {
    SBAR(); qkt(pB0, pB1, (bf16_t*)((char*)K_lds + SHM_K), qr, r32, hi); MK(pB0, pB1, j);
    finishSM(pA0, pA1, alA, l_reg, pa0, pa1, pa2, pa3); SBAR();
    SLOAD(SO, (j + SDEPTH) * KVBLK); SBAR();
    pv_d0(o, vb0, pa0, pa1, pa2, pa3); partialSM(pB0, pB1, m_reg, mnB, alB);
    __syncthreads(); SWAIT(); SWRITE(0, SE);
    RESC(alB); __syncthreads();
    SBAR(); qkt(pA0, pA1, K_lds, qr, r32, hi); MK(pA0, pA1, j + 1);
    finishSM(pB0, pB1, alB, l_reg, pa0, pa1, pa2, pa3); SBAR();
    if (SDEPTH == 1 || j + 3 < NT) SLOAD(SE, (j + 1 + SDEPTH) * KVBLK); SBAR();
    pv_d0(o, vb0 + (int)SHM_V, pa0, pa1, pa2, pa3); partialSM(pA0, pA1, m_reg, mnA, alA);
    __syncthreads(); SWAIT(); SWRITE(1, SO);
    RESC(alA); __syncthreads();
  }
  SBAR(); qkt(pB0, pB1, (bf16_t*)((char*)K_lds + SHM_K), qr, r32, hi); MK(pB0, pB1, NT - 1);
  finishSM(pA0, pA1, alA, l_reg, pa0, pa1, pa2, pa3); SBAR();
  pv_d0(o, vb0, pa0, pa1, pa2, pa3); partialSM(pB0, pB1, m_reg, mnB, alB);
  __syncthreads(); RESC(alB);
  finishSM(pB0, pB1, alB, l_reg, pa0, pa1, pa2, pa3); SBAR();
  pv_d0(o, vb0 + (int)SHM_V, pa0, pa1, pa2, pa3);
  if (hi == 0) li_l[r32] = l_reg; asm volatile("s_waitcnt lgkmcnt(0)" ::: "memory");
  float rli[16];
#pragma unroll
  for (int r = 0; r < 16; ++r) rli[r] = __builtin_amdgcn_rcpf(li_l[crow(r, hi)]) * F8_YMUL;
  unsigned char* Ow = Ob + (long)(wid * QBLK) * LDO; const unsigned lane_off = (unsigned)(4 * hi * LDO + r32);
#pragma unroll
  for (int r = 0; r < 16; ++r) { unsigned char* rowb = Ow + ((r & 3) + 8 * (r >> 2)) * LDO;
#pragma unroll
    for (int d0 = 0; d0 < 4; ++d0) { const float v = o[d0][r] * rli[r]; rowb[lane_off + d0 * 32] = (unsigned char)(__builtin_amdgcn_cvt_pk_fp8_f32(v, v, 0, false) & 0xff); } }
#undef SLOAD
#undef SWRITE
#undef SWAIT
#undef RESC
}

__device__ __forceinline__ bf16x8 f8x8_to_bf16(const u32x2 w) { u32x4 o; o.x = cvtpk(F8D(w.x, 0), F8D(w.x, 1)); o.y = cvtpk(F8D(w.x, 2), F8D(w.x, 3)); o.z = cvtpk(F8D(w.y, 0), F8D(w.y, 1)); o.w = cvtpk(F8D(w.y, 2), F8D(w.y, 3)); return __builtin_bit_cast(bf16x8, o); }
template <int LDQ, int LDK, int LDO, class Mask>
__device__ __forceinline__ void attn_body_simple(const unsigned char* __restrict__ Qb, const unsigned char* __restrict__ Kh, const unsigned char* __restrict__ Vh,
                                                 unsigned char* __restrict__ Ob, int NT, char* lds, const Mask& MK, const int wid, const float* __restrict__ gq, const float* __restrict__ gk) {
  const int lane = lane_now(), tid = wid * 64 + lane, r32 = lane & 31, hi = lane >> 5;
  bf16_t* V_lds = (bf16_t*)lds; bf16_t* K_lds = (bf16_t*)(lds + 2 * SHM_V);
  float* ws = (float*)(lds + 2 * SHM_V + 2 * SHM_K) + wid * 64; float* li_l = ws; float* al_l = ws + 32;
  float m_reg = -1e30f, l_reg = 0; f32x16 o[4] = {}; bf16x8 qr[8];
  const unsigned char* Qw = Qb + (long)(wid * QBLK + r32) * LDQ + hi * 8;
#pragma unroll
  for (int d0 = 0; d0 < 8; ++d0) qr[d0] = f8x8_to_bf16(*(const u32x2*)(Qw + d0 * 16));
  { float ss = 0.f;
#pragma unroll
    for (int d0 = 0; d0 < 8; ++d0) { const u32x4 w = __builtin_bit_cast(u32x4, qr[d0]); const float a0 = bf_lo(w.x), a1 = bf_hi(w.x), a2 = bf_lo(w.y), a3 = bf_hi(w.y), a4 = bf_lo(w.z), a5 = bf_hi(w.z), a6 = bf_lo(w.w), a7 = bf_hi(w.w);
        ss += (a0 * a0 + a1 * a1) + (a2 * a2 + a3 * a3) + (a4 * a4 + a5 * a5) + (a6 * a6 + a7 * a7); }
    { auto rr = __builtin_amdgcn_permlane32_swap(__float_as_uint(ss), __float_as_uint(ss), false, false); ss = __uint_as_float(rr[0]) + __uint_as_float(rr[1]); }
    const float rstd = 1.0f / sqrtf(ss * (1.f / 128.f) + EPS);
#pragma unroll
    for (int d0 = 0; d0 < 8; ++d0) { const u32x4 w = __builtin_bit_cast(u32x4, qr[d0]); const f32x4 g0 = *(const f32x4*)(gq + d0 * 16 + hi * 8), g1 = *(const f32x4*)(gq + d0 * 16 + hi * 8 + 4);
        u32x4 o; o.x = cvtpk(bf_lo(w.x) * rstd * g0.x, bf_hi(w.x) * rstd * g0.y); o.y = cvtpk(bf_lo(w.y) * rstd * g0.z, bf_hi(w.y) * rstd * g0.w);
        o.z = cvtpk(bf_lo(w.z) * rstd * g1.x, bf_hi(w.z) * rstd * g1.y); o.w = cvtpk(bf_lo(w.w) * rstd * g1.z, bf_hi(w.w) * rstd * g1.w); qr[d0] = __builtin_bit_cast(bf16x8, o); } }
  const int sr = tid >> 4, sc = (tid & 15) * 8, vst0 = v_st(sr, sc), vst1 = v_st(32 + sr, sc);
  const unsigned lo0 = (unsigned)(sr * LDK + sc), lo1 = lo0 + 32u * LDK;
  const int vb0 = (int)(uintptr_t)V_lds + v_rd_base(lane);
  const f32x4 gk0 = *(const f32x4*)(gk + sc), gk1 = *(const f32x4*)(gk + sc + 4);
  bf16x8 vs0, vs1, ks0, ks1; u32x2 vr0, vr1, kr0, kr1;
#define KNORM(kv) do { const u32x4 w_ = __builtin_bit_cast(u32x4, kv); const float a0 = bf_lo(w_.x), a1 = bf_hi(w_.x), a2 = bf_lo(w_.y), a3 = bf_hi(w_.y), a4 = bf_lo(w_.z), a5 = bf_hi(w_.z), a6 = bf_lo(w_.w), a7 = bf_hi(w_.w); \
    float ss_ = (a0 * a0 + a1 * a1) + (a2 * a2 + a3 * a3) + (a4 * a4 + a5 * a5) + (a6 * a6 + a7 * a7); ss_ += __shfl_xor(ss_, 1); ss_ += __shfl_xor(ss_, 2); ss_ += __shfl_xor(ss_, 4); ss_ += __shfl_xor(ss_, 8); \
    const float r_ = 1.0f / sqrtf(ss_ * (1.f / 128.f) + EPS); u32x4 o_; o_.x = cvtpk(a0 * r_ * gk0.x, a1 * r_ * gk0.y); o_.y = cvtpk(a2 * r_ * gk0.z, a3 * r_ * gk0.w); o_.z = cvtpk(a4 * r_ * gk1.x, a5 * r_ * gk1.y); o_.w = cvtpk(a6 * r_ * gk1.z, a7 * r_ * gk1.w); \
    kv = __builtin_bit_cast(bf16x8, o_); } while (0)
#define NLOAD(k0) do { const unsigned char* kb_ = Kh + (size_t)(k0) * LDK; const unsigned char* vb_ = Vh + (size_t)(k0) * LDK; \
    vr0 = *(const u32x2*)(vb_ + lo0); vr1 = *(const u32x2*)(vb_ + lo1); kr0 = *(const u32x2*)(kb_ + lo0); kr1 = *(const u32x2*)(kb_ + lo1); } while (0)
#define NWRITE(b) do { vs0 = f8x8_to_bf16(vr0); vs1 = f8x8_to_bf16(vr1); ks0 = f8x8_to_bf16(kr0); ks1 = f8x8_to_bf16(kr1); KNORM(ks0); KNORM(ks1); *(bf16x8*)((char*)V_lds + (b) * SHM_V + vst0) = vs0; *(bf16x8*)((char*)V_lds + (b) * SHM_V + vst1) = vs1; const int kc = sc * 2; \
    *(bf16x8*)((char*)K_lds + (b) * SHM_K + KSWZ(sr, kc)) = ks0; *(bf16x8*)((char*)K_lds + (b) * SHM_K + KSWZ(32 + sr, kc)) = ks1; } while (0)
  NLOAD(0); asm volatile("s_waitcnt vmcnt(0)" ::: "memory"); NWRITE(0); __syncthreads();
  for (int j = 0; j < NT; ++j) {
    const int bsel = j & 1;
    if (j + 1 < NT) NLOAD((j + 1) * KVBLK);
    f32x16 p0, p1; float mn, al; bf16x8 pa0, pa1, pa2, pa3;
    qkt(p0, p1, (const bf16_t*)((const char*)K_lds + bsel * SHM_K), qr, r32, hi); MK(p0, p1, j);
    partialSM(p0, p1, m_reg, mn, al);
    if (__any(al < 1.f)) { if (hi == 0) al_l[r32] = al; asm volatile("s_waitcnt lgkmcnt(0)" ::: "memory");
      for (int d = 0; d < 4; ++d) for (int r = 0; r < 16; ++r) o[d][r] *= al_l[crow(r, hi)]; }
    finishSM(p0, p1, al, l_reg, pa0, pa1, pa2, pa3); SBAR();
    pv_d0(o, vb0 + bsel * (int)SHM_V, pa0, pa1, pa2, pa3);
    if (j + 1 < NT) { asm volatile("s_waitcnt vmcnt(0)" ::: "memory"); NWRITE(bsel ^ 1); }
    __syncthreads();
  }
  if (hi == 0) li_l[r32] = l_reg; asm volatile("s_waitcnt lgkmcnt(0)" ::: "memory");
  float rli[16];
#pragma unroll
  for (int r = 0; r < 16; ++r) rli[r] = __builtin_amdgcn_rcpf(li_l[crow(r, hi)]) * F8_YMUL;
  unsigned char* Ow = Ob + (long)(wid * QBLK) * LDO; const unsigned lane_off = (unsigned)(4 * hi * LDO + r32);
#pragma unroll
  for (int r = 0; r < 16; ++r) { unsigned char* rowb = Ow + ((r & 3) + 8 * (r >> 2)) * LDO;
#pragma unroll
    for (int d0 = 0; d0 < 4; ++d0) { const float v = o[d0][r] * rli[r]; rowb[lane_off + d0 * 32] = (unsigned char)(__builtin_amdgcn_cvt_pk_fp8_f32(v, v, 0, false) & 0xff); } }
#undef NLOAD
#undef NWRITE
#undef KNORM
}
constexpr int F8_KT = 8192, F8_SCR = 49152;
#define MF8(a, b, c, sa, sb) __builtin_amdgcn_mfma_scale_f32_32x32x64_f8f6f4(a, b, c, 0, 0, 0, sa, 0, sb)
#define MFPV(a, b, c, sa, sb) __builtin_amdgcn_mfma_scale_f32_32x32x64_f8f6f4(a, b, c, 3, 2, 0, sa, 0, sb)
#define MF6(a, b, c, sa, sb) __builtin_amdgcn_mfma_scale_f32_32x32x64_f8f6f4(a, b, c, 2, 2, 0, sa, 0, sb)
__device__ __forceinline__ i32x8 cat8(const i32x4 lo, const i32x4 hi) { return __builtin_shufflevector(lo, hi, 0, 1, 2, 3, 4, 5, 6, 7); }
__device__ __forceinline__ i32x8 cat6(const i32x4 lo, const i32x2 hi) { i32x8 r; r[0] = lo[0]; r[1] = lo[1]; r[2] = lo[2]; r[3] = lo[3]; r[4] = hi[0]; r[5] = hi[1]; int u0, u1; asm volatile("" : "=v"(u0), "=v"(u1)); r[6] = u0; r[7] = u1; return r; }
template <bool REL>
__device__ __forceinline__ void qkt8(f32x16& p0, f32x16& p1, const char* Kt, const i32x8 (&qf)[2], const int (&ka)[2][2], const f32x16& negm) {
  const i32x8 k00 = cat6(*(const i32x4*)(Kt + ka[0][0]), *(const i32x2*)(Kt + ka[0][1])), k10 = cat6(*(const i32x4*)(Kt + 4096 + ka[0][0]), *(const i32x2*)(Kt + 4096 + ka[0][1]));
  const i32x8 k01 = cat6(*(const i32x4*)(Kt + ka[1][0]), *(const i32x2*)(Kt + ka[1][1])), k11 = cat6(*(const i32x4*)(Kt + 4096 + ka[1][0]), *(const i32x2*)(Kt + 4096 + ka[1][1]));
  asm volatile("" ::: "memory");
  const f32x16 zero = {};
  p0 = MF6(k00, qf[0], REL ? negm : zero, 126, 123); p1 = MF6(k10, qf[0], REL ? negm : zero, 126, 123); p0 = MF6(k01, qf[1], p0, 126, 123); p1 = MF6(k11, qf[1], p1, 126, 123);
}
__device__ __forceinline__ void partial8(f32x16& p0, f32x16& p1, float& m_reg, float& alpha) {
  float pmax = p0[0]; for (int r = 1; r < 16; ++r) pmax = fmaxf(pmax, p0[r]); for (int r = 0; r < 16; ++r) pmax = fmaxf(pmax, p1[r]);
  { auto rr = __builtin_amdgcn_permlane32_swap(__float_as_uint(pmax), __float_as_uint(pmax), false, false);
    pmax = fmaxf(__uint_as_float(rr[0]), __uint_as_float(rr[1])); }
  float mn;
  if (__builtin_expect(__all(pmax - m_reg <= PTHR), 1)) { mn = m_reg; alpha = 1.f; }
  else { mn = fmaxf(m_reg, pmax) + PHEAD0; alpha = __builtin_amdgcn_exp2f(m_reg - mn); m_reg = mn; }
  const float mb = mn - 4.0f;
  for (int r = 0; r < 16; ++r) p0[r] = p0[r] - mb; for (int r = 0; r < 16; ++r) p1[r] = p1[r] - mb;
  for (int r = 0; r < 16; ++r) p0[r] = __builtin_amdgcn_exp2f(p0[r]);
}
__device__ __forceinline__ void partial8r(f32x16& p0, f32x16& p1, float& m_reg, float& alpha, f32x16& negm) {
  float pmax = p0[0]; for (int r = 1; r < 16; ++r) pmax = fmaxf(pmax, p0[r]); for (int r = 0; r < 16; ++r) pmax = fmaxf(pmax, p1[r]);
  { auto rr = __builtin_amdgcn_permlane32_swap(__float_as_uint(pmax), __float_as_uint(pmax), false, false);
    pmax = fmaxf(__uint_as_float(rr[0]), __uint_as_float(rr[1])); }
  if (__builtin_expect(__all(pmax <= 4.0f + PTHR), 1)) { alpha = 1.f; }
  else { const float d = fmaxf(pmax - 4.0f + PHEAD, 0.f); alpha = __builtin_amdgcn_exp2f(-d); m_reg += d;
    for (int r = 0; r < 16; ++r) { p0[r] -= d; p1[r] -= d; negm[r] -= d; } }
  for (int r = 0; r < 16; ++r) p0[r] = __builtin_amdgcn_exp2f(p0[r]);
}
__device__ __forceinline__ int pk4_fp8_nz(float a, float b, float c, float d, int old) { int w = __builtin_amdgcn_cvt_pk_fp8_f32(a, b, old, false); return __builtin_amdgcn_cvt_pk_fp8_f32(c, d, w, true); }
__device__ __forceinline__ void finish8(const f32x16& p0, f32x16& p1, i32x8& pa) {
  for (int r = 0; r < 16; ++r) p1[r] = __builtin_amdgcn_exp2f(p1[r]);
  typedef unsigned u32x6_ __attribute__((ext_vector_type(6)));
  const u32x6_ pk = __builtin_amdgcn_cvt_scalef32_2xpk16_bf6_f32(p0, p1, 1.0f);
#pragma unroll
  for (int i = 0; i < 6; ++i) pa[i] = (int)pk[i];
  { int u0, u1; asm volatile("" : "=v"(u0), "=v"(u1)); pa[6] = u0; pa[7] = u1; }
}
__device__ __forceinline__ void pv8(f32x16 (&o)[4], f32x16& lacc, const char* Vt, const i32x8& pa, const int (&va)[2], const i32x8& ones) {
  lacc = MFPV(pa, ones, lacc, 127, 127);
#pragma unroll
  for (int d0 = 0; d0 < 4; ++d0) { const i32x8 vf = cat6(*(const i32x4*)(Vt + d0 * 2048 + va[0]), *(const i32x2*)(Vt + d0 * 2048 + va[1]));
    o[d0] = MFPV(pa, vf, o[d0], 127, 126); }
}
struct NoConv { static constexpr bool ON = false; __device__ __forceinline__ bool on() const { return false; } __device__ __forceinline__ void step(int, int) {} __device__ __forceinline__ void end() {} };
template <int LDO, class CV>
__device__ __forceinline__ void attn_body_f8(const unsigned char* __restrict__ Q8b, const unsigned char* __restrict__ K8h, const unsigned char* __restrict__ Vt8h,
                                             unsigned char* __restrict__ Ob, int seq, char* lds, LAS unsigned char* ldsl, const int wid, CV& cvx) {
  const int lane = lane_now(), tid = wid * 64 + lane, r32 = lane & 31, hi = lane >> 5;
  char* K_lds = lds; char* V_lds = lds + 3 * F8_KT;
  float m_reg = -1e30f; f32x16 o[4] = {}; f32x16 lacc = {}; i32x8 qf[2];
  { const unsigned char* qrow = Q8b + (size_t)(wid * QBLK + r32) * HD + hi * 32;
#pragma unroll
    for (int dh = 0; dh < 2; ++dh) qf[dh] = cat8(*(const i32x4*)(qrow + dh * 64), *(const i32x4*)(qrow + dh * 64 + 16)); }
  int ka[2][2]; { const int sw = (r32 >> 1) & 7;
#pragma unroll
    for (int dh = 0; dh < 2; ++dh)
#pragma unroll
      for (int e = 0; e < 2; ++e) ka[dh][e] = r32 * 128 + (((dh * 4 + hi * 2 + e) ^ sw) << 4); }
  int va[2]; { const int sw = (r32 >> 2) & 3;
#pragma unroll
    for (int e = 0; e < 2; ++e) va[e] = r32 * 64 + (((hi * 2 + e) ^ sw) << 4); }
  const int kp_row = wid * 8 + (lane >> 3), kp_c = (lane & 7) ^ ((kp_row >> 1) & 7); const unsigned kgo = (unsigned)(kp_row * 128 + kp_c * 16);
  const int vp_d = wid * 16 + (lane >> 2), vp_c = (lane & 3) ^ ((vp_d >> 2) & 3); const unsigned vgo = (unsigned)(vp_d * 64 + vp_c * 16);
#define DMA8(slot, t) do { \
    __builtin_amdgcn_global_load_lds((const unsigned*)(K8h + (size_t)(t) * 8192 + kgo), (LAS unsigned*)(ldsl + (slot) * F8_KT + wid * 1024), 16, 0, 0); \
    __builtin_amdgcn_global_load_lds((const unsigned*)(Vt8h + (size_t)(t) * 8192 + vgo), (LAS unsigned*)(ldsl + (3 + (slot)) * F8_KT + wid * 1024), 16, 0, 0); } while (0)
#define TBAR() do { if (cvx.on()) asm volatile("s_waitcnt vmcnt(1) lgkmcnt(0)" ::: "memory"); else asm volatile("s_waitcnt vmcnt(0) lgkmcnt(0)" ::: "memory"); \
    __builtin_amdgcn_s_barrier(); asm volatile("" ::: "memory"); } while (0)
#define RESC8(a) do { if (__any((a) < 1.f)) { const int ln_ = lane_now(), r32_ = ln_ & 31, hi_ = ln_ >> 5; float* al2_ = (float*)(lds + F8_SCR) + wid * 64; \
    if (hi_ == 0) al2_[r32_] = (a); asm volatile("s_waitcnt lgkmcnt(0)" ::: "memory"); \
    for (int r = 0; r < 16; ++r) { const float f_ = al2_[crow(r, hi_)]; for (int d = 0; d < 4; ++d) o[d][r] *= f_; lacc[r] *= f_; } } } while (0)
  f32x16 pA0, pA1, pB0, pB1; float alA, alB; i32x8 pa; const int NT = seq / KVBLK;
  i32x8 ones = {(int)0x08208208, (int)0x82082082, (int)0x20820820, (int)0x08208208, (int)0x82082082, (int)0x20820820, 0, 0};
  asm volatile("" : "+v"(ones));
  DMA8(0, 0); DMA8(1, 1);
  cvx.step(0, 0);
  asm volatile("s_waitcnt vmcnt(0)" ::: "memory"); __builtin_amdgcn_s_barrier(); asm volatile("" ::: "memory");
  f32x16 negm = {};
  qkt8<false>(pA0, pA1, K_lds, qf, ka, negm); partial8(pA0, pA1, m_reg, alA);
  { const float nm = 4.0f - m_reg; for (int r = 0; r < 16; ++r) negm[r] = nm; }
  int ks = 1, vs = 0, wsl = 2;
#define RING_NEXT() do { ks = (ks == 2) ? 0 : ks + 1; vs = (vs == 2) ? 0 : vs + 1; wsl = (wsl == 2) ? 0 : wsl + 1; } while (0)
  for (int j = 1; j + 1 < NT; j += 2) {
    TBAR(); DMA8(wsl, j + 1);
    cvx.step(j, 2);
    SBAR(); qkt8<true>(pB0, pB1, K_lds + ks * F8_KT, qf, ka, negm);
    finish8(pA0, pA1, pa); SBAR();
    pv8(o, lacc, V_lds + vs * F8_KT, pa, va, ones); partial8r(pB0, pB1, m_reg, alB, negm);
    RESC8(alB); RING_NEXT();
    TBAR(); const bool more = j + 2 < NT; if (more) DMA8(wsl, j + 2);
    cvx.step(j + 1, more ? 2 : 0);
    SBAR(); qkt8<true>(pA0, pA1, K_lds + ks * F8_KT, qf, ka, negm);
    finish8(pB0, pB1, pa); SBAR();
    pv8(o, lacc, V_lds + vs * F8_KT, pa, va, ones); partial8r(pA0, pA1, m_reg, alA, negm);
    RESC8(alA); RING_NEXT();
  }
  TBAR();
  cvx.step(NT - 1, 0);
  SBAR(); qkt8<true>(pB0, pB1, K_lds + ks * F8_KT, qf, ka, negm);
  finish8(pA0, pA1, pa); SBAR();
  pv8(o, lacc, V_lds + vs * F8_KT, pa, va, ones); partial8r(pB0, pB1, m_reg, alB, negm);
  RESC8(alB); RING_NEXT();
  finish8(pB0, pB1, pa); SBAR();
  pv8(o, lacc, V_lds + vs * F8_KT, pa, va, ones);
#undef RING_NEXT
  cvx.end();
  const int le_ = lane_now();
  unsigned char* Ow = Ob + (long)(wid * QBLK) * LDO; const unsigned lane_off = (unsigned)(4 * (le_ >> 5) * LDO + (le_ & 31));
#pragma unroll
  for (int r = 0; r < 16; ++r) { unsigned char* rowb = Ow + ((r & 3) + 8 * (r >> 2)) * LDO; const float rl = __builtin_amdgcn_rcpf(lacc[r]) * F8_YMUL;
#pragma unroll
    for (int d0 = 0; d0 < 4; ++d0) { const float v = o[d0][r] * rl; rowb[lane_off + d0 * 32] = (unsigned char)(__builtin_amdgcn_cvt_pk_fp8_f32(v, v, 0, false) & 0xff); } }
#undef DMA8
#undef TBAR
#undef RESC8
}
}

#define XB_TMO      128
#define XB_XCNT(j)  (256  + 64 * (j))
#define XB_XSUB(j)  (1280 + 64 * (j))
#define XB_XGEN(j)  (2304 + 64 * (j))
#define XB_TOP      3328
#define XB_TOPGEN   3392
#define XCD_BAR_WORDS 3456
#define XB_SPIN_CAP (1u << 18)
__device__ __forceinline__ unsigned xb_ld(unsigned* p)              { return __hip_atomic_load(p, __ATOMIC_RELAXED, __HIP_MEMORY_SCOPE_AGENT); }
__device__ __forceinline__ unsigned xb_add(unsigned* p, unsigned v) { return __hip_atomic_fetch_add(p, v, __ATOMIC_RELAXED, __HIP_MEMORY_SCOPE_AGENT); }
__device__ __forceinline__ unsigned xb_xcc_id() { return (unsigned)__builtin_amdgcn_s_getreg((3 << 11) | 20) & 0xFu; }
#define XB_SPIN(cond, bar) do { unsigned _sp = 0; while (cond) { __builtin_amdgcn_s_sleep(1); \
    if ((++_sp & 255u) == 0u) { if (xb_ld(&(bar)[XB_TMO])) break; if (_sp > XB_SPIN_CAP) { atomicAdd(&(bar)[XB_TMO], 1u); break; } } } } while (0)
struct XcdBarrier { unsigned* bar; unsigned x; volatile LAS unsigned* st; };
__device__ __forceinline__ XcdBarrier xcd_barrier_post(unsigned* bar, volatile LAS unsigned* st, const bool t0) {
    XcdBarrier b; b.bar = bar; b.x = xb_xcc_id(); b.st = st;
    if (t0) (void)xb_add(&bar[XB_XCNT(b.x)], 1u);
    return b;
}
__device__ __forceinline__ void xcd_barrier_complete(unsigned* bar, unsigned x, unsigned& nloc, unsigned& nx) {
    const unsigned G = gridDim.x * gridDim.y * gridDim.z;
    unsigned sum, cnt, mine, sp = 0u;
    for (;;) {
        sum = 0u; cnt = 0u; mine = 0u;
#pragma unroll
        for (unsigned j = 0; j < 16; ++j) { const unsigned c = xb_ld(&bar[XB_XCNT(j)]); sum += c; cnt += (c > 0u) ? 1u : 0u; mine = (j == x) ? c : mine; }
        if (sum == G) break;
        __builtin_amdgcn_s_sleep(1);
        if ((++sp & 255u) == 0u) { if (xb_ld(&bar[XB_TMO])) break; if (sp > XB_SPIN_CAP) { atomicAdd(&bar[XB_TMO], 1u); break; } }
    }
    nloc = mine > 0u ? mine : 1u; nx = cnt > 0u ? cnt : 1u;
}
__device__ __forceinline__ void xcd_barrier(const XcdBarrier& b, const bool t0) {
    asm volatile("s_waitcnt vmcnt(0)" ::: "memory");
    __syncthreads();
    if (t0) {
        unsigned* bar = b.bar;
        __builtin_amdgcn_s_waitcnt(0);
        unsigned nloc = b.st[0], nx = b.st[1];
        if (nloc == 0u) { xcd_barrier_complete(bar, b.x, nloc, nx); b.st[0] = nloc; b.st[1] = nx; }
        const unsigned old = xb_add(&bar[XB_XSUB(b.x)], 1u);
        const unsigned gen = old / nloc;
        if (old + 1u == (gen + 1u) * nloc) {
            __builtin_amdgcn_fence(__ATOMIC_RELEASE, "agent");
            asm volatile("s_waitcnt vmcnt(0)" ::: "memory");
            const unsigned og = xb_add(&bar[XB_TOP], 1u);
            const unsigned tg = og / nx;
            if (og + 1u == (tg + 1u) * nx) xb_add(&bar[XB_TOPGEN], 1u);
            else XB_SPIN(xb_ld(&bar[XB_TOPGEN]) == tg, bar);
            __builtin_amdgcn_fence(__ATOMIC_ACQUIRE, "agent");
            xb_add(&bar[XB_XGEN(b.x)], 1u);
            asm volatile("s_waitcnt vmcnt(0)" ::: "memory");
        } else {
            XB_SPIN(xb_ld(&bar[XB_XGEN(b.x)]) == gen, bar);
            __builtin_amdgcn_fence(__ATOMIC_ACQUIRE, "agent");
            asm volatile("s_waitcnt vmcnt(0)" ::: "memory");
        }
    }
    __syncthreads();
}

struct Frame {
    LAS unsigned char* lds;
    volatile LAS unsigned* MISC;
    gu32* ctl;
    int tid, lane, wave, G, bx;
    float* out; unsigned char* ws;
};
__device__ __forceinline__ const float* inp(int k) {
    const __attribute__((address_space(4))) char* kp = (const __attribute__((address_space(4))) char*)__builtin_amdgcn_kernarg_segment_ptr();
    asm volatile("" : "+s"(kp));
    return *(const float* const __attribute__((address_space(4)))*)(kp + 8 * k);
}
__device__ __forceinline__ float wave_sum(float v) {
#pragma unroll
    for (int o = 1; o < 64; o <<= 1) v += __shfl_xor(v, o);
    return v;
}
__device__ __forceinline__ unsigned f2bf(float f) { unsigned u = __builtin_bit_cast(unsigned, f); return (u + 0x7fffu + ((u >> 16) & 1u)) >> 16; }
__device__ __forceinline__ unsigned pk2(float lo, float hi) { return f2bf(lo) | (f2bf(hi) << 16); }

__device__ __forceinline__ void tr_item(const float* W, int N, bf16_t* WT, int K, int k0, int n0, size_t dst_row0, LAS float* scr, int lane) {
#pragma unroll
    for (int i = 0; i < 32; ++i) { const int kk = 2 * i + (lane >> 5); scr[kk * 33 + (lane & 31)] = W[(size_t)(k0 + kk) * N + n0 + (lane & 31)]; }
    LDS_WAIT(); asm volatile("" ::: "memory");
    const int c = lane & 7;
#pragma unroll
    for (int j = 0; j < 4; ++j) { const int n = (lane >> 3) + 8 * j; const LAS float* s = scr + (8 * c) * 33 + n;
        u32x4 o; o.x = pk2(s[0 * 33], s[1 * 33]); o.y = pk2(s[2 * 33], s[3 * 33]); o.z = pk2(s[4 * 33], s[5 * 33]); o.w = pk2(s[6 * 33], s[7 * 33]);
        *(GAS u32x4*)(WT + (dst_row0 + n) * K + k0 + 8 * c) = o; }
    LDS_WAIT(); asm volatile("" ::: "memory");
}
template <bool KG> __device__ __forceinline__ void tr_item_f8(const float* W, int N, unsigned char* WT, int K, int k0, int n0, size_t dst_row0, LAS float* scr, int lane, const float* kg = nullptr) {
#pragma unroll
    for (int i = 0; i < 32; ++i) { const int kk = 2 * i + (lane >> 5); scr[kk * 33 + (lane & 31)] = W[(size_t)(k0 + kk) * N + n0 + (lane & 31)]; }
    LDS_WAIT(); asm volatile("" ::: "memory");
    const int c = lane & 7;
    f32x4 m0 = {F8_WMUL, F8_WMUL, F8_WMUL, F8_WMUL}, m1 = m0;
    if (KG) { m0 = *(const f32x4*)(kg + k0 + 8 * c) * F8_WMUL; m1 = *(const f32x4*)(kg + k0 + 8 * c + 4) * F8_WMUL; }
#pragma unroll
    for (int j = 0; j < 4; ++j) { const int n = (lane >> 3) + 8 * j; const LAS float* s = scr + (8 * c) * 33 + n;
        u32x2 o; o.x = pk4_fp8(s[0 * 33] * m0.x, s[1 * 33] * m0.y, s[2 * 33] * m0.z, s[3 * 33] * m0.w); o.y = pk4_fp8(s[4 * 33] * m1.x, s[5 * 33] * m1.y, s[6 * 33] * m1.z, s[7 * 33] * m1.w);
        *(GAS u32x2*)(WT + (dst_row0 + n) * K + k0 + 8 * c) = o; }
    LDS_WAIT(); asm volatile("" ::: "memory");
}
__device__ __forceinline__ void rms_row_to_fp8(int lane, const float* xrow, const float* g, unsigned char* orow) {
    const GAS f32x4* xr = (const GAS f32x4*)xrow + lane; const GAS f32x4* gr = (const GAS f32x4*)g + lane;
    f32x4 v[8]; float s = 0.f;
#pragma unroll
    for (int j = 0; j < 8; ++j) { v[j] = xr[64 * j]; s += (v[j].x * v[j].x + v[j].y * v[j].y) + (v[j].z * v[j].z + v[j].w * v[j].w); }
    const float rstd = 1.0f / sqrtf(wave_sum(s) * (1.f / D) + EPS);
    GAS unsigned* o8 = (GAS unsigned*)orow + lane;
#pragma unroll
    for (int j = 0; j < 8; ++j) { const f32x4 gg = gr[64 * j]; o8[64 * j] = pk4_fp8(v[j].x * rstd * gg.x, v[j].y * rstd * gg.y, v[j].z * rstd * gg.z, v[j].w * rstd * gg.w); }
}
__device__ __forceinline__ void sincos_d(double a, float& c, float& s) {
    const double TWO_OVER_PI = 0.63661977236758134308, PIO2_HI = 1.57079632679489655800e+00, PIO2_LO = 6.12323399573676603587e-17;
    const double q = __builtin_rint(a * TWO_OVER_PI); const double r = (a - q * PIO2_HI) - q * PIO2_LO; const int n = (int)q & 3;
    const double r2 = r * r;
    double sp = -1.0 / 1307674368000.0; sp = sp * r2 + 1.0 / 6227020800.0; sp = sp * r2 - 1.0 / 39916800.0; sp = sp * r2 + 1.0 / 362880.0; sp = sp * r2 - 1.0 / 5040.0; sp = sp * r2 + 1.0 / 120.0; sp = sp * r2 - 1.0 / 6.0; sp = sp * r2 + 1.0;
    const double sn = sp * r;
    double cp = 1.0 / 20922789888000.0; cp = cp * r2 - 1.0 / 87178291200.0; cp = cp * r2 + 1.0 / 479001600.0; cp = cp * r2 - 1.0 / 3628800.0; cp = cp * r2 + 1.0 / 40320.0; cp = cp * r2 - 1.0 / 720.0; cp = cp * r2 + 1.0 / 24.0; cp = cp * r2 - 0.5; cp = cp * r2 + 1.0;
    const double cs = cp;
    double so, co;
    if (n == 0) { so = sn; co = cs; } else if (n == 1) { so = cs; co = -sn; } else if (n == 2) { so = -sn; co = -cs; } else { so = -cs; co = sn; }
    c = (float)co; s = (float)so;
}
__device__ __forceinline__ double inv_freq_d(int f) {
    const double t[32] = {1.0, 0.7498942093324559, 0.5623413251903491, 0.4216965034285822, 0.31622776601683794, 0.23713737056616552, 0.1778279410038923, 0.1333521432163324, 0.09999999999999999, 0.07498942093324558, 0.056234132519034905, 0.042169650342858224, 0.03162277660168379, 0.023713737056616554, 0.01778279410038923, 0.013335214321633239, 0.01, 0.007498942093324559, 0.005623413251903491, 0.004216965034285822, 0.0031622776601683794, 0.002371373705661655, 0.0017782794100389228, 0.0013335214321633238, 0.001, 0.0007498942093324559, 0.000562341325190349, 0.00042169650342858224, 0.00031622776601683794, 0.00023713737056616554, 0.0001778279410038923, 0.0001333521432163324};
    double r = t[0];
#pragma unroll
    for (int i = 1; i < 32; ++i) r = (f == i) ? t[i] : r;
    return r;
}

struct P0Item { const float* src; unsigned char* dst; const float* kg; int N, K, k0, n0; size_t drow0; };
__device__ __forceinline__ void p0_decode(int it, unsigned char* ws, P0Item& d) {
    constexpr int I_IN = 32 * 272, I_PA = 16 * 64, I_OUT = 32 * 64, I_EX = NE * 32 * 64;
    int r = it; d.kg = nullptr;
    if (r < I_IN) { const int kb = r / 272, nb = r % 272; d.src = inp(2); d.N = NCOLS; d.dst = ws + WS_WIN; d.K = D; d.k0 = 64 * kb; d.n0 = 32 * nb; d.drow0 = (size_t)32 * nb; return; } r -= I_IN;
    if (r < I_PA) { const int kb = r / 64, nb = r % 64; d.src = inp(8); d.N = D; d.dst = ws + WS_WPA; d.K = 1024; d.k0 = 64 * kb; d.n0 = 32 * nb; d.drow0 = (size_t)32 * nb; return; } r -= I_PA;
    if (r < I_PA) { const int kb = r / 64, nb = r % 64; d.src = inp(9); d.N = D; d.dst = ws + WS_WPB; d.K = 1024; d.k0 = 64 * kb; d.n0 = 32 * nb; d.drow0 = (size_t)32 * nb; return; } r -= I_PA;
    if (r < I_OUT) { const int kb = r / 64, nb = r % 64; d.src = inp(10); d.N = D; d.dst = ws + WS_WOUT; d.K = D; d.k0 = 64 * kb; d.n0 = 32 * nb; d.drow0 = (size_t)32 * nb; return; } r -= I_OUT;
    const int which = r / I_EX; r -= which * I_EX; const int e = r / 2048, rr = r % 2048, kb = rr / 64, nb = rr % 64, n0 = 32 * nb;
    d.k0 = 64 * kb; d.n0 = n0;
    if (which == 0) { d.src = inp(14) + (size_t)e * D * DE; d.N = DE; d.dst = ws + WS_WGU + (size_t)e * 4096 * D; d.K = D; d.drow0 = (size_t)((n0 >> 7) * 256 + (n0 & 127)); d.kg = inp(11); }
    else if (which == 1) { d.src = inp(16) + (size_t)e * D * DE; d.N = DE; d.dst = ws + WS_WGU + (size_t)e * 4096 * D; d.K = D; d.drow0 = (size_t)((n0 >> 7) * 256 + 128 + (n0 & 127)); d.kg = inp(11); }
    else { d.src = inp(18) + (size_t)e * DE * D; d.N = D; d.dst = ws + WS_WD + (size_t)e * 2048 * DE; d.K = DE; d.drow0 = (size_t)n0; }
}
__device__ __forceinline__ void p0_load(const P0Item& d, float (&v)[32], int lane) {
    const float* p = d.src + (size_t)(d.k0 + (lane >> 5)) * d.N + d.n0 + (lane & 31);
#pragma unroll
    for (int i = 0; i < 32; ++i) v[i] = p[(size_t)(2 * i) * d.N];
}
__device__ __forceinline__ void p0_finish(const P0Item& d, const float (&v)[32], LAS float* scr, int lane) {
#pragma unroll
    for (int i = 0; i < 32; ++i) scr[(2 * i + (lane >> 5)) * 33 + (lane & 31)] = v[i];
    LDS_WAIT(); asm volatile("" ::: "memory");
    const int c = lane & 7;
    f32x4 m0 = {F8_WMUL, F8_WMUL, F8_WMUL, F8_WMUL}, m1 = m0;
    if (d.kg) { m0 = *(const f32x4*)(d.kg + d.k0 + 8 * c) * F8_WMUL; m1 = *(const f32x4*)(d.kg + d.k0 + 8 * c + 4) * F8_WMUL; }
#pragma unroll
    for (int j = 0; j < 4; ++j) { const int n = (lane >> 3) + 8 * j; const LAS float* s = scr + (8 * c) * 33 + n;
        u32x2 o; o.x = pk4_fp8(s[0 * 33] * m0.x, s[1 * 33] * m0.y, s[2 * 33] * m0.z, s[3 * 33] * m0.w); o.y = pk4_fp8(s[4 * 33] * m1.x, s[5 * 33] * m1.y, s[6 * 33] * m1.z, s[7 * 33] * m1.w);
        *(GAS u32x2*)(d.dst + (d.drow0 + n) * d.K + d.k0 + 8 * c) = o; }
    LDS_WAIT(); asm volatile("" ::: "memory");
}
constexpr int P0_I_FIRST = 32 * 272 + 2 * 16 * 64 + 32 * 64, P0_I_ALL = P0_I_FIRST + 3 * NE * 32 * 64;
struct ConvW {
    static constexpr bool ON = true;
    const float* src0; unsigned char* dst0; size_t sstride, dstride; int N, K, k0; size_t drow0; bool kgf, act;
    LAS float* scr; const LAS float* gl;
    __device__ __forceinline__ void init(unsigned char* ws, int unit, int slot) {
        P0Item d; p0_decode(P0_I_FIRST + (unit * 32) * 2048 + slot, ws, d);
        src0 = d.src + (size_t)d.k0 * d.N + d.n0; dst0 = d.dst; N = d.N; K = d.K; k0 = d.k0; drow0 = d.drow0; kgf = d.kg != nullptr;
        sstride = (size_t)D * DE; dstride = (unit < 2) ? (size_t)4096 * D : (size_t)2048 * DE;
    }
    __device__ __forceinline__ bool on() const { return act; }
    __device__ __forceinline__ void finish(int q) {
        const int lane = lane_now(), c = lane & 7;
        f32x4 m0 = {F8_WMUL, F8_WMUL, F8_WMUL, F8_WMUL}, m1 = m0;
        if (kgf) { m0 = *(const LAS f32x4*)(gl + k0 + 8 * c) * F8_WMUL; m1 = *(const LAS f32x4*)(gl + k0 + 8 * c + 4) * F8_WMUL; }
        unsigned char* dq = dst0 + (size_t)q * dstride;
#pragma unroll
        for (int j = 0; j < 4; ++j) { const int n = (lane >> 3) + 8 * j; const LAS float* s = scr + c * 256 + ((((n >> 2) + c) & 7) << 2) + (n & 3);
            u32x2 o; o.x = pk4_fp8(s[0 * 32] * m0.x, s[1 * 32] * m0.y, s[2 * 32] * m0.z, s[3 * 32] * m0.w); o.y = pk4_fp8(s[4 * 32] * m1.x, s[5 * 32] * m1.y, s[6 * 32] * m1.z, s[7 * 32] * m1.w);
            __builtin_nontemporal_store(o, (GAS u32x2*)(dq + (drow0 + n) * K + k0 + 8 * c)); }
    }
    __device__ __forceinline__ void step(int c, int newer) {
        if (!act) return;
        if ((c & 7) == 0 && c > 0) { if (newer == 2) asm volatile("s_waitcnt vmcnt(2)" ::: "memory"); else asm volatile("s_waitcnt vmcnt(0)" ::: "memory");
            finish((c >> 3) - 1); }
        const int lane = lane_now(), sblk = c & 7;
        const float* src = src0 + (size_t)(c >> 3) * sstride + (size_t)(8 * sblk + (lane >> 3)) * N + 4 * (((lane & 7) - sblk) & 7);
        __builtin_amdgcn_global_load_lds((const unsigned*)src, (LAS unsigned*)(scr + sblk * 256), 16, 0, 2);
    }
    __device__ __forceinline__ void end() { if (!act) return; asm volatile("s_waitcnt vmcnt(0)" ::: "memory"); finish(31); }
};
__device__ __forceinline__ void p0_prologue(Frame& F) {
    LAS float* scr = (LAS float*)(F.lds + RING_OFF + F.wave * 16384);
    const int gw = F.bx * NWAVES + F.wave, NGW = F.G * NWAVES;
    unsigned char* ws = F.ws;
    const int NITEMS = (F.G == 256) ? P0_I_FIRST : P0_I_ALL;
    { P0Item A, B; float va[32], vb[32]; int it = gw;
      if (it < NITEMS) { p0_decode(it, ws, A); p0_load(A, va, F.lane);
        for (;;) {
            const bool hb = it + NGW < NITEMS; if (hb) { p0_decode(it + NGW, ws, B); p0_load(B, vb, F.lane); }
            p0_finish(A, va, scr, F.lane); if (!hb) break;
            it += 2 * NGW; const bool ha = it < NITEMS; if (ha) { p0_decode(it, ws, A); p0_load(A, va, F.lane); }
            p0_finish(B, vb, scr, F.lane); if (!ha) break;
        } } }
    for (int m = gw; m < NTOK; m += NGW) rms_row_to_fp8(F.lane, inp(0) + (size_t)m * D, inp(1), (unsigned char*)(ws + WS_H) + (size_t)m * D);
    { float* tab = (float*)(ws + WS_TAB); const int gid = F.bx * 512 + F.tid;
      if (gid < 320 * 32) { const int pos = gid >> 5, f = gid & 31; const int p = pos < 256 ? pos : pos - 256; float c, s; sincos_d((double)p * inv_freq_d(f), c, s);
        if (pos < 256) { tab[pos * 32 + f] = c; tab[8192 + pos * 32 + f] = s; } else { tab[16384 + p * 32 + f] = c; tab[16384 + 2048 + p * 32 + f] = s; } } }
}

__device__ __forceinline__ void p2_qknorm(Frame& F) {
    const float* tab = (const float*)(F.ws + WS_TAB);
    const int l16 = F.lane & 15, g4 = F.lane >> 4, gw = F.bx * NWAVES + F.wave, NGW = F.G * NWAVES;
    constexpr int R_QA = 2 * 8 * SEQ, R_KA = 2 * 2 * SEQ, NCH = (R_QA + R_KA) / 16;
    const int axis = l16 >> 3, half = (l16 >> 2) & 1;
    const int cch = gw, cstep = NGW, cend = NCH;
    u32x2 w[4];
#define P2_LOAD(dst, chx) do { int r_ = (chx) * 16; const unsigned char* b_ = F.ws + WS_QA; if (r_ >= R_QA) { r_ -= R_QA; b_ = F.ws + WS_KA; } \
        _Pragma("unroll") for (int k = 0; k < 4; ++k) dst[k] = *(const u32x2*)(b_ + (size_t)(r_ + 4 * k + g4) * HD + 8 * l16); } while (0)
    if (cch < cend) P2_LOAD(w, cch);
    for (int ch = cch; ch < cend; ch += cstep) {
        int r0 = ch * 16; const float* g; unsigned char* o8; float omul = 1.0f;
        if (r0 < R_QA) { g = inp(3); o8 = F.ws + WS_Q8; omul = att::QMUL; }
        else { r0 -= R_QA; g = inp(4); o8 = F.ws + WS_K8; omul = att::KMUL; }
        u32x2 wn[4];
#pragma unroll
        for (int k = 0; k < 4; ++k) wn[k] = w[k];
        if (ch + cstep < cend) P2_LOAD(wn, ch + cstep);
        const f32x4 g0 = *(const f32x4*)(g + 8 * l16), g1 = *(const f32x4*)(g + 8 * l16 + 4);
#pragma unroll
        for (int k = 0; k < 4; ++k) {
            const int row = r0 + 4 * k + g4;
            float x[8] = {F8D(w[k].x, 0), F8D(w[k].x, 1), F8D(w[k].x, 2), F8D(w[k].x, 3), F8D(w[k].y, 0), F8D(w[k].y, 1), F8D(w[k].y, 2), F8D(w[k].y, 3)};
            float ss = 0.f;
#pragma unroll
            for (int i = 0; i < 8; ++i) ss += x[i] * x[i];
            ss += __shfl_xor(ss, 1); ss += __shfl_xor(ss, 2); ss += __shfl_xor(ss, 4); ss += __shfl_xor(ss, 8);
            const float rstd = 1.0f / sqrtf(ss * (1.f / 128.f) + EPS);
#pragma unroll
            for (int i = 0; i < 4; ++i) { x[i] = x[i] * rstd * g0[i]; x[4 + i] = x[4 + i] * rstd * g1[i]; }
            const int sq = row & (SEQ - 1), pos = axis ? (sq & 63) : (sq >> 6);
            const float* ct = tab + (axis ? 16384 : 0) + pos * 32 + 8 * (l16 & 3); const float* st = ct + (axis ? 2048 : 8192);
            const f32x4 c0 = *(const f32x4*)ct, c1 = *(const f32x4*)(ct + 4), s0 = *(const f32x4*)st, s1 = *(const f32x4*)(st + 4);
            float y[8];
#pragma unroll
            for (int i = 0; i < 8; ++i) { const float pr = __shfl_xor(x[i], 4); const float cc = i < 4 ? c0[i & 3] : c1[i & 3], sn = i < 4 ? s0[i & 3] : s1[i & 3];
                y[i] = half ? (x[i] * cc + pr * sn) : (x[i] * cc - pr * sn); }
            const unsigned a24 = f6pack24(f6x4_bytes(y[0], y[1], y[2], y[3], omul)), b24 = f6pack24(f6x4_bytes(y[4], y[5], y[6], y[7], omul));
            const unsigned lo = a24 | (b24 << 24), hi16 = b24 >> 8;
            const unsigned plo = (unsigned)__builtin_amdgcn_update_dpp(0, (int)lo, 0xB1, 0xf, 0xf, false), phi = (unsigned)__builtin_amdgcn_update_dpp(0, (int)hi16, 0xB1, 0xf, 0xf, false);
            if (!(l16 & 1)) { unsigned* dst = (unsigned*)(o8 + (size_t)row * HD + (l16 >> 2) * 32 + ((l16 & 3) >> 1) * 12);
                dst[0] = lo; dst[1] = hi16 | (plo << 16); dst[2] = (plo >> 16) | (phi << 16); }
        }
#pragma unroll
        for (int k = 0; k < 4; ++k) w[k] = wn[k];
    }
#undef P2_LOAD
    LAS unsigned char* vt = F.lds + RING_OFF + F.wave * 16384;
    for (int T = gw; T < 2 * 2 * (SEQ / 64); T += NGW) {
        const unsigned char* vsrc = F.ws + WS_VA + ((size_t)T * 64 + F.lane) * HD;
#pragma unroll
        for (int c = 0; c < 16; ++c) { const u32x2 w = *(const u32x2*)(vsrc + 8 * c);
            u32x2 q;
            q.x = f6x4_bytes(F8D(w.x, 0), F8D(w.x, 1), F8D(w.x, 2), F8D(w.x, 3), att::VMUL); q.y = f6x4_bytes(F8D(w.y, 0), F8D(w.y, 1), F8D(w.y, 2), F8D(w.y, 3), att::VMUL);
            *(LAS u32x2*)(vt + F.lane * 144 + 8 * c) = q; }
        LDS_WAIT(); asm volatile("" ::: "memory");
#pragma unroll
        for (int dd = 0; dd < 2; ++dd) { const int d = F.lane + 64 * dd;
            unsigned char* dst = F.ws + WS_VT8 + (size_t)T * 8192 + (size_t)d * 64;
#pragma unroll
            for (int hh = 0; hh < 2; ++hh) { unsigned wv[6] = {0u, 0u, 0u, 0u, 0u, 0u};
#pragma unroll
                for (int j = 0; j < 32; ++j) { const int key = (j < 16) ? att::crow(j, hh) : 32 + att::crow(j - 16, hh); const unsigned code = vt[key * 144 + d];
                    const int fld = (j < 16) ? 2 * j : 2 * (j - 16) + 1;
                    const int bit = 6 * fld, wi = bit >> 5, sh = bit & 31; wv[wi] |= code << sh; if (sh > 26) wv[wi + 1] |= code >> (32 - sh); }
                *(u32x4*)(dst + 32 * hh) = (u32x4){wv[0], wv[1], wv[2], wv[3]}; *(u32x2*)(dst + 32 * hh + 16) = (u32x2){wv[4], wv[5]}; } }
        LDS_WAIT(); asm volatile("" ::: "memory");
    }
}

__device__ __forceinline__ void p3_attention(Frame& F, char* lds) {
    unsigned char* ya = (unsigned char*)(F.ws + WS_YA); unsigned char* yb = (unsigned char*)(F.ws + WS_YB);
    { const int tl = F.wave * 64 + lane_now(); *(LAS f32x4*)(F.lds + RING_OFF + 116736 + tl * 16) = *(const f32x4*)(inp(11) + tl * 4); }
    for (int i = 0; ; ++i) {
        int b, h, qb;
        if (F.G == 256) { if (i >= 4) break; const int x = F.bx & 7, combo = x & 3, cu = (x >> 2) * 32 + (F.bx >> 3); b = combo >> 1; h = (combo & 1) * 4 + i; qb = cu; }
        else { const int u = F.bx + i * F.G; if (u >= 1024) break; b = u >> 9; h = (u >> 6) & 7; qb = u & 63; }
        const size_t t0 = (size_t)b * SEQ;
        __syncthreads();
        ConvW cvx; cvx.scr = (LAS float*)(F.lds + RING_OFF + 51200 + F.wave * 8192); cvx.gl = (const LAS float*)(F.lds + RING_OFF + 116736);
        cvx.act = (F.G == 256) && (i < 3); cvx.init(F.ws, i < 3 ? i : 0, F.bx * NWAVES + F.wave);
        att::attn_body_f8<1024, ConvW>(F.ws + WS_Q8 + ((size_t)(b * 8 + h) * SEQ + (size_t)qb * 256) * HD, F.ws + WS_K8 + (size_t)(b * 2 + (h >> 2)) * SEQ * HD,
                                F.ws + WS_VT8 + (size_t)(b * 2 + (h >> 2)) * (SEQ / 64) * 8192, ya + (t0 + (size_t)qb * 256) * 1024 + 128 * h, SEQ, lds, F.lds + RING_OFF, F.wave, cvx);
    }
    float* bias_l = (float*)(lds + att::BIAS_OFF);
    for (int i = 0; ; ++i) {
        const int u = F.bx + i * F.G; if (u >= 1024) break;
        const int b = u >> 9, h = (u >> 6) & 7, rb = u & 63, R0 = rb * 4;
        int kr0 = R0 - 4; kr0 = kr0 < 0 ? 0 : (kr0 > ROWS - 12 ? ROWS - 12 : kr0);
        __syncthreads();
        const int lane = lane_now(), wid = F.wave, tl = wid * 64 + lane;
        if (tl < 15 * 32) { const int ro = tl >> 5, co = tl & 31; bias_l[tl] = co < 31 ? inp(7)[(h * 15 + ro) * 31 + co] * (1.0f / att::SCALE) : 0.f; }
        const size_t t0 = (size_t)b * SEQ;
        const int c = 32 * (wid & 1) + (lane & 31); int cs = c - 8; cs = cs < 0 ? 0 : (cs > GW - 16 ? GW - 16 : cs);
        att::NaMask mk{bias_l, kr0, R0 + (wid >> 1), c, cs, lane >> 5};
        att::attn_body_simple<HD, HD, 1024, att::NaMask>(F.ws + WS_QB + ((size_t)(b * 8 + h) * SEQ + (size_t)R0 * 64) * HD, F.ws + WS_KB + ((size_t)(b * 8 + h) * SEQ + (size_t)kr0 * 64) * HD,
                                                            F.ws + WS_VB + ((size_t)(b * 8 + h) * SEQ + (size_t)kr0 * 64) * HD, yb + (t0 + (size_t)R0 * 64) * 1024 + 128 * h, 12, lds, mk, F.wave, inp(5), inp(6));
    }
}

__device__ __forceinline__ void p6_router(Frame& F) {
    const bf16_t* x1 = (const bf16_t*)(F.ws + WS_X1B); const float* g2 = inp(11); const float* wr = inp(12); const float* br = inp(13);
    unsigned char* h2 = (unsigned char*)(F.ws + WS_H8);
    LAS unsigned char* tile = F.lds + RING_OFF;
    LAS float* part = (LAS float*)(F.lds + PART_OFF);
    LAS unsigned* asg = (LAS unsigned*)(F.lds + ASG_OFF);
    LAS unsigned* hist = (LAS unsigned*)(F.lds + HIST_OFF);
    const int lane = F.lane, w = F.wave, row = lane & 15, kq = lane >> 4;
    if (F.tid < 64) hist[F.tid] = 0u;
    float Breg[16][4][2];
#pragma unroll
    for (int s = 0; s < 16; ++s)
#pragma unroll
        for (int i = 0; i < 4; ++i)
#pragma unroll
            for (int hf = 0; hf < 2; ++hf) { const int k = 256 * w + 16 * s + 4 * kq + i; Breg[s][i][hf] = wr[(size_t)k * NE + row + 16 * hf] * g2[k]; }
    int nasg = 0;
    u32x2 va[8], vb[8];
    const unsigned lofs = (unsigned)lane * 16u;
    { const int ch = F.bx; if (ch < NTOK / 16) { const char* xa = (const char*)(x1 + ((size_t)ch * 16 + 2 * w) * D);
#pragma unroll
        for (int j = 0; j < 8; ++j) { va[j] = *(const u32x2*)(xa + (lofs >> 1) + 512 * j); vb[j] = *(const u32x2*)(xa + 4096 + (lofs >> 1) + 512 * j); } } }
    for (int ch = F.bx; ch < NTOK / 16; ch += F.G) {
        __syncthreads();
#define P6_ROW(vr, tt) do { const int tl = 2 * w + (tt); const size_t tok = (size_t)ch * 16 + tl; float ss = 0.f; f32x4 v[8]; \
            _Pragma("unroll") for (int j = 0; j < 8; ++j) { v[j] = (f32x4){bf_lo(vr[j].x), bf_hi(vr[j].x), bf_lo(vr[j].y), bf_hi(vr[j].y)}; ss += (v[j].x * v[j].x + v[j].y * v[j].y) + (v[j].z * v[j].z + v[j].w * v[j].w); } \
            const float rstd = 1.0f / sqrtf(wave_sum(ss) * (1.f / D) + EPS); unsigned char* o8 = h2 + tok * D; \
            _Pragma("unroll") for (int j = 0; j < 8; ++j) { const f32x4 y = v[j] * rstd;     \
                *(unsigned*)(o8 + (lofs >> 2) + 256 * j) = pk4_fp8(y.x, y.y, y.z, y.w); *(LAS f32x4*)(tile + tl * 8192 + (((lofs >> 4) ^ tl) << 4) + 1024 * j) = y; } } while (0)
        P6_ROW(va, 0); P6_ROW(vb, 1);
#undef P6_ROW
        __syncthreads();
        { const int chn = ch + F.G; if (chn < NTOK / 16) { const char* xa = (const char*)(x1 + ((size_t)chn * 16 + 2 * w) * D);
            const unsigned lo2 = (unsigned)lane_now() * 16u;
#pragma unroll
            for (int j = 0; j < 8; ++j) { va[j] = *(const u32x2*)(xa + (lo2 >> 1) + 512 * j); vb[j] = *(const u32x2*)(xa + 4096 + (lo2 >> 1) + 512 * j); } } }
        f32x4 a0 = {0.f, 0.f, 0.f, 0.f}, a1 = {0.f, 0.f, 0.f, 0.f};
        f32x4 ab[2][2];
        unsigned abase[4];
        { const int ln = lane_now(), rw = ln & 15, kk = ln >> 4;
#pragma unroll
          for (int q = 0; q < 4; ++q) abase[q] = (unsigned)(rw * 8192 + ((64 * w + ((4 * q + kk) ^ rw)) << 4)); }
#define P6_LDA(g) do { _Pragma("unroll") for (int q = 0; q < 2; ++q) { const int s_ = 2 * (g) + q; ab[(g) & 1][q] = *(const LAS f32x4*)(tile + abase[s_ & 3] + (s_ >> 2) * 256); } } while (0)
        P6_LDA(0);
#pragma unroll
        for (int g = 0; g < 8; ++g) {
            if (g < 7) P6_LDA(g + 1);
#pragma unroll
            for (int q = 0; q < 2; ++q)
#pragma unroll
                for (int i = 0; i < 4; ++i) { a0 = __builtin_amdgcn_mfma_f32_16x16x4f32(ab[g & 1][q][i], Breg[2 * g + q][i][0], a0, 0, 0, 0); a1 = __builtin_amdgcn_mfma_f32_16x16x4f32(ab[g & 1][q][i], Breg[2 * g + q][i][1], a1, 0, 0, 0); }
            __builtin_amdgcn_sched_barrier(0);
        }
#undef P6_LDA
#pragma unroll
        for (int j = 0; j < 4; ++j) { part[(w * 16 + 4 * kq + j) * 32 + row] = a0[j]; part[(w * 16 + 4 * kq + j) * 32 + 16 + row] = a1[j]; }
        __syncthreads();
        { const int tl = F.tid >> 5, e = F.tid & 31; float lg = br[e];
#pragma unroll
          for (int ww = 0; ww < 8; ++ww) lg += part[(ww * 16 + tl) * 32 + e];
          float tv[4]; int ti[4]; bool taken = false;
#pragma unroll
          for (int r = 0; r < 4; ++r) { float bv = taken ? -__builtin_inff() : lg; int bi = e;
#define P6_STEP(EXPR_F, EXPR_I) do { const float ov = __int_as_float(EXPR_F); const int oi = (EXPR_I); if (ov > bv || (ov == bv && oi < bi)) { bv = ov; bi = oi; } } while (0)
#define P6_DPP(v, c) __builtin_amdgcn_update_dpp((v), (v), (c), 0xf, 0xf, false)
              P6_STEP(P6_DPP(__float_as_int(bv), 0xB1), P6_DPP(bi, 0xB1));
              P6_STEP(P6_DPP(__float_as_int(bv), 0x4E), P6_DPP(bi, 0x4E));
              P6_STEP(P6_DPP(__float_as_int(bv), 0x141), P6_DPP(bi, 0x141));
              P6_STEP(P6_DPP(__float_as_int(bv), 0x140), P6_DPP(bi, 0x140));
              P6_STEP(__builtin_amdgcn_ds_swizzle(__float_as_int(bv), 0x401F), __builtin_amdgcn_ds_swizzle(bi, 0x401F));
#undef P6_STEP
#undef P6_DPP
              tv[r] = bv; ti[r] = bi; if (bi == e) taken = true; }
          const float e1 = __expf(tv[1] - tv[0]), e2 = __expf(tv[2] - tv[0]), e3 = __expf(tv[3] - tv[0]); const float inv = 1.0f / (1.0f + e1 + e2 + e3);
          if (e < 4) { const float wt = (e == 0 ? 1.0f : e == 1 ? e1 : e == 2 ? e2 : e3) * inv; const int ex = e == 0 ? ti[0] : e == 1 ? ti[1] : e == 2 ? ti[2] : ti[3];
              const int n = nasg * 64 + tl * 4 + e; asg[n * 4 + 0] = (unsigned)(ch * 16 + tl) * 4u + (unsigned)e; asg[n * 4 + 1] = (unsigned)ex; asg[n * 4 + 2] = __float_as_uint(wt); } }
        ++nasg;
        if (nasg == 8) {
            __syncthreads();
            const int tf = F.wave * 64 + lane_now();
            { const unsigned ex = asg[tf * 4 + 1]; asg[tf * 4 + 3] = __hip_atomic_fetch_add((LAS unsigned*)&hist[ex], 1u, __ATOMIC_RELAXED, __HIP_MEMORY_SCOPE_WORKGROUP); }
            __syncthreads();
            if (tf < 32) { const unsigned n = hist[tf]; hist[32 + tf] = n ? __hip_atomic_fetch_add((unsigned*)(F.ctl + CW_CNT + 64 * tf), n, RLX_AGENT) : 0u; }
            __syncthreads();
            { const unsigned tk = asg[tf * 4 + 0], ex = asg[tf * 4 + 1], wb = asg[tf * 4 + 2], pos = hist[32 + ex] + asg[tf * 4 + 3];
              ((int*)(F.ws + WS_LTOK))[(size_t)ex * LCAP + pos] = (int)(tk >> 2); ((unsigned*)(F.ws + WS_LW))[(size_t)ex * LCAP + pos] = wb;
              ((unsigned*)(F.ws + WS_TOKEP))[tk] = (ex << 16) | pos; }
            __syncthreads();
            if (tf < 64) hist[tf] = 0u;
            nasg = 0;
        }
    }
    if (nasg) {
        __syncthreads();
        const int tf = F.wave * 64 + lane_now();
        const bool act = tf < nasg * 64;
        if (act) { const unsigned ex = asg[tf * 4 + 1]; asg[tf * 4 + 3] = __hip_atomic_fetch_add((LAS unsigned*)&hist[ex], 1u, __ATOMIC_RELAXED, __HIP_MEMORY_SCOPE_WORKGROUP); }
        __syncthreads();
        if (tf < 32) { const unsigned n = hist[tf]; hist[32 + tf] = n ? __hip_atomic_fetch_add((unsigned*)(F.ctl + CW_CNT + 64 * tf), n, RLX_AGENT) : 0u; }
        __syncthreads();
        if (act) { const unsigned tk = asg[tf * 4 + 0], ex = asg[tf * 4 + 1], wb = asg[tf * 4 + 2], pos = hist[32 + ex] + asg[tf * 4 + 3];
          ((int*)(F.ws + WS_LTOK))[(size_t)ex * LCAP + pos] = (int)(tk >> 2); ((unsigned*)(F.ws + WS_LW))[(size_t)ex * LCAP + pos] = wb;
          ((unsigned*)(F.ws + WS_TOKEP))[tk] = (ex << 16) | pos; }
        __syncthreads();
    }
}

__device__ __forceinline__ int moe_tables(Frame& F) {
    LAS int* cnt = (LAS int*)(F.lds + TAB_OFF); LAS int* tstart = cnt + 32; LAS unsigned char* tile_e = (LAS unsigned char*)(F.lds + TAB_OFF + 384);
    __syncthreads();
    if (F.tid < 32) cnt[F.tid] = (int)__hip_atomic_load((unsigned*)(F.ctl + CW_CNT + 64 * F.tid), RLX_AGENT);
    __syncthreads();
    if (F.tid == 0) { int s = 0; for (int e = 0; e < NE; ++e) { tstart[e] = s; s += (cnt[e] + 255) >> 8; } tstart[NE] = s; }
    __syncthreads();
    const int TT = tstart[NE];
    for (int t = F.tid; t < TT; t += 512) { int e = 0;
#pragma unroll
        for (int k = 1; k < NE; ++k) e += (tstart[k] <= t) ? 1 : 0;
        tile_e[t] = (unsigned char)e; }
    __syncthreads();
    return TT;
}

#define f8lo(w, b) __builtin_amdgcn_cvt_f32_fp8((int)(w), b)
__device__ __forceinline__ void p9_combine(Frame& F) {
    const LAS int* tstart = (const LAS int*)(F.lds + TAB_OFF) + 32;
    const unsigned char* Y = (const unsigned char*)(F.ws + WS_Y); const unsigned* tokep = (const unsigned*)(F.ws + WS_TOKEP);
    const int gw = F.bx * NWAVES + F.wave, NGW = F.G * NWAVES, lane = F.lane;
    for (int t0 = gw; t0 < NTOK; t0 += 16 * NGW) {
        const int tk = t0 + (lane & 15) * NGW; u32x4 ep = {0u, 0u, 0u, 0u};
        if (tk < NTOK) ep = *(const u32x4*)(tokep + (size_t)tk * 4);
        unsigned so0 = (unsigned)tstart[ep.x >> 16] * 256u + (ep.x & 0xffffu), so1 = (unsigned)tstart[ep.y >> 16] * 256u + (ep.y & 0xffffu);
        unsigned so2 = (unsigned)tstart[ep.z >> 16] * 256u + (ep.z & 0xffffu), so3 = (unsigned)tstart[ep.w >> 16] * 256u + (ep.w & 0xffffu);
#pragma unroll 2
        for (int k = 0; k < 16; ++k) {
            const int t = t0 + k * NGW; if (t >= NTOK) break;
            const size_t s0 = (size_t)__builtin_amdgcn_readlane((int)so0, k), s1 = (size_t)__builtin_amdgcn_readlane((int)so1, k), s2 = (size_t)__builtin_amdgcn_readlane((int)so2, k), s3 = (size_t)__builtin_amdgcn_readlane((int)so3, k);
            float* xo = F.out + (size_t)t * D; const bf16_t* xi = (const bf16_t*)(F.ws + WS_X1B) + (size_t)t * D;
            u32x2 y0[4], y1[4], y2[4], y3[4]; f32x4 a[4], b[4];
#pragma unroll
            for (int j = 0; j < 4; ++j) { const int c = (lane + 64 * j) * 8;
                y0[j] = *(const u32x2*)(Y + s0 * D + c); y1[j] = *(const u32x2*)(Y + s1 * D + c); y2[j] = *(const u32x2*)(Y + s2 * D + c); y3[j] = *(const u32x2*)(Y + s3 * D + c);
                const u32x4 xw = *(const u32x4*)(xi + c); a[j] = (f32x4){bf_lo(xw.x), bf_hi(xw.x), bf_lo(xw.y), bf_hi(xw.y)}; b[j] = (f32x4){bf_lo(xw.z), bf_hi(xw.z), bf_lo(xw.w), bf_hi(xw.w)}; }
#pragma unroll
            for (int j = 0; j < 4; ++j) { const int c = (lane + 64 * j) * 8;
#define Y4(w, i) ((f8lo(y0[j].w, i) + f8lo(y1[j].w, i)) + (f8lo(y2[j].w, i) + f8lo(y3[j].w, i))) * 0.0625f
                a[j].x += Y4(x, 0); a[j].y += Y4(x, 1); a[j].z += Y4(x, 2); a[j].w += Y4(x, 3);
                b[j].x += Y4(y, 0); b[j].y += Y4(y, 1); b[j].z += Y4(y, 2); b[j].w += Y4(y, 3);
#undef Y4
                *(f32x4*)(xo + c) = a[j]; *(f32x4*)(xo + c + 4) = b[j]; }
        }
    }
}

struct Args { const float* in[20]; float* out; unsigned char* ws; int ph_lo, ph_hi, li, pad; };
__global__ void __launch_bounds__(NWAVES * 64, 2) mk_fwd(Args args) {
    extern __shared__ __attribute__((aligned(16))) unsigned char lds[];
    Frame F;
    F.lds = (LAS unsigned char*)lds;
    F.MISC = (volatile LAS unsigned*)(F.lds + MISC_OFF);
    F.tid = threadIdx.x; F.lane = F.tid & 63; F.wave = __builtin_amdgcn_readfirstlane(F.tid >> 6);
    F.G = gridDim.x; F.bx = blockIdx.x;
    F.out = args.out; F.ws = args.ws; F.ctl = (gu32*)(args.ws + WS_CTL);
    for (int u = F.tid; u < (LDS_BYTES - LDSCTL_OFF) / 4; u += NWAVES * 64) ((LAS unsigned*)(F.lds + LDSCTL_OFF))[u] = 0u;
    __syncthreads();
    XcdBarrier bar; bar.bar = (unsigned*)(F.ctl + CW_BAR); bar.x = 0; bar.st = nullptr;
    if (N_LAUNCHES != PER_PHASE) bar = xcd_barrier_post((unsigned*)(F.ctl + CW_BAR), F.MISC + 8, F.tid == 0);
#define GRID_BAR(seam) do { if (N_LAUNCHES == PER_PHASE) { if (F.tid == 0) __hip_atomic_store(F.ctl + CW_TMO, 0xBADBA0u | (unsigned)(seam), RLX_AGENT); } else { xcd_barrier(bar, F.wave == 0 && lane_now() == 0); } } while (0)
    const int lo = args.ph_lo, hi = args.ph_hi;
#ifndef PH_MASK
#define PH_MASK 0x3ff
#endif
#define IN(k) (((PH_MASK >> (k)) & 1) && lo <= (k) && (k) < hi)
#define BOTH(k) (IN(k) && IN((k) + 1))
#define REFRESH() do { F.lane = lane_now(); F.tid = F.wave * 64 + F.lane; } while (0)
    unsigned char* ws = args.ws;

    if (IN(0)) { REFRESH(); p0_prologue(F); if (BOTH(0)) GRID_BAR(0); }

    if (IN(1)) { REFRESH();
        pg8::Gemm g{ws + WS_H, ws + WS_WIN, D, F8_ONE, F8_W}; pg8::StaticOrder S; S.init(NTOK, NCOLS, F.G, F.bx);
        pg8::EpiProj E{ws};
        pg8::gemm_phase<pg8::EpiProj, pg8::StaticOrder, true, true>(F.lds + RING_OFF, g, S, E, F.wave);
        if (BOTH(1)) GRID_BAR(1);
    }
    if (IN(2)) { REFRESH(); p2_qknorm(F); if (BOTH(2)) GRID_BAR(2); }
    if (IN(3)) { REFRESH(); p3_attention(F, (char*)lds + RING_OFF); if (BOTH(3)) GRID_BAR(3); }
    if (IN(4)) { REFRESH();
        { pg8::Gemm g{ws + WS_YA, ws + WS_WPA, 1024, F8_Y, F8_W, (long long)(WS_YB - WS_YA), (long long)(WS_WPB - WS_WPA)}; pg8::StaticOrder S; S.init(NTOK, D, F.G, F.bx);
          pg8::EpiGateDual E{(unsigned char*)(ws + WS_MERGED8), (const unsigned char*)(ws + WS_G)};
          pg8::gemm_phase<pg8::EpiGateDual, pg8::StaticOrder, true, true, true>(F.lds + RING_OFF, g, S, E, F.wave); }
        if (BOTH(4)) GRID_BAR(4);
    }
    if (IN(5)) { REFRESH();
        pg8::Gemm g{ws + WS_MERGED8, ws + WS_WOUT, D, F8_M, F8_W}; pg8::StaticOrder S; S.init(NTOK, D, F.G, F.bx);
        pg8::EpiResidB E{inp(0), (bf16_t*)(ws + WS_X1B), D};
        pg8::gemm_phase<pg8::EpiResidB, pg8::StaticOrder, true, true>(F.lds + RING_OFF, g, S, E, F.wave);
        if (BOTH(5)) GRID_BAR(5);
    }
    if (IN(6)) { REFRESH(); p6_router(F); if (BOTH(6)) GRID_BAR(6); }
    if (IN(7)) { REFRESH();
        const int TT = moe_tables(F);
        const LAS int* cnt = (const LAS int*)(F.lds + TAB_OFF);
        pg8::Gemm g{ws + WS_H8, ws + WS_WGU, D, F8_ONE, F8_W};
        pg8::MoeOrder S{cnt, cnt + 32, (const LAS unsigned char*)(F.lds + TAB_OFF + 384), TT, 16, F.G, F.bx, (const int*)(ws + WS_LTOK), true, (size_t)4096};
        pg8::EpiSwiglu E{(unsigned char*)(ws + WS_ACT), inp(15), inp(17)};
        pg8::gemm_phase<pg8::EpiSwiglu, pg8::MoeOrder, true, true>(F.lds + RING_OFF, g, S, E, F.wave);
        if (BOTH(7)) GRID_BAR(7);
    }
    if (IN(8)) { REFRESH();
        const int TT = moe_tables(F);
        const LAS int* cnt = (const LAS int*)(F.lds + TAB_OFF);
        pg8::Gemm g{ws + WS_ACT, ws + WS_WD, DE, F8_ONE, F8_W};
        pg8::MoeOrder S{cnt, cnt + 32, (const LAS unsigned char*)(F.lds + TAB_OFF + 384), TT, 8, F.G, F.bx, (const int*)(ws + WS_LTOK), false, (size_t)2048};
        pg8::EpiDown E{(unsigned char*)(ws + WS_Y), inp(19), (const float*)(ws + WS_LW), cnt + 32};
        pg8::gemm_phase<pg8::EpiDown, pg8::MoeOrder, true, true>(F.lds + RING_OFF, g, S, E, F.wave);
        if (BOTH(8)) GRID_BAR(8);
    }
    if (IN(9)) { REFRESH(); (void)moe_tables(F); p9_combine(F); }
#undef IN
#undef BOTH
}

extern "C" void kernel_launch(void* const* d_in, const int* in_sizes, int n_in, void* d_out, int out_size, void* d_ws, size_t ws_size, hipStream_t stream) {
    static int grid = 0;
    if (grid == 0) {
        if (n_in != 20 || out_size != NTOK * D || ws_size < WS_END) { fprintf(stderr, "kernel_launch: shape mismatch n_in %d out %d ws %zu (need %zu)\n", n_in, out_size, ws_size, (size_t)WS_END); grid = -1; return; }
        int dev = 0, cus = 0, per_cu = 0;
        if (hipGetDevice(&dev) != hipSuccess || hipDeviceGetAttribute(&cus, hipDeviceAttributeMultiprocessorCount, dev) != hipSuccess) { grid = -1; return; }
        if (hipFuncSetAttribute((const void*)mk_fwd, hipFuncAttributeMaxDynamicSharedMemorySize, LDS_BYTES) != hipSuccess) { fprintf(stderr, "kernel_launch: hipFuncSetAttribute failed\n"); grid = -1; return; }
        if (hipOccupancyMaxActiveBlocksPerMultiprocessor(&per_cu, (const void*)mk_fwd, NWAVES * 64, LDS_BYTES) != hipSuccess || per_cu < 1) fprintf(stderr, "kernel_launch: occupancy query reports %d\n", per_cu);
        (void)hipGetLastError();
        grid = cus < 256 ? cus : 256;
    }
    if (grid < 0) return;
    if (hipMemsetAsync((char*)d_ws + WS_CTL, 0, CTL_ZERO_BYTES, stream) != hipSuccess) return;
    Args a{};
    for (int i = 0; i < 20; ++i) a.in[i] = (const float*)d_in[i];
    a.out = (float*)d_out; a.ws = (unsigned char*)d_ws;
    for (int li = 0; li < N_LAUNCHES; ++li) {
        a.ph_lo = (N_LAUNCHES == PER_PHASE) ? li : 0; a.ph_hi = (N_LAUNCHES == PER_PHASE) ? li + 1 : PER_PHASE; a.li = li; a.pad = 0;
        for (int rep = 0; rep < ((N_LAUNCHES == PER_PHASE && li == DUP_PHASE) ? DUP_TIMES : 1) - 1; ++rep) hipLaunchKernelGGL(mk_fwd, dim3(grid), dim3(NWAVES * 64), LDS_BYTES, stream, a);
        hipLaunchKernelGGL(mk_fwd, dim3(grid), dim3(NWAVES * 64), LDS_BYTES, stream, a);
        const hipError_t le = hipPeekAtLastError();
        if (le != hipSuccess) { fprintf(stderr, "kernel_launch: launch %d failed: %s\n", li, hipGetErrorName(le)); break; }
    }
}
```
